# Optimizing an MI355X kernel written in HIP

```python
import jax
import jax.numpy as jnp
from jax import lax
import numpy as np


D_MODEL = 1024
BATCH = 32
SEQ = 2048
DEPTH = 4

N_META = 16
CHUNK = 64
D_MIX = D_MODEL
MLA_HEADS = 8
QK_NOPE = 64
QK_ROPE = 32
V_HEAD = 64
Q_LORA = 768
KV_LORA = 256
ROPE_THETA = 10000.0
ATTN_BLOCK = 128
MLA_WIDTH = MLA_HEADS * V_HEAD
POOL_GROUPS = 4
POOL_GROUP_DIM = 64
POOL_WINDOWS = (2, 4, 8, 16)
POOL_WIDTH = POOL_GROUPS * POOL_GROUP_DIM
MLSTM_HEADS = 4
MLSTM_HEAD_DIM = 64
MLSTM_WIDTH = MLSTM_HEADS * MLSTM_HEAD_DIM
CONV_WIDTH = 4
MLSTM_BLOCK = 16
D_FF = 2816
N_EXPERTS = 8
TOP_K = 2
D_FF_EXPERT = 3584
MOE_BLOCK = 256
EPS = 1e-6
NEG_INF = -1e30
IN_SIZES = (Q_LORA, KV_LORA, QK_ROPE, POOL_WIDTH, 2 * MLSTM_WIDTH, MLSTM_WIDTH, MLSTM_WIDTH, 2 * MLSTM_HEADS)
D_IN = Q_LORA + KV_LORA + QK_ROPE + POOL_WIDTH + 4 * MLSTM_WIDTH + 2 * MLSTM_HEADS

kernel_name = "hybrid_meta_mla_pool_mlstm_moe_trunk"


def _rmsnorm(x, g):
    xf = x.astype(jnp.float32)
    y = xf * lax.rsqrt(jnp.mean(xf * xf, axis=-1, keepdims=True) + EPS)
    return (y * g.astype(jnp.float32)).astype(x.dtype)


def _rope(x, cos, sin):
    half = x.shape[-1] // 2
    x1, x2 = x[..., :half], x[..., half:]
    cos = cos.astype(x.dtype)
    sin = sin.astype(x.dtype)
    return jnp.concatenate([x1 * cos - x2 * sin, x2 * cos + x1 * sin], axis=-1)


def _mla_attention(qn, qr, kn, kr, v, cid):
    bsz, L, H, _ = qn.shape
    scale = (QK_NOPE + QK_ROPE) ** -0.5
    outs = []
    for q0 in range(0, L, ATTN_BLOCK):
        q1 = min(q0 + ATTN_BLOCK, L)
        kend = min(L, N_META + ((q1 - 1 - N_META) // CHUNK + 1) * CHUNK)
        s = (jnp.einsum('bqhd,bkhd->bhqk', qn[:, q0:q1], kn[:, :kend])
             + jnp.einsum('bqhr,bkr->bhqk', qr[:, q0:q1], kr[:, :kend]))
        s = s.astype(jnp.float32) * scale
        mask = cid[None, :kend] <= cid[q0:q1, None]
        p = jax.nn.softmax(jnp.where(mask, s, NEG_INF), axis=-1).astype(v.dtype)
        outs.append(jnp.einsum('bhqk,bkhd->bqhd', p, v[:, :kend]))
    return jnp.concatenate(outs, axis=1).reshape(bsz, L, H * V_HEAD)


def _multiscale_pool(xp, pool_w, pool_scale):
    bsz, L, _ = xp.shape
    xf = xp.astype(jnp.float32).reshape(bsz, L, POOL_GROUPS, POOL_GROUP_DIM)
    cs = jnp.cumsum(xf, axis=1)
    count = jnp.arange(1, L + 1, dtype=jnp.float32)
    diffs = []
    for g, w in enumerate(POOL_WINDOWS):
        c = cs[:, :, g]
        lag = jnp.pad(c[:, :L - w], ((0, 0), (w, 0), (0, 0)))
        mean = (c - lag) / jnp.minimum(count, float(w))[None, :, None]
        diffs.append(mean - xf[:, :, g])
    d = jnp.stack(diffs, axis=2)
    y = jnp.einsum('blgc,gcd->blgd', d, pool_w.astype(jnp.float32))
    return (y.reshape(bsz, L, POOL_WIDTH) * pool_scale.astype(jnp.float32)).astype(xp.dtype)


def _causal_depthwise_conv(x, w, b):
    C = x.shape[-1]
    y = lax.conv_general_dilated(x, w[:, None, :].astype(x.dtype), window_strides=(1,),
                                 padding=[(CONV_WIDTH - 1, 0)],
                                 dimension_numbers=('NWC', 'WIO', 'NWC'),
                                 feature_group_count=C)
    return y + b.astype(x.dtype)


def _mlstm(q, k, v, ig, fg):
    bsz, L, H, dh = q.shape
    T = MLSTM_BLOCK
    NC = L // T

    def chunks(a):
        return a.reshape(bsz, NC, T, H, -1).transpose(1, 0, 3, 2, 4)

    def chunks_g(a):
        return a.reshape(bsz, NC, T, H).transpose(1, 0, 3, 2)

    li = chunks_g(ig)
    lf = chunks_g(jax.nn.log_sigmoid(fg))
    tri = jnp.tril(jnp.ones((T, T), dtype=bool))

    def step(carry, inp):
        C, n, m = carry
        qc, kc, vc, lic, lfc = inp
        b = jnp.cumsum(lfc, axis=-1)
        D = jnp.where(tri, b[..., :, None] - b[..., None, :] + lic[..., None, :], NEG_INF)
        m_inter = b + m[..., None]
        m_t = jnp.maximum(m_inter, jnp.max(D, axis=-1))
        s = jnp.einsum('bhtd,bhsd->bhts', qc, kc) * jnp.exp(D - m_t[..., None])
        decay = jnp.exp(m_inter - m_t)
        num = (jnp.einsum('bhts,bhsd->bhtd', s, vc)
               + decay[..., None] * jnp.einsum('bhvk,bhtk->bhtv', C, qc))
        den = jnp.sum(s, axis=-1) + decay * jnp.einsum('bhk,bhtk->bht', n, qc)
        hc = num / jnp.maximum(jnp.abs(den), jnp.exp(-m_t))[..., None]
        g = b[..., -1:] - b + lic
        m_new = jnp.maximum(b[..., -1] + m, jnp.max(g, axis=-1))
        wg = jnp.exp(g - m_new[..., None])
        carry_decay = jnp.exp(b[..., -1] + m - m_new)
        C_new = carry_decay[..., None, None] * C + jnp.einsum('bhsv,bhsk->bhvk', vc * wg[..., None], kc)
        n_new = carry_decay[..., None] * n + jnp.einsum('bhs,bhsk->bhk', wg, kc)
        return (C_new, n_new, m_new), hc

    init = (jnp.zeros((bsz, H, dh, dh), jnp.float32),
            jnp.zeros((bsz, H, dh), jnp.float32),
            jnp.zeros((bsz, H), jnp.float32))
    _, hs = lax.scan(step, init, (chunks(q), chunks(k), chunks(v), li, lf))
    return hs.transpose(1, 0, 3, 2, 4).reshape(bsz, L, H, dh)


def _mixer(xn, w_in, q_norm, w_q_up, kv_norm, w_kv_up, pool_w, pool_scale,
           conv_w, conv_b, gate_bias, mlstm_norm, w_out, cos, sin, cid):
    bsz, L, _ = xn.shape
    z = xn @ w_in
    pts = np.cumsum(np.array(IN_SIZES))[:-1].tolist()
    cq, ckv, kr, xp, mqk, mv, mo, mg = jnp.split(z, pts, axis=-1)

    q = (_rmsnorm(cq, q_norm) @ w_q_up).reshape(bsz, L, MLA_HEADS, QK_NOPE + QK_ROPE)
    qn, qr = q[..., :QK_NOPE], _rope(q[..., QK_NOPE:], cos[:, None, :], sin[:, None, :])
    kv = (_rmsnorm(ckv, kv_norm) @ w_kv_up).reshape(bsz, L, MLA_HEADS, QK_NOPE + V_HEAD)
    kn, v = kv[..., :QK_NOPE], kv[..., QK_NOPE:]
    kr = _rope(kr, cos, sin)
    y_attn = _mla_attention(qn, qr, kn, kr, v, cid)

    y_pool = _multiscale_pool(xp, pool_w, pool_scale)

    qk = jax.nn.silu(_causal_depthwise_conv(mqk, conv_w, conv_b))
    mq, mk = qk[..., :MLSTM_WIDTH], qk[..., MLSTM_WIDTH:]
    gates = (mg + gate_bias).astype(jnp.float32)
    ig, fg = gates[..., :MLSTM_HEADS], gates[..., MLSTM_HEADS:]
    shp = (bsz, L, MLSTM_HEADS, MLSTM_HEAD_DIM)
    hm = _mlstm(mq.astype(jnp.float32).reshape(shp),
                mk.astype(jnp.float32).reshape(shp) * (MLSTM_HEAD_DIM ** -0.5),
                mv.astype(jnp.float32).reshape(shp), ig, fg)
    hm = _rmsnorm(hm, mlstm_norm).reshape(bsz, L, MLSTM_WIDTH).astype(xn.dtype)
    y_mlstm = hm * jax.nn.sigmoid(mo)

    return jnp.concatenate([y_attn, y_pool, y_mlstm], axis=-1) @ w_out


def _swiglu(h, wg, wu, wd):
    return (jax.nn.silu(h @ wg) * (h @ wu)) @ wd


def _moe(h, router_w, wg, wu, wd):
    bsz, L, D = h.shape
    xt = h.reshape(-1, D)
    N = xt.shape[0]
    logits = (xt @ router_w).astype(jnp.float32)
    top_val, top_idx = lax.top_k(logits, TOP_K)
    gates = jax.nn.softmax(top_val, axis=-1)
    A = N * TOP_K
    e_flat = top_idx.reshape(-1)
    tok_flat = jnp.repeat(jnp.arange(N, dtype=jnp.int32), TOP_K)
    g_flat = gates.reshape(-1)
    order = jnp.argsort(e_flat)
    e_sorted = e_flat[order]
    counts = jnp.bincount(e_flat, length=N_EXPERTS)
    padded = (counts + MOE_BLOCK - 1) // MOE_BLOCK * MOE_BLOCK
    start = jnp.cumsum(counts) - counts
    pend = jnp.cumsum(padded)
    pstart = pend - padded
    dest = pstart[e_sorted] + (jnp.arange(A) - start[e_sorted])
    n_blocks = -(-A // MOE_BLOCK) + N_EXPERTS
    R = n_blocks * MOE_BLOCK
    row_tok = jnp.zeros((R,), jnp.int32).at[dest].set(tok_flat[order])
    row_gate = jnp.zeros((R,), jnp.float32).at[dest].set(g_flat[order])
    block_exp = jnp.minimum(
        jnp.searchsorted(pend, jnp.arange(n_blocks) * MOE_BLOCK, side='right'), N_EXPERTS - 1)
    xs = xt[row_tok].reshape(n_blocks, MOE_BLOCK, D)
    ys = lax.map(lambda a: _swiglu(a[0], wg[a[1]], wu[a[1]], wd[a[1]]), (xs, block_exp))
    ys = ys.reshape(R, D) * row_gate[:, None].astype(xt.dtype)
    out = jnp.zeros_like(xt).at[row_tok].add(ys)
    return out.reshape(bsz, L, D)


def setup_inputs(seed: int = 0) -> dict:
    key = jax.random.key(seed)
    ks = jax.random.split(key, 32)
    n_dense = (DEPTH + 1) // 2
    n_moe = DEPTH // 2

    def nrm(k, shape, scale):
        return jax.random.normal(k, shape, jnp.float32) * scale

    f_bias = jnp.linspace(3.0, 6.0, MLSTM_HEADS, dtype=jnp.float32)[None, :] + nrm(ks[13], (DEPTH, MLSTM_HEADS), 0.1)
    i_bias = nrm(ks[12], (DEPTH, MLSTM_HEADS), 0.1)
    return {
        "x": nrm(ks[0], (BATCH, SEQ, D_MODEL), 1.0),
        "meta_tokens": nrm(ks[1], (N_META, D_MODEL), 1.0),
        "attn_norm": 1.0 + nrm(ks[2], (DEPTH, D_MODEL), 0.05),
        "w_in": nrm(ks[3], (DEPTH, D_MODEL, D_IN), D_MODEL ** -0.5),
        "q_norm": 1.0 + nrm(ks[4], (DEPTH, Q_LORA), 0.05),
        "w_q_up": nrm(ks[5], (DEPTH, Q_LORA, MLA_HEADS * (QK_NOPE + QK_ROPE)), Q_LORA ** -0.5),
        "kv_norm": 1.0 + nrm(ks[6], (DEPTH, KV_LORA), 0.05),
        "w_kv_up": nrm(ks[7], (DEPTH, KV_LORA, MLA_HEADS * (QK_NOPE + V_HEAD)), KV_LORA ** -0.5),
        "pool_w": nrm(ks[8], (DEPTH, POOL_GROUPS, POOL_GROUP_DIM, POOL_GROUP_DIM), POOL_GROUP_DIM ** -0.5),
        "pool_scale": 1.0 + nrm(ks[9], (DEPTH, POOL_WIDTH), 0.1),
        "conv_w": nrm(ks[10], (DEPTH, CONV_WIDTH, 2 * MLSTM_WIDTH), CONV_WIDTH ** -0.5),
        "conv_b": nrm(ks[11], (DEPTH, 2 * MLSTM_WIDTH), 0.01),
        "gate_bias": jnp.concatenate([i_bias, f_bias], axis=-1),
        "mlstm_norm": 1.0 + nrm(ks[14], (DEPTH, MLSTM_HEADS, MLSTM_HEAD_DIM), 0.05),
        "w_out": nrm(ks[15], (DEPTH, D_MIX, D_MODEL), D_MIX ** -0.5),
        "ffn_norm": 1.0 + nrm(ks[16], (DEPTH, D_MODEL), 0.05),
        "dense_w_gate": nrm(ks[17], (n_dense, D_MODEL, D_FF), D_MODEL ** -0.5),
        "dense_w_up": nrm(ks[18], (n_dense, D_MODEL, D_FF), D_MODEL ** -0.5),
        "dense_w_down": nrm(ks[19], (n_dense, D_FF, D_MODEL), D_FF ** -0.5),
        "router_w": nrm(ks[20], (n_moe, D_MODEL, N_EXPERTS), D_MODEL ** -0.5),
        "moe_w_gate": nrm(ks[21], (n_moe, N_EXPERTS, D_MODEL, D_FF_EXPERT), D_MODEL ** -0.5),
        "moe_w_up": nrm(ks[22], (n_moe, N_EXPERTS, D_MODEL, D_FF_EXPERT), D_MODEL ** -0.5),
        "moe_w_down": nrm(ks[23], (n_moe, N_EXPERTS, D_FF_EXPERT, D_MODEL), D_FF_EXPERT ** -0.5),
        "final_norm": 1.0 + nrm(ks[24], (D_MODEL,), 0.05),
    }


def reference(x, meta_tokens, attn_norm, w_in, q_norm, w_q_up, kv_norm, w_kv_up, pool_w,
              pool_scale, conv_w, conv_b, gate_bias, mlstm_norm, w_out, ffn_norm,
              dense_w_gate, dense_w_up, dense_w_down, router_w, moe_w_gate, moe_w_up,
              moe_w_down, final_norm):
    bsz = x.shape[0]
    meta = jnp.broadcast_to(meta_tokens[None].astype(x.dtype), (bsz, N_META, D_MODEL))
    h = jnp.concatenate([meta, x], axis=1)
    L = h.shape[1]
    pos = jnp.arange(L, dtype=jnp.int32)
    cid = (pos - N_META) // CHUNK + 1
    inv_freq = ROPE_THETA ** (-jnp.arange(0, QK_ROPE, 2, dtype=jnp.float32) / QK_ROPE)
    ang = pos.astype(jnp.float32)[:, None] * inv_freq[None, :]
    cos, sin = jnp.cos(ang), jnp.sin(ang)
    for l in range(DEPTH):
        h = h + _mixer(_rmsnorm(h, attn_norm[l]), w_in[l], q_norm[l], w_q_up[l], kv_norm[l],
                       w_kv_up[l], pool_w[l], pool_scale[l], conv_w[l], conv_b[l],
                       gate_bias[l], mlstm_norm[l], w_out[l], cos, sin, cid)
        hn = _rmsnorm(h, ffn_norm[l])
        if l % 2 == 0:
            j = l // 2
            h = h + _swiglu(hn, dense_w_gate[j], dense_w_up[j], dense_w_down[j])
        else:
            j = l // 2
            h = h + _moe(hn, router_w[j], moe_w_gate[j], moe_w_up[j], moe_w_down[j])
    return _rmsnorm(h, final_norm)[:, N_META:]
```

```cpp
#include <hip/hip_runtime.h>
#include <cstdio>
#include <cstdint>

#define LAS __attribute__((address_space(3)))
#define GAS __attribute__((address_space(1)))
typedef unsigned short bf16_t;
typedef short bf16x8 __attribute__((ext_vector_type(8)));
typedef short s16x4 __attribute__((ext_vector_type(4)));
typedef float f32x4 __attribute__((ext_vector_type(4)));
typedef float f32x2 __attribute__((ext_vector_type(2)));
typedef float f32x16 __attribute__((ext_vector_type(16)));
typedef unsigned u32x4 __attribute__((ext_vector_type(4)));
typedef unsigned u32x2 __attribute__((ext_vector_type(2)));
typedef unsigned long long u64;

constexpr int NBATCH = 32, SEQ = 2048, DM = 1024, DEPTH = 4, NMETA = 16, LTOT = SEQ + NMETA;
constexpr int MMAIN = NBATCH * SEQ;
constexpr int MREAL = MMAIN + NMETA;
constexpr int NPANEL = 257, MPAD = NPANEL * 256;
constexpr int QLORA = 768, KVLORA = 256, NHEAD = 8, QKN = 64, QKR = 32, VH = 64;
constexpr int DIN = 2344, DINP = 2560;
constexpr int DFF = 2816, DFFE = 3584, NEXP = 8;
constexpr int MH = 4, MHD = 64;
constexpr float EPS = 1e-6f;
constexpr float QSCALE = 0.10206207261596577f * 1.4426950408889634f;
constexpr float SSFIX = 1048576.0f;

__device__ __forceinline__ unsigned f2bf(float f) { unsigned u = __builtin_bit_cast(unsigned, f); return (u + 0x7fffu + ((u >> 16) & 1u)) >> 16; }
__device__ __forceinline__ unsigned pk2(float lo, float hi) { f32x2 v = {lo, hi}; typedef __bf16 bf2 __attribute__((ext_vector_type(2))); bf2 b = __builtin_convertvector(v, bf2); return __builtin_bit_cast(unsigned, b); }
__device__ __forceinline__ float bf2f(unsigned short h) { return __builtin_bit_cast(float, (unsigned)h << 16); }
__device__ __forceinline__ float bflo(unsigned w) { return __builtin_bit_cast(float, w << 16); }
__device__ __forceinline__ float bfhi(unsigned w) { return __builtin_bit_cast(float, w & 0xffff0000u); }
__device__ __forceinline__ float fexp2(float x) { return __builtin_amdgcn_exp2f(x); }
__device__ __forceinline__ float fexp(float x) { return __builtin_amdgcn_exp2f(x * 1.4426950408889634f); }
__device__ __forceinline__ float frcp(float x) { return __builtin_amdgcn_rcpf(x); }
__device__ __forceinline__ float sigmoidf_(float x) { return frcp(1.0f + fexp(-x)); }
__device__ __forceinline__ float siluf_(float x) { return x * sigmoidf_(x); }
__device__ __forceinline__ float rstd_of(u64 ss, float inv_n) { return rsqrtf((float)ss * (1.0f / SSFIX) * inv_n + EPS); }
__device__ __forceinline__ u64 ss_fix(float s) { return (u64)(s * SSFIX + 0.5f); }
__device__ __forceinline__ int lane_id() { int l; asm volatile("v_mbcnt_lo_u32_b32 %0, -1, 0\n\tv_mbcnt_hi_u32_b32 %0, -1, %0" : "=v"(l)); return l; }
__device__ __forceinline__ int seqrow(int b, int pos) { return pos < NMETA ? MMAIN + pos : b * SEQ + (pos - NMETA); }
__device__ __forceinline__ int rowpos(int row) { return row < MMAIN ? NMETA + (row & (SEQ - 1)) : row - MMAIN; }

#define XB_TMO      128
#define XB_XCNT(j)  (256  + 64 * (j))
#define XB_XSUB(j)  (1280 + 64 * (j))
#define XB_XGEN(j)  (2304 + 64 * (j))
#define XB_TOP      3328
#define XB_TOPGEN   3392
#define XCD_BAR_WORDS 3456
#define XB_SPIN_CAP (1u << 22)

__device__ __forceinline__ unsigned xb_ld(unsigned* p)              { return __hip_atomic_load(p, __ATOMIC_RELAXED, __HIP_MEMORY_SCOPE_AGENT); }
__device__ __forceinline__ unsigned xb_add(unsigned* p, unsigned v) { return __hip_atomic_fetch_add(p, v, __ATOMIC_RELAXED, __HIP_MEMORY_SCOPE_AGENT); }
__device__ __forceinline__ unsigned xb_xcc_id() { return (unsigned)__builtin_amdgcn_s_getreg((3 << 11) | 20) & 0xFu; }
#define XB_SPIN(cond, bar) do { unsigned _sp = 0; while (cond) { __builtin_amdgcn_s_sleep(1); \
    if ((++_sp & 255u) == 0u) { if (xb_ld(&(bar)[XB_TMO])) break; if (_sp > XB_SPIN_CAP) { atomicAdd(&(bar)[XB_TMO], 1u); break; } } } } while (0)

struct XcdBarrier { unsigned* bar; unsigned x; volatile LAS unsigned* st; };

__device__ __forceinline__ XcdBarrier xcd_barrier_post(unsigned* bar, volatile LAS unsigned* st, bool leader) {
    XcdBarrier b; b.bar = bar; b.x = xb_xcc_id(); b.st = st;
    if (leader) (void)xb_add(&bar[XB_XCNT(b.x)], 1u);
    return b;
}
__device__ __forceinline__ void xcd_barrier_complete(unsigned* bar, unsigned x, unsigned& nloc, unsigned& nx) {
    const unsigned G = gridDim.x * gridDim.y * gridDim.z;
    unsigned sum, cnt, mine, sp = 0u;
    for (;;) {
        sum = 0u; cnt = 0u; mine = 0u;
#pragma unroll
        for (unsigned j = 0; j < 16; ++j) { const unsigned c = xb_ld(&bar[XB_XCNT(j)]); sum += c; cnt += (c > 0u) ? 1u : 0u; mine = (j == x) ? c : mine; }
        if (sum == G) break;
        __builtin_amdgcn_s_sleep(1);
        if ((++sp & 255u) == 0u) { if (xb_ld(&bar[XB_TMO])) break; if (sp > XB_SPIN_CAP) { atomicAdd(&bar[XB_TMO], 1u); break; } }
    }
    nloc = mine > 0u ? mine : 1u; nx = cnt > 0u ? cnt : 1u;
}
__device__ __forceinline__ void xcd_barrier(const XcdBarrier& b, bool leader) {
    asm volatile("s_waitcnt vmcnt(0)" ::: "memory");
    __syncthreads();
    if (leader) {
        unsigned* bar = b.bar;
        __builtin_amdgcn_s_waitcnt(0);
        unsigned nloc = b.st[0], nx = b.st[1];
        if (nloc == 0u) { xcd_barrier_complete(bar, b.x, nloc, nx); b.st[0] = nloc; b.st[1] = nx; }
        const unsigned old = xb_add(&bar[XB_XSUB(b.x)], 1u);
        const unsigned gen = old / nloc;
        if (old + 1u == (gen + 1u) * nloc) {
            __builtin_amdgcn_fence(__ATOMIC_RELEASE, "agent");
            asm volatile("s_waitcnt vmcnt(0)" ::: "memory");
            const unsigned og = xb_add(&bar[XB_TOP], 1u);
            const unsigned tg = og / nx;
            if (og + 1u == (tg + 1u) * nx) xb_add(&bar[XB_TOPGEN], 1u);
            else XB_SPIN(xb_ld(&bar[XB_TOPGEN]) == tg, bar);
            __builtin_amdgcn_fence(__ATOMIC_ACQUIRE, "agent");
            xb_add(&bar[XB_XGEN(b.x)], 1u);
            asm volatile("s_waitcnt vmcnt(0)" ::: "memory");
        } else {
            XB_SPIN(xb_ld(&bar[XB_XGEN(b.x)]) == gen, bar);
            __builtin_amdgcn_fence(__ATOMIC_ACQUIRE, "agent");
            asm volatile("s_waitcnt vmcnt(0)" ::: "memory");
        }
    }
    __syncthreads();
}

__device__ __forceinline__ const char* uni_ptr(const char* p) { const unsigned long long v = (unsigned long long)p; const unsigned lo = __builtin_amdgcn_readfirstlane((unsigned)v), hi = __builtin_amdgcn_readfirstlane((unsigned)(v >> 32)); return (const char*)(((unsigned long long)hi << 32) | lo); }
namespace pg8 {
constexpr int BM = 256, BK = 64, HALF = 128, HTB = HALF * BK * 2, STAGE_BYTES = 8 * HTB, NXCD = 8, WGM = 8;
__host__ __device__ __forceinline__ int lds_byte(int r, int c) { const int st = (r >> 4) * 2 + (c >> 5), rr = r & 15, cc = c & 31, ob = rr * 64 + cc * 2; return st * 1024 + (ob ^ (((ob >> 9) & 1) << 5)); }
__host__ __device__ __forceinline__ void stage_rc(int b, int& R, int& C) { const int st = b / 1024, sb = b % 1024, swz = sb ^ (((sb >> 9) & 1) << 5); R = (st >> 1) * 16 + swz / 64; C = (st & 1) * 32 + (swz % 64) / 2; }
__host__ __device__ __forceinline__ int perm32(int rho) { const int n = rho >> 4, i = rho & 15; return 8 * (i >> 2) + 4 * n + (i & 3); }

struct Unit { int pm, pn; };

struct StaticOrder {
    int nM, nN, nwg, G, c; const char* A; const char* B; size_t tstep;
    __device__ __forceinline__ void init(const bf16_t* A_, const bf16_t* B_, int K, int nM_, int nN_, int G_, int c_) { A = (const char*)A_; B = (const char*)B_; tstep = (size_t)BM * K * 2; nM = nM_; nN = nN_; nwg = nM * nN; G = G_; c = c_; }
    __device__ __forceinline__ bool next(int i, Unit& u) const {
        const long L = (long)i * G + c; if (L >= nwg) return false;
        int wgid = (int)L; { const int q = nwg / NXCD, r = nwg % NXCD, xcd = wgid % NXCD, off = wgid / NXCD; wgid = (xcd < r ? xcd * (q + 1) : r * (q + 1) + (xcd - r) * q) + off; }
        const int nig = WGM * nN, gid = wgid / nig, fm = gid * WGM, gsz = (nM - fm) < WGM ? (nM - fm) : WGM;
        u.pm = fm + ((wgid % nig) % gsz); u.pn = (wgid % nig) / gsz; return true;
    }
    __device__ __forceinline__ const char* a_ptr(const Unit& u) const { return A + (size_t)u.pm * tstep; }
    __device__ __forceinline__ const char* b_ptr(const Unit& u) const { return B + (size_t)u.pn * tstep; }
    __device__ __forceinline__ int a_row(const Unit&, int) const { return 0; }
    __device__ __forceinline__ const int* a_row_ptr(const Unit&, int) const { return nullptr; }
};

template <class Epi, class Sched, bool GATHER>
__device__ __forceinline__ void gemm_phase(LAS unsigned char* lds, const int tid_, const int K_, const Sched& S, const Epi& E) {
    int tid = tid_, K = K_;
    asm volatile("" : "+v"(tid)); asm volatile("" : "+s"(K));
    const int wid = __builtin_amdgcn_readfirstlane(tid >> 6), lane = tid & 63, wr = wid >> 2, wc = wid & 3, fr = lane & 15, fq = lane >> 4;
    const int nt = K / BK;
    unsigned voffA[2], voffB[2]; int RA[2], CA2[2];
#pragma unroll
    for (int i = 0; i < 2; ++i) { int R, C; stage_rc(tid * 16 + i * 8192, R, C); const int Rb = Epi::PERM ? ((R & ~31) + perm32(R & 31)) : R;
        voffA[i] = (unsigned)(R * K + C) * 2u; voffB[i] = (unsigned)(Rb * K + C) * 2u; RA[i] = R; CA2[i] = C * 2; }
    const size_t kstep = (size_t)(BK * 2);
    const size_t hstep = GATHER ? (size_t)0 : (size_t)HALF * K * 2;
    const size_t hstepB = (size_t)HALF * K * 2;
    const unsigned ldsw = (unsigned)wid * 1024u;
    const int aoff = lds_byte(wr * 64 + fr, fq * 8), boff = lds_byte(wc * 32 + fr, fq * 8);
#define PG8_SA(b, h) (((b) * 2 + (h)) * HTB)
#define PG8_SB(b, h) ((4 + (b) * 2 + (h)) * HTB)
#define PG8_STAGE(bufoff, gbase, voff) do { const char* _gb = uni_ptr((const char*)(gbase)); _Pragma("unroll") for (int _i = 0; _i < 2; ++_i) \
        __builtin_amdgcn_global_load_lds((const unsigned*)(_gb + (voff)[_i]), (LAS unsigned*)(lds + (bufoff) + ldsw + _i * 8192), 16, 0, 0); } while (0)
#define PG8_LDA(dst, b, h) do { _Pragma("unroll") for (int m = 0; m < 4; ++m) _Pragma("unroll") for (int k = 0; k < 2; ++k) dst[m][k] = *(const LAS bf16x8*)(lds + PG8_SA(b, h) + aoff + m * 2048 + k * 1024); } while (0)
#define PG8_LDB(dst, b, h) do { _Pragma("unroll") for (int n = 0; n < 2; ++n) _Pragma("unroll") for (int k = 0; k < 2; ++k) dst[n][k] = *(const LAS bf16x8*)(lds + PG8_SB(b, h) + boff + n * 2048 + k * 1024); } while (0)
#define PG8_MMA(ai, bj, At, Bt) do { __builtin_amdgcn_s_setprio(1); _Pragma("unroll") for (int m = 0; m < 4; ++m) _Pragma("unroll") for (int n = 0; n < 2; ++n) _Pragma("unroll") for (int k = 0; k < 2; ++k) \
        acc[ai][bj][m][n] = __builtin_amdgcn_mfma_f32_16x16x32_bf16(Bt[n][k], At[m][k], acc[ai][bj][m][n], 0, 0, 0); __builtin_amdgcn_s_setprio(0); } while (0)
#define PG8_WAIT_V(n) asm volatile("s_waitcnt vmcnt(" #n ")" ::: "memory")
#define PG8_WAIT_L(n) asm volatile("s_waitcnt lgkmcnt(" #n ")" ::: "memory")
#define PG8_BAR __builtin_amdgcn_s_barrier()
#define PG8_SCHED __builtin_amdgcn_sched_barrier(0)
    Unit cur, nxt; int ui = 0;
    if (!S.next(0, cur)) return;
    f32x4 acc[2][2][4][2];
#pragma unroll
    for (int a = 0; a < 2; ++a)
#pragma unroll
        for (int b = 0; b < 2; ++b)
#pragma unroll
            for (int m = 0; m < 4; ++m)
#pragma unroll
                for (int n = 0; n < 2; ++n) acc[a][b][m][n] = (f32x4){0.f, 0.f, 0.f, 0.f};
    bf16x8 At[4][2], B0[2][2], B1[2][2];
    unsigned gc0[2], gc1[2];
    const char* cA = S.a_ptr(cur); const char* cB = S.b_ptr(cur);
    LAS int* gtab = (LAS int*)(lds + STAGE_BYTES + 1024);
    if constexpr (GATHER) {
#pragma unroll
        for (int i = 0; i < 2; ++i) { gc0[i] = (unsigned)S.a_row(cur, RA[i]) * (unsigned)(K * 2) + CA2[i]; gc1[i] = (unsigned)S.a_row(cur, HALF + RA[i]) * (unsigned)(K * 2) + CA2[i]; }
    } else {
#pragma unroll
        for (int i = 0; i < 2; ++i) { gc0[i] = voffA[i]; gc1[i] = voffA[i]; }
    }
    PG8_STAGE(PG8_SB(0, 0), cB, voffB); PG8_STAGE(PG8_SB(0, 1), cB + hstepB, voffB); PG8_STAGE(PG8_SA(0, 0), cA, gc0); PG8_STAGE(PG8_SA(0, 1), cA + hstep, gc1);
    if (wr == 1) PG8_BAR;
    PG8_WAIT_V(2); PG8_BAR;
    PG8_STAGE(PG8_SB(1, 0), cB + kstep, voffB); PG8_STAGE(PG8_SA(1, 0), cA + kstep, gc0); PG8_STAGE(PG8_SB(1, 1), cB + hstepB + kstep, voffB);
    PG8_WAIT_V(6); PG8_BAR;
    for (;;) {
        const bool has_next = S.next(ui + 1, nxt);
        const char* nA = has_next ? S.a_ptr(nxt) : cA; const char* nB = has_next ? S.b_ptr(nxt) : cB;
        if constexpr (GATHER) { if (has_next && wid < 4)
            __builtin_amdgcn_global_load_lds((const unsigned*)S.a_row_ptr(nxt, tid), (LAS unsigned*)(gtab + ((ui + 1) & 1) * 256 + wid * 64), 4, 0, 0); }
        for (int t = 0; t < nt; t += 2) {
            const bool last = (t == nt - 2);
            const char* a1 = cA + (size_t)(t + 1) * kstep;
            const char* a2 = last ? nA : cA + (size_t)(t + 2) * kstep; const char* b2 = last ? nB : cB + (size_t)(t + 2) * kstep;
            const char* a3 = a2 + kstep; const char* b3 = b2 + kstep;
            unsigned s0[2], s1[2];
#pragma unroll
            for (int i = 0; i < 2; ++i) { s0[i] = gc0[i]; s1[i] = gc1[i]; }
            if constexpr (GATHER) { if (last && has_next) {
#pragma unroll
                for (int i = 0; i < 2; ++i) { const LAS int* tb = gtab + ((ui + 1) & 1) * 256; int r0 = tb[RA[i]], r1 = tb[HALF + RA[i]]; r0 = r0 < 0 ? 0 : r0; r1 = r1 < 0 ? 0 : r1;
                    s0[i] = (unsigned)r0 * (unsigned)(K * 2) + CA2[i]; s1[i] = (unsigned)r1 * (unsigned)(K * 2) + CA2[i]; } } }
            PG8_LDB(B0, 0, 0); PG8_LDB(B1, 0, 1); PG8_SCHED; PG8_LDA(At, 0, 0); PG8_STAGE(PG8_SA(1, 1), a1 + hstep, gc1);
            PG8_WAIT_V(8); PG8_WAIT_L(0); PG8_BAR; PG8_MMA(0, 0, At, B0); PG8_MMA(0, 1, At, B1); PG8_BAR; PG8_SCHED;
            PG8_LDA(At, 0, 1); PG8_STAGE(PG8_SB(0, 0), b2, voffB); PG8_STAGE(PG8_SB(0, 1), b2 + hstepB, voffB); PG8_STAGE(PG8_SA(0, 0), a2, s0);
            PG8_WAIT_V(8); PG8_WAIT_L(0); PG8_BAR; PG8_MMA(1, 0, At, B0); PG8_MMA(1, 1, At, B1); PG8_BAR; PG8_SCHED;
            PG8_LDB(B0, 1, 0); PG8_LDB(B1, 1, 1); PG8_SCHED; PG8_LDA(At, 1, 0); PG8_STAGE(PG8_SA(0, 1), a2 + hstep, s1);
            PG8_WAIT_V(8); PG8_WAIT_L(0); PG8_BAR; PG8_MMA(0, 0, At, B0); PG8_MMA(0, 1, At, B1); PG8_BAR; PG8_SCHED;
            PG8_LDA(At, 1, 1); PG8_STAGE(PG8_SB(1, 0), b3, voffB); PG8_STAGE(PG8_SB(1, 1), b3 + hstepB, voffB); PG8_STAGE(PG8_SA(1, 0), a3, s0);
            PG8_WAIT_V(8); PG8_WAIT_L(0); PG8_BAR; PG8_MMA(1, 0, At, B0); PG8_MMA(1, 1, At, B1); PG8_BAR; PG8_SCHED;
        }
        if (wr == 0) PG8_BAR;
        E(acc, cur, wr, wc, fr, fq);
        if (!has_next) break;
#pragma unroll
        for (int a = 0; a < 2; ++a)
#pragma unroll
            for (int b = 0; b < 2; ++b)
#pragma unroll
                for (int m = 0; m < 4; ++m)
#pragma unroll
                    for (int n = 0; n < 2; ++n) acc[a][b][m][n] = (f32x4){0.f, 0.f, 0.f, 0.f};
        cur = nxt; cA = nA; cB = nB; ++ui;
        if constexpr (GATHER) {
#pragma unroll
            for (int i = 0; i < 2; ++i) { const LAS int* tb = gtab + (ui & 1) * 256; int r0 = tb[RA[i]], r1 = tb[HALF + RA[i]]; r0 = r0 < 0 ? 0 : r0; r1 = r1 < 0 ? 0 : r1;
                gc0[i] = (unsigned)r0 * (unsigned)(K * 2) + CA2[i]; gc1[i] = (unsigned)r1 * (unsigned)(K * 2) + CA2[i]; }
        }
        if (wr == 1) PG8_BAR;
    }
    PG8_WAIT_V(0);
    PG8_BAR;
#undef PG8_SA
#undef PG8_SB
#undef PG8_STAGE
#undef PG8_LDA
#undef PG8_LDB
#undef PG8_MMA
#undef PG8_WAIT_V
#undef PG8_WAIT_L
#undef PG8_BAR
#undef PG8_SCHED
}
}
constexpr size_t AL256(size_t x) { return (x + 255) & ~(size_t)255; }
constexpr size_t WS_CTL = 0;
constexpr size_t CTL_BAR_W = 4096;
constexpr size_t CTL_QUEUE_B = 32768;
constexpr size_t CTL_MOECNT_B = 40960;
constexpr size_t CTL_SS_B = 65536;
constexpr size_t SS_BYTES = (size_t)MPAD * 8;
constexpr size_t CTL_BYTES = 9437184;
static_assert(CTL_SS_B + 17 * SS_BYTES <= CTL_BYTES, "ctl");
constexpr size_t WS_ROPE = CTL_BYTES;
constexpr size_t WS_ROUTER = WS_ROPE + 524288;
constexpr size_t WS_WMIX = WS_ROUTER + 65536;
constexpr size_t SZ_WIN = (size_t)DINP * DM * 2, SZ_WQ = (size_t)768 * QLORA * 2, SZ_WKV = (size_t)1024 * KVLORA * 2, SZ_WO = (size_t)DM * DM * 2;
constexpr size_t SZ_WMIX = SZ_WIN + SZ_WQ + SZ_WKV + SZ_WO;
constexpr size_t WS_WDENSE = WS_WMIX + DEPTH * SZ_WMIX;
constexpr size_t SZ_DGU = (size_t)2 * DFF * DM * 2, SZ_DD = (size_t)DM * DFF * 2, SZ_DENSE = SZ_DGU + SZ_DD;
constexpr size_t WS_WMOE = WS_WDENSE + 2 * SZ_DENSE;
constexpr size_t SZ_EGU = (size_t)2 * DFFE * DM * 2, SZ_ED = (size_t)DM * DFFE * 2, SZ_EXP = SZ_EGU + SZ_ED;
constexpr size_t WS_H = WS_WMOE + NEXP * SZ_EXP;
constexpr size_t WS_S = WS_H + (size_t)MPAD * DM * 2;
constexpr size_t S_CQ = 0, S_CKV = S_CQ + (size_t)MPAD * QLORA * 2, S_CAT = 0  ;
constexpr size_t S_XP = S_CKV + (size_t)MPAD * 256 * 2, S_MQK = S_XP + (size_t)MPAD * 256 * 2, S_MV = S_MQK + (size_t)MPAD * 512 * 2, S_MO = S_MV + (size_t)MPAD * 256 * 2;
constexpr size_t S_KR = S_MO + (size_t)MPAD * 256 * 2, S_GATES = S_KR + (size_t)MPAD * 32 * 2, S_Q = S_GATES + (size_t)MPAD * 8 * 4;
constexpr size_t S_KN = S_Q + (size_t)MPAD * 768 * 2, S_V = S_KN + (size_t)MPAD * 512 * 2, S_MIX_END = S_V + (size_t)MPAD * 512 * 2;
constexpr size_t S_ACT = 0;
constexpr int MOE_CHUNK = 128, MOE_CHUNK_CAP = 136, MOE_RCAP = 520 * 256, MOE_NASG = MREAL * 2;
constexpr size_t S_ACTE = 0;
constexpr size_t S_Y = S_ACTE + (size_t)MOE_CHUNK_CAP * 256 * DFFE * 2;
constexpr size_t S_STOK = S_Y + (size_t)MOE_NASG * DM * 2;
constexpr size_t S_SSLOT = S_STOK + (size_t)MOE_RCAP * 4, S_SGATE = S_SSLOT + (size_t)MOE_RCAP * 4, S_SRSTD = S_SGATE + (size_t)MOE_RCAP * 4;
constexpr size_t S_AE = S_SRSTD + (size_t)MOE_RCAP * 4;
constexpr size_t S_APOS = S_AE + AL256((size_t)MOE_NASG * 4), S_AGATE = S_APOS + AL256((size_t)MOE_NASG * 4);
constexpr size_t S_MINFO = S_AGATE + AL256((size_t)MOE_NASG * 4);
constexpr size_t S_MOE_END = S_MINFO + 4096;
static_assert(S_MOE_END <= S_MIX_END && (size_t)MPAD * DFF * 2 <= S_MIX_END, "overlays fit the mixer scratch");
constexpr size_t WS_END = WS_S + S_MIX_END;

constexpr int RING_BYTES = 131072;
constexpr int LDS_MISC = RING_BYTES;
constexpr int LDS_BYTES = 147456;

enum { IN_X = 0, IN_META, IN_ATTN_NORM, IN_W_IN, IN_Q_NORM, IN_W_Q_UP, IN_KV_NORM, IN_W_KV_UP, IN_POOL_W, IN_POOL_SCALE, IN_CONV_W, IN_CONV_B, IN_GATE_BIAS, IN_MLSTM_NORM,
       IN_W_OUT, IN_FFN_NORM, IN_DGATE, IN_DUP, IN_DDOWN, IN_ROUTER, IN_MGATE, IN_MUP, IN_MDOWN, IN_FINAL_NORM, N_IN };
struct Args { const float* in[N_IN]; float* out; unsigned char* ws; int ph_lo, ph_hi; };
__device__ __forceinline__ const float* inp(int i) { return ((const float* const __attribute__((address_space(4)))*)__builtin_amdgcn_kernarg_segment_ptr())[i]; }
__device__ __forceinline__ float* outp() { return ((float* const __attribute__((address_space(4)))*)__builtin_amdgcn_kernarg_segment_ptr())[N_IN]; }
__device__ __forceinline__ unsigned char* wsp() { return ((unsigned char* const __attribute__((address_space(4)))*)__builtin_amdgcn_kernarg_segment_ptr())[N_IN + 1]; }
__device__ __forceinline__ int argi(int i) { return ((const int __attribute__((address_space(4)))*)__builtin_amdgcn_kernarg_segment_ptr())[2 * (N_IN + 2) + i]; }

struct Ctx {
    LAS unsigned char* lds; unsigned char* ws; int tid, lane, wave, G, bid;
    __device__ __forceinline__ u64* ss(int idx) const { return (u64*)(ws + CTL_SS_B) + (size_t)idx * MPAD; }
    __device__ __forceinline__ bf16_t* sb(size_t off) const { return (bf16_t*)(ws + WS_S + off); }
};
__device__ __forceinline__ Ctx fresh(const Ctx& X) { Ctx Y = X; asm volatile("" : "+s"(Y.ws)); Y.tid = Y.wave * 64 + lane_id(); asm volatile("" : "+v"(Y.tid)); Y.lane = Y.tid & 63; return Y; }

enum { KIND_ID = 0, KIND_WIN, KIND_QUP, KIND_KVUP, KIND_GU, KIND_WO };
struct Cvt { const float* W; const float* W2; const float* gain; bf16_t* dst; int ldw, K, NP, kind; };
__device__ __forceinline__ int cvt_srccol(int kind, int n, int ldw, bool& second) {
    second = false;
    switch (kind) {
    case KIND_WIN:
        if (n < 1024) return n; if (n < 1280) return 1056 + (n - 1024); if (n < 1792) return 1312 + (n - 1280); if (n < 2048) return 1824 + (n - 1792);
        if (n < 2304) return 2080 + (n - 2048); if (n < 2336) return 1024 + (n - 2304); if (n < 2344) return n; return -1;
    case KIND_QUP: return n < 512 ? (n >> 6) * 96 + (n & 63) : ((n - 512) >> 5) * 96 + 64 + ((n - 512) & 31);
    case KIND_KVUP: return n < 512 ? (n >> 6) * 128 + (n & 63) : ((n - 512) >> 6) * 128 + 64 + ((n - 512) & 63);
    case KIND_GU: { const int t = n >> 8, r = n & 255; if (r >= 128) { second = true; return 128 * t + r - 128; } return 128 * t + r; }
    default: return n < ldw ? n : -1;
    }
}
__device__ __forceinline__ void cvt_item(const Cvt& c, int item, LAS float* scr, int lane) {
    const int nblk = c.NP / 32, kb = item / nblk, nb = item % nblk, k0 = 64 * kb, n0 = 32 * nb;
    if (c.kind == KIND_WO && k0 >= 512 && k0 < 768) return;
    bool second; const int sc = cvt_srccol(c.kind, n0 + (lane & 31), c.ldw, second);
    const float* src = second ? c.W2 : c.W;
#pragma unroll 8
    for (int i = 0; i < 32; ++i) { const int kk = 2 * i + (lane >> 5); float v = 0.f; if (sc >= 0) v = src[(size_t)(k0 + kk) * c.ldw + sc]; if (c.gain) v *= c.gain[k0 + kk]; scr[kk * 33 + (lane & 31)] = v; }
    asm volatile("s_waitcnt lgkmcnt(0)" ::: "memory");
    const int ch = lane & 7;
#pragma unroll
    for (int j = 0; j < 4; ++j) { const int n = (lane >> 3) + 8 * j; const LAS float* s = scr + (8 * ch) * 33 + n;
        u32x4 o; o.x = pk2(s[0 * 33], s[1 * 33]); o.y = pk2(s[2 * 33], s[3 * 33]); o.z = pk2(s[4 * 33], s[5 * 33]); o.w = pk2(s[6 * 33], s[7 * 33]);
        *(u32x4*)(c.dst + (size_t)(n0 + n) * c.K + k0 + 8 * ch) = o; }
    asm volatile("s_waitcnt lgkmcnt(0)" ::: "memory");
}
__device__ __forceinline__ int cvt_nitems(const Cvt& c) { return (c.K / 64) * (c.NP / 32); }
__device__ __forceinline__ void pool_prep_item(const Ctx& X, int l, int item) {
    const int g = item >> 4, nb = item & 15, n = nb * 64 + X.lane;
    const float* pw = inp(IN_POOL_W) + ((size_t)l * 4 + g) * 4096; const float* ps = inp(IN_POOL_SCALE) + l * 256 + g * 64;
    const float* wo = inp(IN_W_OUT) + (size_t)l * DM * DM + (size_t)(512 + 64 * g) * DM + n;
    bf16_t* dst = (bf16_t*)(X.ws + WS_WMIX + (size_t)l * SZ_WMIX + SZ_WIN + SZ_WQ + SZ_WKV) + (size_t)n * DM + 512 + 64 * g;
    float wv[64];
#pragma unroll
    for (int d = 0; d < 64; ++d) wv[d] = ps[d] * wo[(size_t)d * DM];
#pragma unroll 1
    for (int c8 = 0; c8 < 8; ++c8) {
        float o[8];
#pragma unroll
        for (int cc = 0; cc < 8; ++cc) { const float* pr = pw + (c8 * 8 + cc) * 64; float s = 0.f;
#pragma unroll
            for (int d = 0; d < 64; ++d) s += pr[d] * wv[d];
            o[cc] = s; }
        u32x4 w; w.x = pk2(o[0], o[1]); w.y = pk2(o[2], o[3]); w.z = pk2(o[4], o[5]); w.w = pk2(o[6], o[7]);
        *(u32x4*)(dst + c8 * 8) = w;
    }
}
__device__ __forceinline__ float wave_sum(float v) {
#pragma unroll
    for (int o = 1; o < 64; o <<= 1) v += __shfl_xor(v, o);
    return v;
}
__device__ __forceinline__ void moe_convert(const Ctx& X, int lm) {
    const float* fg = inp(IN_FFN_NORM) + (2 * lm + 1) * DM;
    LAS float* scr = (LAS float*)(X.lds + X.wave * 8448);
    const int gw = X.bid * 8 + X.wave, NGW = X.G * 8;
    constexpr int NI_GU = (DM / 64) * (2 * DFFE / 32), NI_D = (DFFE / 64) * (DM / 32), NI_E = NI_GU + NI_D;
    for (int it = gw; it < NEXP * NI_E; it += NGW) {
        const int e = it / NI_E, r = it % NI_E; Cvt c;
        if (r < NI_GU) { c.W = inp(IN_MGATE) + ((size_t)lm * NEXP + e) * DM * DFFE; c.W2 = inp(IN_MUP) + ((size_t)lm * NEXP + e) * DM * DFFE; c.gain = fg;
            c.dst = (bf16_t*)(X.ws + WS_WMOE + (size_t)e * SZ_EXP); c.ldw = DFFE; c.K = DM; c.NP = 2 * DFFE; c.kind = KIND_GU; cvt_item(c, r, scr, X.lane); }
        else { c.W = inp(IN_MDOWN) + ((size_t)lm * NEXP + e) * DFFE * DM; c.W2 = nullptr; c.gain = nullptr;
            c.dst = (bf16_t*)(X.ws + WS_WMOE + (size_t)e * SZ_EXP + SZ_EGU); c.ldw = DM; c.K = DFFE; c.NP = DM; c.kind = KIND_ID; cvt_item(c, r - NI_GU, scr, X.lane); }
    }
}
__device__ __forceinline__ void prologue(const Ctx& X) {
        LAS float* scr = (LAS float*)(X.lds + X.wave * 8448);
    const int gw = X.bid * 8 + X.wave, NGW = X.G * 8;
    constexpr int NI_WIN = (DM / 64) * (DINP / 32), NI_WQ = (QLORA / 64) * (768 / 32), NI_WKV = (KVLORA / 64) * (1024 / 32), NI_WO = (DM / 64) * (DM / 32);
    constexpr int NI_MIX = NI_WIN + NI_WQ + NI_WKV + NI_WO;
    constexpr int NI_DGU = (DM / 64) * (2 * DFF / 32), NI_DD = (DFF / 64) * (DM / 32), NI_DENSE = NI_DGU + NI_DD;
    for (int it = gw; it < DEPTH * NI_MIX + 2 * NI_DENSE; it += NGW) {
        Cvt c; c.W2 = nullptr; c.gain = nullptr;
        if (it < DEPTH * NI_MIX) {
            const int l = it / NI_MIX; int r = it % NI_MIX; unsigned char* wb = X.ws + WS_WMIX + (size_t)l * SZ_WMIX;
            if (r < NI_WIN) { c.W = inp(IN_W_IN) + (size_t)l * DM * DIN; c.gain = inp(IN_ATTN_NORM) + l * DM; c.dst = (bf16_t*)wb; c.ldw = DIN; c.K = DM; c.NP = DINP; c.kind = KIND_WIN; }
            else if ((r -= NI_WIN) < NI_WQ) { c.W = inp(IN_W_Q_UP) + (size_t)l * QLORA * 768; c.gain = inp(IN_Q_NORM) + l * QLORA; c.dst = (bf16_t*)(wb + SZ_WIN); c.ldw = 768; c.K = QLORA; c.NP = 768; c.kind = KIND_QUP; }
            else if ((r -= NI_WQ) < NI_WKV) { c.W = inp(IN_W_KV_UP) + (size_t)l * KVLORA * 1024; c.gain = inp(IN_KV_NORM) + l * KVLORA; c.dst = (bf16_t*)(wb + SZ_WIN + SZ_WQ); c.ldw = 1024; c.K = KVLORA; c.NP = 1024; c.kind = KIND_KVUP; }
            else { r -= NI_WKV; c.W = inp(IN_W_OUT) + (size_t)l * DM * DM; c.dst = (bf16_t*)(wb + SZ_WIN + SZ_WQ + SZ_WKV); c.ldw = DM; c.K = DM; c.NP = DM; c.kind = KIND_WO; }
            cvt_item(c, r, scr, X.lane);
        } else {
            const int q = it - DEPTH * NI_MIX, j = q / NI_DENSE; int r = q % NI_DENSE; unsigned char* wb = X.ws + WS_WDENSE + (size_t)j * SZ_DENSE;
            if (r < NI_DGU) { c.W = inp(IN_DGATE) + (size_t)j * DM * DFF; c.W2 = inp(IN_DUP) + (size_t)j * DM * DFF; c.gain = inp(IN_FFN_NORM) + (2 * j) * DM; c.dst = (bf16_t*)wb; c.ldw = DFF; c.K = DM; c.NP = 2 * DFF; c.kind = KIND_GU; }
            else { r -= NI_DGU; c.W = inp(IN_DDOWN) + (size_t)j * DFF * DM; c.dst = (bf16_t*)(wb + SZ_DGU); c.ldw = DM; c.K = DFF; c.NP = DM; c.kind = KIND_ID; }
            cvt_item(c, r, scr, X.lane);
        }
    }
    for (int it = gw; it < DEPTH * 64; it += NGW) pool_prep_item(X, it >> 6, it & 63);
    { float* rope = (float*)(X.ws + WS_ROPE); const int gt = X.bid * 512 + X.tid, NT = X.G * 512;
      for (int i = gt; i < LTOT * 16; i += NT) { const int pos = i >> 4, j = i & 15; const float inv = powf(10000.0f, -(float)(2 * j) / 32.0f); const float ang = (float)pos * inv;
          rope[pos * 32 + j] = cosf(ang); rope[pos * 32 + 16 + j] = sinf(ang); }
      float* gr = (float*)(X.ws + WS_ROUTER);
      for (int i = gt; i < 2 * DM * NEXP; i += NT) { const int lm = i / (DM * NEXP), k = (i / NEXP) % DM; gr[i] = inp(IN_ROUTER)[i] * inp(IN_FFN_NORM)[(2 * lm + 1) * DM + k]; } }
    { bf16_t* h = (bf16_t*)(X.ws + WS_H); u64* ss0 = X.ss(0);
      for (int row = gw; row < MREAL; row += NGW) {
          const float* src = row < MMAIN ? inp(IN_X) + (size_t)row * DM : inp(IN_META) + (size_t)(row - MMAIN) * DM;
          float s = 0.f;
#pragma unroll
          for (int j = 0; j < 4; ++j) { const f32x4 v = *(const f32x4*)(src + j * 256 + X.lane * 4); u32x2 w; w.x = pk2(v[0], v[1]); w.y = pk2(v[2], v[3]);
              *(u32x2*)(h + (size_t)row * DM + j * 256 + X.lane * 4) = w; s += (bflo(w.x) * bflo(w.x) + bfhi(w.x) * bfhi(w.x)) + (bflo(w.y) * bflo(w.y) + bfhi(w.y) * bfhi(w.y)); }
          s = wave_sum(s); if (X.lane == 0) ss0[row] = ss_fix(s);
      } }
    moe_convert(X, 0);
}
typedef f32x4 AccT[2][2][4][2];
#define EPI_ROWS_BEGIN  _Pragma("unroll") for (int ai = 0; ai < 2; ++ai) _Pragma("unroll") for (int m = 0; m < 4; ++m) { const int row = row0 + ai * 128 + m * 16;
#define EPI_ROWS_END    }
template <class T> __device__ __forceinline__ T ldo(const void* base, unsigned off) { return *(const T*)((const char*)base + off); }
template <class T> __device__ __forceinline__ void sto(void* base, unsigned off, T v) { *(T*)((char*)base + off) = v; }
__device__ __forceinline__ u32x2 bf4(f32x4 v) { u32x2 w; w.x = pk2(v[0], v[1]); w.y = pk2(v[2], v[3]); return w; }
__device__ __forceinline__ u32x4 bf8(f32x4 a, f32x4 b) { u32x4 w; w.x = pk2(a[0], a[1]); w.y = pk2(a[2], a[3]); w.z = pk2(b[0], b[1]); w.w = pk2(b[2], b[3]); return w; }
__device__ __forceinline__ float sq4(f32x4 v) { return (v[0] * v[0] + v[1] * v[1]) + (v[2] * v[2] + v[3] * v[3]); }
__device__ __forceinline__ float red_fq(float s) { s += __shfl_xor(s, 16); s += __shfl_xor(s, 32); return s; }
__device__ __forceinline__ float sqw(unsigned w) { return bflo(w) * bflo(w) + bfhi(w) * bfhi(w); }
#define EPI_LAUNDER int fr = fr_, fq = fq_; asm volatile("" : "+v"(fr), "+v"(fq));
constexpr size_t SSOFF(int idx) { return CTL_SS_B + (size_t)idx * SS_BYTES; }

struct EpiWin {
    static constexpr bool PERM = false;
    unsigned char* ws; int l;
    __device__ __forceinline__ void operator()(const AccT& acc, const pg8::Unit& u, int wr, int wc, int fr_, int fq_) const {
        EPI_LAUNDER
        const int row0 = u.pm * 256 + wr * 64 + fr, pn = u.pn;
        const unsigned char* ssin = ws + CTL_SS_B + (size_t)(4 * l) * SS_BYTES;
        if (pn <= 8) {
            unsigned char* dst; int pitch, coff; unsigned char* ssacc = nullptr;
            if (pn < 3) { dst = ws + WS_S + S_CQ; pitch = QLORA; coff = pn * 256; ssacc = ws + CTL_SS_B + (size_t)(4 * l + 1) * SS_BYTES; }
            else if (pn == 3) { dst = ws + WS_S + S_CKV; pitch = 256; coff = 0; ssacc = ws + CTL_SS_B + (size_t)(4 * l + 2) * SS_BYTES; }
            else if (pn == 4) { dst = ws + WS_S + S_XP; pitch = 256; coff = 0; }
            else if (pn <= 6) { dst = ws + WS_S + S_MQK; pitch = 512; coff = (pn - 5) * 256; }
            else if (pn == 7) { dst = ws + WS_S + S_MV; pitch = 256; coff = 0; }
            else { dst = ws + WS_S + S_MO; pitch = 256; coff = 0; }
            EPI_ROWS_BEGIN
                const float r = rstd_of(ldo<u64>(ssin, (unsigned)row * 8u), 1.0f / DM); float s = 0.f;
                const unsigned ro = ((unsigned)row * (unsigned)pitch + (unsigned)(coff + wc * 32 + fq * 4)) * 2u;
#pragma unroll
                for (int bj = 0; bj < 2; ++bj)
#pragma unroll
                    for (int n = 0; n < 2; ++n) { const f32x4 v = acc[ai][bj][m][n] * r; s += sq4(v); sto<u32x2>(dst, ro + (bj * 128 + n * 16) * 2, bf4(v)); }
                if (ssacc) { s = red_fq(s); if (fq == 0) atomicAdd((u64*)(ssacc + (unsigned)row * 8u), ss_fix(s)); }
            EPI_ROWS_END
        } else {
            if (wc == 0) {
                const unsigned char* rope = ws + WS_ROPE; unsigned char* zkr = ws + WS_S + S_KR;
                EPI_ROWS_BEGIN
                    const float r = rstd_of(ldo<u64>(ssin, (unsigned)row * 8u), 1.0f / DM);
                    const f32x4 x1 = acc[ai][0][m][0] * r, x2 = acc[ai][0][m][1] * r;
                    const unsigned co = ((unsigned)rowpos(row) * 32u + fq * 4) * 4u;
                    const f32x4 c = ldo<f32x4>(rope, co), sn = ldo<f32x4>(rope, co + 64);
                    sto<u32x2>(zkr, ((unsigned)row * 32u + fq * 4) * 2u, bf4(x1 * c - x2 * sn));
                    sto<u32x2>(zkr, ((unsigned)row * 32u + 16 + fq * 4) * 2u, bf4(x2 * c + x1 * sn));
                EPI_ROWS_END
            } else if (wc == 1) {
                if (fq < 2) {
                    const f32x4 gb = *(const f32x4*)(inp(IN_GATE_BIAS) + l * 8 + fq * 4); unsigned char* gates = ws + WS_S + S_GATES;
                    EPI_ROWS_BEGIN
                        const float r = rstd_of(ldo<u64>(ssin, (unsigned)row * 8u), 1.0f / DM);
                        sto<f32x4>(gates, ((unsigned)row * 8u + fq * 4) * 4u, acc[ai][0][m][0] * r + gb);
                    EPI_ROWS_END
                }
            }
        }
    }
};
struct EpiQ {
    static constexpr bool PERM = false;
    unsigned char* ws; int l;
    __device__ __forceinline__ void operator()(const AccT& acc, const pg8::Unit& u, int wr, int wc, int fr_, int fq_) const {
        EPI_LAUNDER
        const int row0 = u.pm * 256 + wr * 64 + fr, pn = u.pn;
        const unsigned char* ssin = ws + CTL_SS_B + (size_t)(4 * l + 1) * SS_BYTES; unsigned char* q = ws + WS_S + S_Q; const unsigned char* rope = ws + WS_ROPE;
        EPI_ROWS_BEGIN
            const float r = rstd_of(ldo<u64>(ssin, (unsigned)row * 8u), 1.0f / QLORA) * QSCALE;
            const unsigned ro = ((unsigned)row * 768u + (unsigned)(pn * 256 + wc * 32 + fq * 4)) * 2u;
            if (pn < 2) {
#pragma unroll
                for (int bj = 0; bj < 2; ++bj)
#pragma unroll
                    for (int n = 0; n < 2; ++n) sto<u32x2>(q, ro + (bj * 128 + n * 16) * 2, bf4(acc[ai][bj][m][n] * r));
            } else {
                const unsigned co = ((unsigned)rowpos(row) * 32u + fq * 4) * 4u;
                const f32x4 c = ldo<f32x4>(rope, co), sn = ldo<f32x4>(rope, co + 64);
#pragma unroll
                for (int bj = 0; bj < 2; ++bj) { const f32x4 x1 = acc[ai][bj][m][0] * r, x2 = acc[ai][bj][m][1] * r;
                    sto<u32x2>(q, ro + bj * 256, bf4(x1 * c - x2 * sn)); sto<u32x2>(q, ro + bj * 256 + 32, bf4(x2 * c + x1 * sn)); }
            }
        EPI_ROWS_END
    }
};
struct EpiKV {
    static constexpr bool PERM = true;
    unsigned char* ws; int l;
    __device__ __forceinline__ void operator()(const AccT& acc, const pg8::Unit& u, int wr, int wc, int fr_, int fq_) const {
        EPI_LAUNDER
        const int row0 = u.pm * 256 + wr * 64 + fr, pn = u.pn;
        const unsigned char* ssin = ws + CTL_SS_B + (size_t)(4 * l + 2) * SS_BYTES;
        unsigned char* dst = ws + WS_S + ((pn < 2) ? S_KN : S_V); const int coff = (pn & 1) * 256 + wc * 32 + fq * 8;
        EPI_ROWS_BEGIN
            const float r = rstd_of(ldo<u64>(ssin, (unsigned)row * 8u), 1.0f / KVLORA);
            const unsigned ro = ((unsigned)row * 512u + (unsigned)coff) * 2u;
#pragma unroll
            for (int bj = 0; bj < 2; ++bj) sto<u32x4>(dst, ro + bj * 256, bf8(acc[ai][bj][m][0] * r, acc[ai][bj][m][1] * r));
        EPI_ROWS_END
    }
};
struct EpiRes {
    static constexpr bool PERM = true;
    unsigned char* ws; int ssidx;
    __device__ __forceinline__ void operator()(const AccT& acc, const pg8::Unit& u, int wr, int wc, int fr_, int fq_) const {
        EPI_LAUNDER
        const int row0 = u.pm * 256 + wr * 64 + fr, pn = u.pn;
        unsigned char* h = ws + WS_H; unsigned char* ssout = ws + CTL_SS_B + (size_t)ssidx * SS_BYTES;
        EPI_ROWS_BEGIN
            const unsigned ro = ((unsigned)row * (unsigned)DM + (unsigned)(pn * 256 + wc * 32 + fq * 8)) * 2u; float s = 0.f;
#pragma unroll
            for (int bj = 0; bj < 2; ++bj) {
                const u32x4 o = ldo<u32x4>(h, ro + bj * 256);
                const f32x4 a = acc[ai][bj][m][0], b = acc[ai][bj][m][1];
                u32x4 w;
                w.x = pk2(bflo(o.x) + a[0], bfhi(o.x) + a[1]); w.y = pk2(bflo(o.y) + a[2], bfhi(o.y) + a[3]);
                w.z = pk2(bflo(o.z) + b[0], bfhi(o.z) + b[1]); w.w = pk2(bflo(o.w) + b[2], bfhi(o.w) + b[3]);
                sto<u32x4>(h, ro + bj * 256, w);
                s += (sqw(w.x) + sqw(w.y)) + (sqw(w.z) + sqw(w.w));
            }
            s = red_fq(s); if (fq == 0) atomicAdd((u64*)(ssout + (unsigned)row * 8u), ss_fix(s));
        EPI_ROWS_END
    }
};
struct EpiGU {
    static constexpr bool PERM = true;
    unsigned char* ws; int ssidx;
    __device__ __forceinline__ void operator()(const AccT& acc, const pg8::Unit& u, int wr, int wc, int fr_, int fq_) const {
        EPI_LAUNDER
        const int row0 = u.pm * 256 + wr * 64 + fr, pn = u.pn;
        const unsigned char* ssin = ws + CTL_SS_B + (size_t)ssidx * SS_BYTES; unsigned char* act = ws + WS_S + S_ACT;
        EPI_ROWS_BEGIN
            const float r = rstd_of(ldo<u64>(ssin, (unsigned)row * 8u), 1.0f / DM);
            f32x4 o[2];
#pragma unroll
            for (int n = 0; n < 2; ++n) { const f32x4 g = acc[ai][0][m][n] * r, uu = acc[ai][1][m][n] * r;
#pragma unroll
                for (int e = 0; e < 4; ++e) o[n][e] = siluf_(g[e]) * uu[e]; }
            sto<u32x4>(act, ((unsigned)row * (unsigned)DFF + (unsigned)(pn * 128 + wc * 32 + fq * 8)) * 2u, bf8(o[0], o[1]));
        EPI_ROWS_END
    }
};
struct EpiMoeGU {
    static constexpr bool PERM = true;
    unsigned char* ws; int blk0;
    __device__ __forceinline__ void operator()(const AccT& acc, const pg8::Unit& u, int wr, int wc, int fr_, int fq_) const {
        EPI_LAUNDER
        const int row0 = wr * 64 + fr, pn = u.pn;
        const unsigned char* srstd = ws + WS_S + S_SRSTD; unsigned char* act = ws + WS_S + S_ACTE;
        EPI_ROWS_BEGIN
            const float r = ldo<float>(srstd, ((unsigned)u.pm * 256u + row) * 4u);
            f32x4 o[2];
#pragma unroll
            for (int n = 0; n < 2; ++n) { const f32x4 g = acc[ai][0][m][n] * r, uu = acc[ai][1][m][n] * r;
#pragma unroll
                for (int e = 0; e < 4; ++e) o[n][e] = siluf_(g[e]) * uu[e]; }
            sto<u32x4>(act, (((unsigned)(u.pm - blk0) * 256u + row) * (unsigned)DFFE + (unsigned)(pn * 128 + wc * 32 + fq * 8)) * 2u, bf8(o[0], o[1]));
        EPI_ROWS_END
    }
};
struct EpiMoeDown {
    static constexpr bool PERM = true;
    unsigned char* ws;
    __device__ __forceinline__ void operator()(const AccT& acc, const pg8::Unit& u, int wr, int wc, int fr_, int fq_) const {
        EPI_LAUNDER
        const int row0 = wr * 64 + fr, pn = u.pn;
        const unsigned char* sslot = ws + WS_S + S_SSLOT; const unsigned char* sgate = ws + WS_S + S_SGATE; unsigned char* y = ws + WS_S + S_Y;
        EPI_ROWS_BEGIN
            const unsigned so = ((unsigned)u.pm * 256u + row) * 4u;
            const int slot = ldo<int>(sslot, so); const float g = ldo<float>(sgate, so);
            if (slot >= 0) {
                const unsigned ro = ((unsigned)slot * (unsigned)DM + (unsigned)(pn * 256 + wc * 32 + fq * 8)) * 2u;
#pragma unroll
                for (int bj = 0; bj < 2; ++bj) sto<u32x4>(y, ro + bj * 256, bf8(acc[ai][bj][m][0] * g, acc[ai][bj][m][1] * g));
            }
        EPI_ROWS_END
    }
};
struct MixP { const bf16_t *q, *kn, *v, *kr, *xp, *mqk, *mv, *mo; const float* gates; bf16_t* cat; const float *conv_w, *conv_b, *mnorm; };
#define MFMA32(a, b, c) __builtin_amdgcn_mfma_f32_32x32x16_bf16((a), (b), (c), 0, 0, 0)
__device__ __forceinline__ int crow(int r, int hi) { return (r & 3) + 8 * (r >> 2) + 4 * hi; }
__device__ __forceinline__ float swap_max(float m) { auto rr = __builtin_amdgcn_permlane32_swap(__float_as_uint(m), __float_as_uint(m), false, false); return fmaxf(__uint_as_float(rr[0]), __uint_as_float(rr[1])); }
__device__ __forceinline__ float swap_sum(float m) { auto rr = __builtin_amdgcn_permlane32_swap(__float_as_uint(m), __float_as_uint(m), false, false); return __uint_as_float(rr[0]) + __uint_as_float(rr[1]); }
__device__ __forceinline__ s16x4 vtr(const LAS char* p) { typedef short v4i16_t __attribute__((ext_vector_type(4))); return __builtin_bit_cast(s16x4, __builtin_amdgcn_ds_read_tr16_b64_v4i16((LAS v4i16_t*)p)); }

constexpr int AK_PITCH = 208, AK_BYTES = 64 * AK_PITCH, A_K0 = 0, A_V0 = 2 * AK_BYTES, A_WS = A_V0 + 2 * 8192, A_OST = A_WS + 8 * 256, A_END = A_OST + 8 * 4096;
static_assert(A_END <= RING_BYTES, "attention LDS");

__device__ __forceinline__ void attn_ld(const MixP& P, int b, int hd, int j, int tid, u32x4& k0, u32x4& k1, u32x4& v0) {
    const int rowbase = (j == 0) ? MMAIN : b * SEQ + 64 * (j - 1), valid = (j == 0) ? 16 : 64;
    const u32x4 z = {0u, 0u, 0u, 0u}; k0 = z; k1 = z; v0 = z;
    { const int key = tid / 12, ch = tid % 12;
      if (key < valid) k0 = ch < 8 ? *(const u32x4*)(P.kn + (size_t)(rowbase + key) * 512 + hd * 64 + ch * 8) : *(const u32x4*)(P.kr + (size_t)(rowbase + key) * 32 + (ch - 8) * 8); }
    if (tid < 256) { const int id = tid + 512, key = id / 12, ch = id % 12;
      if (key < valid) k1 = ch < 8 ? *(const u32x4*)(P.kn + (size_t)(rowbase + key) * 512 + hd * 64 + ch * 8) : *(const u32x4*)(P.kr + (size_t)(rowbase + key) * 32 + (ch - 8) * 8); }
    { const int key = tid >> 3, ch = tid & 7; if (key < valid) v0 = *(const u32x4*)(P.v + (size_t)(rowbase + key) * 512 + hd * 64 + ch * 8); }
}
__device__ __forceinline__ void attn_st(LAS unsigned char* lds, int buf, int tid, const u32x4& k0, const u32x4& k1, const u32x4& v0) {
    LAS unsigned char* kb = lds + A_K0 + buf * AK_BYTES; LAS unsigned char* vb = lds + A_V0 + buf * 8192;
    { const int key = tid / 12, ch = tid % 12; *(LAS u32x4*)(kb + key * AK_PITCH + ch * 16) = k0; }
    if (tid < 256) { const int id = tid + 512, key = id / 12, ch = id % 12; *(LAS u32x4*)(kb + key * AK_PITCH + ch * 16) = k1; }
    { const int key = tid >> 3, ch = tid & 7; *(LAS u32x4*)(vb + (ch >> 2) * 4096 + (key >> 4) * 1024 + (key & 15) * 64 + (ch & 3) * 16) = v0; }
}
__device__ __forceinline__ void attn_unit(LAS unsigned char* lds, const MixP& P, int tid_, int b, int hd, int qt) {
    int tid = tid_; asm volatile("" : "+v"(tid));
    const int lane = tid & 63, wid = __builtin_amdgcn_readfirstlane(tid >> 6), r32 = lane & 31, hh = lane >> 5;
    const bool meta = qt < 0;
    const int qbase = meta ? MMAIN + wid * 32 : b * SEQ + qt * 256 + wid * 32;
    const int cw = meta ? 0 : qt * 4 + (wid >> 1) + 1, NT = meta ? 1 : qt * 4 + 5;
    const bool active = !meta || wid == 0;
    bf16x8 qf[6];
    { const bf16_t* qr = P.q + (size_t)(qbase + r32) * 768;
#pragma unroll
      for (int d0 = 0; d0 < 4; ++d0) qf[d0] = *(const bf16x8*)(qr + hd * 64 + d0 * 16 + hh * 8);
#pragma unroll
      for (int d0 = 0; d0 < 2; ++d0) qf[4 + d0] = *(const bf16x8*)(qr + 512 + hd * 32 + d0 * 16 + hh * 8); }
    f32x16 o0, o1;
#pragma unroll
    for (int i = 0; i < 16; ++i) { o0[i] = 0.f; o1[i] = 0.f; }
    float m_run = -1e30f, l_run = 0.f;
    LAS float* wsf = (LAS float*)(lds + A_WS + wid * 256);
    u32x4 k0, k1, v0;
    attn_ld(P, b, hd, 0, tid, k0, k1, v0); attn_st(lds, 0, tid, k0, k1, v0);
    __syncthreads();
    for (int j = 0; j < NT; ++j) {
        if (j + 1 < NT) attn_ld(P, b, hd, j + 1, tid, k0, k1, v0);
        if (active && j <= cw) {
            const LAS unsigned char* Kb = lds + A_K0 + (j & 1) * AK_BYTES; const LAS char* Vb = (const LAS char*)(lds + A_V0 + (j & 1) * 8192);
            f32x16 p0, p1;
#pragma unroll
            for (int i = 0; i < 16; ++i) { p0[i] = 0.f; p1[i] = 0.f; }
#pragma unroll
            for (int d0 = 0; d0 < 6; ++d0) {
                const bf16x8 a0 = *(const LAS bf16x8*)(Kb + r32 * AK_PITCH + (2 * d0 + hh) * 16);
                const bf16x8 a1 = *(const LAS bf16x8*)(Kb + (32 + r32) * AK_PITCH + (2 * d0 + hh) * 16);
                p0 = MFMA32(a0, qf[d0], p0); p1 = MFMA32(a1, qf[d0], p1);
            }
            if (j == 0) {
#pragma unroll
                for (int i = 0; i < 16; ++i) { if (i >= 8) p0[i] = -1e30f; p1[i] = -1e30f; }
            }
            float mx = fmaxf(p0[0], p1[0]);
#pragma unroll
            for (int i = 1; i < 16; ++i) mx = fmaxf(mx, fmaxf(p0[i], p1[i]));
            mx = swap_max(mx);
            if (__any(mx > m_run)) {
                const float m_new = fmaxf(m_run, mx), sc = fexp2(m_run - m_new);
                l_run *= sc; m_run = m_new;
                if (hh == 0) wsf[r32] = sc;
#pragma unroll
                for (int i = 0; i < 16; ++i) { const float f = wsf[crow(i, hh)]; o0[i] *= f; o1[i] *= f; }
            }
            float ls = 0.f;
#pragma unroll
            for (int i = 0; i < 16; ++i) { p0[i] = fexp2(p0[i] - m_run); p1[i] = fexp2(p1[i] - m_run); ls += p0[i] + p1[i]; }
            l_run += ls;
            const int q4 = (lane & 15) >> 2, p4 = lane & 3, blk = (lane >> 4) & 1;
            const LAS char* vp = Vb + (4 * hh + q4) * 64 + blk * 32 + p4 * 8;
#pragma unroll
            for (int s = 0; s < 4; ++s) {
                u32x4 pw;
                if (s < 2) { pw.x = pk2(p0[8 * s], p0[8 * s + 1]); pw.y = pk2(p0[8 * s + 2], p0[8 * s + 3]); pw.z = pk2(p0[8 * s + 4], p0[8 * s + 5]); pw.w = pk2(p0[8 * s + 6], p0[8 * s + 7]); }
                else { const int t = s - 2; pw.x = pk2(p1[8 * t], p1[8 * t + 1]); pw.y = pk2(p1[8 * t + 2], p1[8 * t + 3]); pw.z = pk2(p1[8 * t + 4], p1[8 * t + 5]); pw.w = pk2(p1[8 * t + 6], p1[8 * t + 7]); }
                const bf16x8 pa = __builtin_bit_cast(bf16x8, pw);
                { const s16x4 lo = vtr(vp + s * 1024), hi = vtr(vp + s * 1024 + 512);
                  const bf16x8 vf = {lo[0], lo[1], lo[2], lo[3], hi[0], hi[1], hi[2], hi[3]}; o0 = MFMA32(pa, vf, o0); }
                { const s16x4 lo = vtr(vp + 4096 + s * 1024), hi = vtr(vp + 4096 + s * 1024 + 512);
                  const bf16x8 vf = {lo[0], lo[1], lo[2], lo[3], hi[0], hi[1], hi[2], hi[3]}; o1 = MFMA32(pa, vf, o1); }
            }
        }
        if (j + 1 < NT) attn_st(lds, (j + 1) & 1, tid, k0, k1, v0);
        __syncthreads();
    }
    if (active) {
        const float lt = swap_sum(l_run);
        if (hh == 0) wsf[32 + r32] = lt;
        LAS bf16_t* stg = (LAS bf16_t*)(lds + A_OST + wid * 4096);
#pragma unroll
        for (int i = 0; i < 16; ++i) { const int orow = crow(i, hh); const float rl = frcp(wsf[32 + orow]);
            stg[orow * 64 + r32] = (bf16_t)f2bf(o0[i] * rl); stg[orow * 64 + 32 + r32] = (bf16_t)f2bf(o1[i] * rl); }
        const int nvalid = meta ? 16 : 32;
#pragma unroll
        for (int it = 0; it < 4; ++it) { const int row = it * 8 + (lane >> 3), ch = lane & 7; const u32x4 val = *(const LAS u32x4*)(stg + row * 64 + ch * 8);
            if (row < nvalid) *(u32x4*)(P.cat + (size_t)(qbase + row) * DM + hd * 64 + ch * 8) = val; }
    }
    __syncthreads();
}

__device__ __forceinline__ void pool_unit(const MixP& P, int tid_, int b, int grp) {
    int tid = tid_; asm volatile("" : "+v"(tid));
    const int t = tid >> 3, seg = tid & 7, g = seg >> 1, w = 2 << g;
    const int pos = (grp == 0) ? t : NMETA + 64 * (grp - 1) + t;
    if (grp == 0 && t >= NMETA) return;
    const int row = seqrow(b, pos), cnt = (pos + 1 < w) ? pos + 1 : w; const float inv = 1.0f / (float)cnt;
#pragma unroll 1
    for (int pc = 0; pc < 4; ++pc) {
        const int ch = seg * 32 + pc * 8; float a[8];
#pragma unroll
        for (int e = 0; e < 8; ++e) a[e] = 0.f;
        u32x4 self = {0u, 0u, 0u, 0u};
        for (int jj = 0; jj < cnt; ++jj) { const u32x4 x = *(const u32x4*)(P.xp + (size_t)seqrow(b, pos - jj) * 256 + ch); if (jj == 0) self = x;
            a[0] += bflo(x.x); a[1] += bfhi(x.x); a[2] += bflo(x.y); a[3] += bfhi(x.y); a[4] += bflo(x.z); a[5] += bfhi(x.z); a[6] += bflo(x.w); a[7] += bfhi(x.w); }
        u32x4 o; o.x = pk2(a[0] * inv - bflo(self.x), a[1] * inv - bfhi(self.x)); o.y = pk2(a[2] * inv - bflo(self.y), a[3] * inv - bfhi(self.y));
        o.z = pk2(a[4] * inv - bflo(self.z), a[5] * inv - bfhi(self.z)); o.w = pk2(a[6] * inv - bflo(self.w), a[7] * inv - bfhi(self.w));
        *(u32x4*)(P.cat + (size_t)row * DM + 512 + ch) = o;
    }
}

constexpr int ML_Q = 0, ML_K = ML_Q + 16 * 64 * 4, ML_V = ML_K + 16 * 65 * 4, ML_MO = ML_V + 16 * 64 * 4, ML_SX = ML_MO + 16 * 64 * 4, ML_H = ML_SX + 16 * 16 * 4, ML_N = ML_H + 16 * 64 * 4,
              ML_LF = ML_N + 256, ML_LI = ML_LF + 64, ML_NQ = ML_LI + 64, ML_WG = ML_NQ + 64, ML_SC = ML_WG + 64, ML_END = ML_SC + 64;
__device__ __forceinline__ float log_sigmoid_(float x) { return fminf(x, 0.f) - log1pf(__expf(-fabsf(x))); }
__device__ __forceinline__ void mlstm_unit(LAS unsigned char* lds, const MixP& P, int tid_, int b, int hd) {
    int tid = tid_; asm volatile("" : "+v"(tid));
    const int v = tid >> 3, ksg = tid & 7;
    LAS float* qs = (LAS float*)(lds + ML_Q); LAS float* ks = (LAS float*)(lds + ML_K); LAS float* vs = (LAS float*)(lds + ML_V); LAS float* mos = (LAS float*)(lds + ML_MO);
    LAS float* Sx = (LAS float*)(lds + ML_SX); LAS float* hb = (LAS float*)(lds + ML_H); LAS float* nst = (LAS float*)(lds + ML_N);
    LAS float* lf = (LAS float*)(lds + ML_LF); LAS float* li = (LAS float*)(lds + ML_LI); LAS float* nq = (LAS float*)(lds + ML_NQ); LAS float* wg = (LAS float*)(lds + ML_WG); LAS float* sc = (LAS float*)(lds + ML_SC);
    float C[8];
#pragma unroll
    for (int j = 0; j < 8; ++j) C[j] = 0.f;
    if (tid < 64) nst[tid] = 0.f;
    float m = 0.f;
    const int ct = tid >> 5, cc = (tid & 31) * 4;
    const int gcol = (cc < 64) ? hd * 64 + cc : 256 + hd * 64 + (cc - 64);
    f32x4 cw4[4], cb4;
#pragma unroll
    for (int j = 0; j < 4; ++j) cw4[j] = *(const f32x4*)(P.conv_w + j * 512 + gcol);
    cb4 = *(const f32x4*)(P.conv_b + gcol);
    __syncthreads();
    for (int c = 0; c <= 128; ++c) {
        const int pos0 = 16 * c;
        { const int pos = pos0 + ct; f32x4 a = cb4;
#pragma unroll
          for (int j = 0; j < 4; ++j) { const int pp = pos - 3 + j; if (pp >= 0) { const u32x2 x = *(const u32x2*)(P.mqk + (size_t)seqrow(b, pp) * 512 + gcol);
              a[0] += cw4[j][0] * bflo(x.x); a[1] += cw4[j][1] * bfhi(x.x); a[2] += cw4[j][2] * bflo(x.y); a[3] += cw4[j][3] * bfhi(x.y); } }
#pragma unroll
          for (int e = 0; e < 4; ++e) a[e] = siluf_(a[e]);
          if (cc < 64) { *(LAS f32x4*)(qs + ct * 64 + cc) = a; } else { ks[ct * 65 + cc - 64] = a[0] * 0.125f; ks[ct * 65 + cc - 63] = a[1] * 0.125f; ks[ct * 65 + cc - 62] = a[2] * 0.125f; ks[ct * 65 + cc - 61] = a[3] * 0.125f; }
          const int row = seqrow(b, pos), c2 = (tid & 31) * 2;
          const unsigned xv = *(const unsigned*)(P.mv + (size_t)row * 256 + hd * 64 + c2); vs[ct * 64 + c2] = bflo(xv); vs[ct * 64 + c2 + 1] = bfhi(xv);
          const unsigned xo = *(const unsigned*)(P.mo + (size_t)row * 256 + hd * 64 + c2); mos[ct * 64 + c2] = bflo(xo); mos[ct * 64 + c2 + 1] = bfhi(xo);
          if (tid < 16) { const int r2 = seqrow(b, pos0 + tid); li[tid] = P.gates[(size_t)r2 * 8 + hd]; lf[tid] = log_sigmoid_(P.gates[(size_t)r2 * 8 + 4 + hd]); } }
        __syncthreads();
        if (tid < 256) { const int t = tid >> 4, s = tid & 15;
            float bt = 0.f, bs = 0.f, mx = -1e30f, run = 0.f;
            for (int r = 0; r <= t; ++r) { run += lf[r]; if (r == s) bs = run; }
            bt = run; run = 0.f;
            for (int r = 0; r <= t; ++r) { run += lf[r]; mx = fmaxf(mx, bt - run + li[r]); }
            const float mt = fmaxf(bt + m, mx);
            float dot = 0.f;
#pragma unroll 8
            for (int d = 0; d < 64; ++d) dot += qs[t * 64 + d] * ks[s * 65 + d];
            Sx[t * 16 + s] = (s <= t) ? dot * __expf(bt - bs + li[s] - mt) : 0.f;
            if (s == 0) { sc[t] = mt; sc[16 + t] = __expf(bt + m - mt); }
        } else if (tid < 272) { const int t = tid - 256; float d = 0.f;
#pragma unroll 8
            for (int k = 0; k < 64; ++k) d += nst[k] * qs[t * 64 + k];
            nq[t] = d;
        } else if (tid < 288) { const int s = tid - 272; float bl = 0.f, bs = 0.f, mx = -1e30f, run = 0.f;
            for (int r = 0; r < 16; ++r) { run += lf[r]; if (r == s) bs = run; }
            bl = run; run = 0.f;
            for (int r = 0; r < 16; ++r) { run += lf[r]; mx = fmaxf(mx, bl - run + li[r]); }
            const float mn = fmaxf(bl + m, mx);
            wg[s] = __expf(bl - bs + li[s] - mn);
            if (s == 0) { sc[32] = mn; sc[33] = __expf(bl + m - mn); }
        }
        __syncthreads();
        { float sel0 = 0.f, sel1 = 0.f;
#pragma unroll
          for (int t = 0; t < 16; ++t) { float s = 0.f;
#pragma unroll
              for (int j = 0; j < 8; ++j) s += C[j] * qs[t * 64 + ksg * 8 + j];
              s += __shfl_xor(s, 1); s += __shfl_xor(s, 2); s += __shfl_xor(s, 4); if (t == ksg) sel0 = s; if (t == ksg + 8) sel1 = s; }
#pragma unroll
          for (int tt = 0; tt < 2; ++tt) { const int t = ksg + 8 * tt; float num = 0.f, den = 0.f;
#pragma unroll
              for (int s = 0; s < 16; ++s) { const float x = Sx[t * 16 + s]; num += x * vs[s * 64 + v]; den += x; }
              const float dec = sc[16 + t], mt = sc[t];
              num += dec * (tt == 0 ? sel0 : sel1); den += dec * nq[t];
              hb[t * 64 + v] = num / fmaxf(fabsf(den), __expf(-mt)); }
          const float cd = sc[33];
          float vw[16];
#pragma unroll
          for (int s = 0; s < 16; ++s) vw[s] = vs[s * 64 + v] * wg[s];
#pragma unroll
          for (int j = 0; j < 8; ++j) { float a = cd * C[j];
#pragma unroll
              for (int s = 0; s < 16; ++s) a += vw[s] * ks[s * 65 + ksg * 8 + j];
              C[j] = a; }
          m = sc[32]; }
        __syncthreads();
        if (tid < 64) { float a = sc[33] * nst[tid];
#pragma unroll
            for (int s = 0; s < 16; ++s) a += wg[s] * ks[s * 65 + tid];
            nst[tid] = a; }
        { const int t = tid >> 5, vp = (tid & 31) * 2; const float h0 = hb[t * 64 + vp], h1 = hb[t * 64 + vp + 1];
          float s = h0 * h0 + h1 * h1;
          s += __shfl_xor(s, 1); s += __shfl_xor(s, 2); s += __shfl_xor(s, 4); s += __shfl_xor(s, 8); s += __shfl_xor(s, 16);
          const float r = rsqrtf(s * (1.0f / 64.0f) + EPS);
          const float y0 = h0 * r * P.mnorm[hd * 64 + vp] * sigmoidf_(mos[t * 64 + vp]), y1 = h1 * r * P.mnorm[hd * 64 + vp + 1] * sigmoidf_(mos[t * 64 + vp + 1]);
          if (c > 0 || b == 0) *(unsigned*)(P.cat + (size_t)seqrow(b, pos0 + t) * DM + 768 + hd * 64 + vp) = pk2(y0, y1); }
        __syncthreads();
    }
}
constexpr int R1_GR = 0, R1_E = 32768, R1_LP = R1_E + 2048, R1_G = R1_LP + 2048, R1_CNT = R1_G + 2048, R1_BASE = R1_CNT + 64, R1_END = R1_BASE + 64;
__device__ __forceinline__ void moe_route(const Ctx& X, int l) {
    const int lm = l >> 1, tid = X.tid, lane = X.lane, wid = X.wave;
    LAS float* gr = (LAS float*)(X.lds + R1_GR); LAS int* le = (LAS int*)(X.lds + R1_E); LAS int* lp = (LAS int*)(X.lds + R1_LP); LAS float* lg = (LAS float*)(X.lds + R1_G);
    LAS unsigned* lcnt = (LAS unsigned*)(X.lds + R1_CNT); LAS unsigned* lbase = (LAS unsigned*)(X.lds + R1_BASE);
    const float* grg = (const float*)(X.ws + WS_ROUTER) + (size_t)lm * DM * NEXP;
    for (int i = tid; i < DM * NEXP; i += 512) gr[i] = grg[i];
    { int* stok = (int*)(X.ws + WS_S + S_STOK); int* sslot = (int*)(X.ws + WS_S + S_SSLOT); float* sgate = (float*)(X.ws + WS_S + S_SGATE); float* srstd = (float*)(X.ws + WS_S + S_SRSTD);
      for (int i = X.bid * 512 + tid; i < MOE_RCAP; i += X.G * 512) { stok[i] = 0; sslot[i] = -1; sgate[i] = 0.f; srstd[i] = 0.f; } }
    const bf16_t* h = (const bf16_t*)(X.ws + WS_H); const u64* ssf = X.ss(4 * l + 3);
    unsigned* gcnt = (unsigned*)(X.ws + CTL_MOECNT_B) + (size_t)lm * 8 * 64;
    int* ae = (int*)(X.ws + WS_S + S_AE); int* apos = (int*)(X.ws + WS_S + S_APOS); float* agate = (float*)(X.ws + WS_S + S_AGATE);
    for (int p = X.bid; p < NPANEL; p += X.G) {
        if (tid < 8) lcnt[tid] = 0u;
        __syncthreads();
        for (int rr = 0; rr < 32; ++rr) {
            const int r = wid * 32 + rr, row = p * 256 + r;
            if (row >= MREAL) break;
            const u32x4 x0 = *(const u32x4*)(h + (size_t)row * DM + lane * 16), x1 = *(const u32x4*)(h + (size_t)row * DM + lane * 16 + 8);
            float xv[16] = {bflo(x0.x), bfhi(x0.x), bflo(x0.y), bfhi(x0.y), bflo(x0.z), bfhi(x0.z), bflo(x0.w), bfhi(x0.w), bflo(x1.x), bfhi(x1.x), bflo(x1.y), bfhi(x1.y), bflo(x1.z), bfhi(x1.z), bflo(x1.w), bfhi(x1.w)};
            float lg8[8];
#pragma unroll
            for (int e = 0; e < 8; ++e) lg8[e] = 0.f;
#pragma unroll
            for (int k = 0; k < 16; ++k) { const f32x4 w0 = *(const LAS f32x4*)(gr + (lane * 16 + k) * 8), w1 = *(const LAS f32x4*)(gr + (lane * 16 + k) * 8 + 4);
                lg8[0] += xv[k] * w0[0]; lg8[1] += xv[k] * w0[1]; lg8[2] += xv[k] * w0[2]; lg8[3] += xv[k] * w0[3]; lg8[4] += xv[k] * w1[0]; lg8[5] += xv[k] * w1[1]; lg8[6] += xv[k] * w1[2]; lg8[7] += xv[k] * w1[3]; }
            const float rs = rstd_of(ssf[row], 1.0f / DM);
#pragma unroll
            for (int e = 0; e < 8; ++e) lg8[e] = wave_sum(lg8[e]) * rs;
            int i0 = 0; float v0 = lg8[0];
#pragma unroll
            for (int e = 1; e < 8; ++e) if (lg8[e] > v0) { v0 = lg8[e]; i0 = e; }
            int i1 = -1; float v1 = -3.0e38f;
#pragma unroll
            for (int e = 0; e < 8; ++e) if (e != i0 && lg8[e] > v1) { v1 = lg8[e]; i1 = e; }
            if (i1 < 0) { i1 = (i0 == 0) ? 1 : 0; v1 = v0; }
            if (lane == 0) { const float ex = __expf(v1 - v0), g0 = 1.0f / (1.0f + ex);
                le[r * 2] = i0; le[r * 2 + 1] = i1; lg[r * 2] = g0; lg[r * 2 + 1] = ex * g0;
                lp[r * 2] = (int)__hip_atomic_fetch_add(&lcnt[i0], 1u, __ATOMIC_RELAXED, __HIP_MEMORY_SCOPE_WORKGROUP); lp[r * 2 + 1] = (int)__hip_atomic_fetch_add(&lcnt[i1], 1u, __ATOMIC_RELAXED, __HIP_MEMORY_SCOPE_WORKGROUP); }
        }
        __syncthreads();
        if (tid < 8) lbase[tid] = atomicAdd(gcnt + tid * 64, lcnt[tid]);
        __syncthreads();
        if (tid < 256 && p * 256 + tid < MREAL) { const int row = p * 256 + tid;
#pragma unroll
            for (int k = 0; k < 2; ++k) { const int e = le[tid * 2 + k]; ae[row * 2 + k] = e; apos[row * 2 + k] = (int)lbase[e] + lp[tid * 2 + k]; agate[row * 2 + k] = lg[tid * 2 + k]; } }
        __syncthreads();
    }
}
__device__ __forceinline__ void moe_scatter(const Ctx& X, int l) {
    const int lm = l >> 1, tid = X.tid;
    const unsigned* gcnt = (const unsigned*)(X.ws + CTL_MOECNT_B) + (size_t)lm * 8 * 64;
    int pstart[8]; int acc = 0;
#pragma unroll
    for (int e = 0; e < 8; ++e) { const int c = (int)__hip_atomic_load(gcnt + e * 64, __ATOMIC_RELAXED, __HIP_MEMORY_SCOPE_AGENT); pstart[e] = acc; acc += ((c + 255) >> 8) << 8; }
    const int nblk = acc >> 8;
    int* minfo = (int*)(X.ws + WS_S + S_MINFO);
    if (X.bid == 0) { if (tid == 0) minfo[0] = nblk;
        for (int blk = tid; blk < nblk; blk += 512) { int e = 0;
#pragma unroll
            for (int k = 1; k < 8; ++k) if (blk * 256 >= pstart[k]) e = k;
            minfo[16 + blk] = e; } }
    int* stok = (int*)(X.ws + WS_S + S_STOK); int* sslot = (int*)(X.ws + WS_S + S_SSLOT); float* sgate = (float*)(X.ws + WS_S + S_SGATE); float* srstd = (float*)(X.ws + WS_S + S_SRSTD);
    const int* ae = (const int*)(X.ws + WS_S + S_AE); const int* apos = (const int*)(X.ws + WS_S + S_APOS); const float* agate = (const float*)(X.ws + WS_S + S_AGATE);
    const u64* ssf = X.ss(4 * l + 3);
    for (int a = X.bid * 512 + tid; a < MOE_NASG; a += X.G * 512) {
        const int e = ae[a]; int ps = 0;
#pragma unroll
        for (int k = 0; k < 8; ++k) if (k == e) ps = pstart[k];
        const int dest = ps + apos[a], row = a >> 1;
        stok[dest] = row; sslot[dest] = a; sgate[dest] = agate[a]; srstd[dest] = rstd_of(ssf[row], 1.0f / DM);
    }
}
struct MoeOrder {
    int blk_lo, nb, nN, G, c; const char* A; const char* W; size_t tstepA, tstepB; const int* stok; const int* bexp; bool gather;
    __device__ __forceinline__ bool next(int i, pg8::Unit& u) const { const long L = (long)i * G + c; if (L >= (long)nb * nN) return false; u.pn = (int)(L / nb); u.pm = blk_lo + (int)(L % nb); return true; }
    __device__ __forceinline__ const char* a_ptr(const pg8::Unit& u) const { return gather ? A : A + (size_t)(u.pm - blk_lo) * tstepA; }
    __device__ __forceinline__ const char* b_ptr(const pg8::Unit& u) const { const int e = __builtin_amdgcn_readfirstlane(bexp[u.pm]); return W + (size_t)e * SZ_EXP + (size_t)u.pn * tstepB; }
    __device__ __forceinline__ int a_row(const pg8::Unit& u, int r) const { return stok[(size_t)u.pm * 256 + r]; }
    __device__ __forceinline__ const int* a_row_ptr(const pg8::Unit& u, int r) const { return stok + (size_t)u.pm * 256 + r; }
};
__device__ __forceinline__ void moe_combine(const Ctx& X, int l) {
    const bool lastl = (l == DEPTH - 1);
    bf16_t* h = (bf16_t*)(X.ws + WS_H); const bf16_t* y = X.sb(S_Y); u64* ssn = X.ss(lastl ? 16 : 4 * (l + 1)); const float* fn = inp(IN_FINAL_NORM); float* out = outp();
    const int gw = X.bid * 8 + X.wave, NGW = X.G * 8, lane = X.lane;
    for (int row = gw; row < MREAL; row += NGW) {
        float vv[16]; float s = 0.f;
#pragma unroll
        for (int j = 0; j < 4; ++j) { const size_t c = (size_t)j * 256 + lane * 4;
            const u32x2 a = *(const u32x2*)(h + (size_t)row * DM + c), b0 = *(const u32x2*)(y + (size_t)(2 * row) * DM + c), b1 = *(const u32x2*)(y + (size_t)(2 * row + 1) * DM + c);
            vv[4 * j] = bflo(a.x) + (bflo(b0.x) + bflo(b1.x)); vv[4 * j + 1] = bfhi(a.x) + (bfhi(b0.x) + bfhi(b1.x)); vv[4 * j + 2] = bflo(a.y) + (bflo(b0.y) + bflo(b1.y)); vv[4 * j + 3] = bfhi(a.y) + (bfhi(b0.y) + bfhi(b1.y)); }
        if (!lastl) {
#pragma unroll
            for (int j = 0; j < 4; ++j) { u32x2 w; w.x = pk2(vv[4 * j], vv[4 * j + 1]); w.y = pk2(vv[4 * j + 2], vv[4 * j + 3]); *(u32x2*)(h + (size_t)row * DM + j * 256 + lane * 4) = w;
                s += (bflo(w.x) * bflo(w.x) + bfhi(w.x) * bfhi(w.x)) + (bflo(w.y) * bflo(w.y) + bfhi(w.y) * bfhi(w.y)); }
            s = wave_sum(s); if (lane == 0) ssn[row] = ss_fix(s);
        } else {
#pragma unroll
            for (int k = 0; k < 16; ++k) s += vv[k] * vv[k];
            s = wave_sum(s); const float r = rsqrtf(s * (1.0f / DM) + EPS);
            if (row < MMAIN) {
#pragma unroll
                for (int j = 0; j < 4; ++j) { const f32x4 g = *(const f32x4*)(fn + j * 256 + lane * 4); f32x4 o = {vv[4 * j] * r * g[0], vv[4 * j + 1] * r * g[1], vv[4 * j + 2] * r * g[2], vv[4 * j + 3] * r * g[3]};
                    *(f32x4*)(out + (size_t)row * DM + j * 256 + lane * 4) = o; } }
        }
    }
}
#ifndef SKIP
#define SKIP 0
#endif
#define PH_ON(bit) (!((SKIP >> (bit)) & 1))
#ifndef ONE_LAUNCH
#define ONE_LAUNCH 0
#endif
constexpr int PH_PER_LAYER = 15, N_PHASES = 1 + DEPTH * PH_PER_LAYER;
constexpr int ATT_UNITS = NBATCH * NHEAD * 8 + NHEAD;

__global__ void __launch_bounds__(512, 2) fwd(Args args) {
    extern __shared__ __attribute__((aligned(16))) unsigned char lds_raw[];
    Ctx X0; X0.lds = (LAS unsigned char*)lds_raw; X0.ws = wsp(); X0.wave = __builtin_amdgcn_readfirstlane((int)threadIdx.x >> 6); X0.lane = lane_id(); X0.tid = X0.wave * 64 + X0.lane; X0.G = gridDim.x; X0.bid = blockIdx.x;
    volatile LAS unsigned* MISC = (volatile LAS unsigned*)(X0.lds + LDS_MISC);
    for (int u = X0.tid; u < (LDS_BYTES - LDS_MISC) / 4; u += 512) MISC[u] = 0u;
    __syncthreads();
    const int lo = argi(0), hi = argi(1);
    const bool use_bar = (hi - lo) > 1;
    XcdBarrier bar; bar.bar = (unsigned*)(X0.ws + WS_CTL) + CTL_BAR_W; bar.x = 0; bar.st = MISC + 8;
    if (use_bar) bar = xcd_barrier_post((unsigned*)(X0.ws + WS_CTL) + CTL_BAR_W, MISC + 8, X0.wave == 0 && lane_id() == 0);
#define IN(k) (lo <= (k) && (k) < hi)
#define SEAM(k) do { if ((k) + 1 < hi) xcd_barrier(bar, X0.wave == 0 && lane_id() == 0); } while (0)
    LAS unsigned char* ring = X0.lds;
#define PHASE_CTX const Ctx X = fresh(X0); bf16_t* H = (bf16_t*)(X.ws + WS_H); const float* rope = (const float*)(X.ws + WS_ROPE); (void)H; (void)rope;

    if (PH_ON(0) && IN(0)) { PHASE_CTX prologue(X); SEAM(0); }

#pragma unroll 1
    for (int l = 0; l < DEPTH; ++l) {
        const int pb = 1 + l * PH_PER_LAYER;
        if (PH_ON(1) && IN(pb)) {
            PHASE_CTX unsigned char* wmix = X.ws + WS_WMIX + (size_t)l * SZ_WMIX; (void)wmix;
            if (PH_ON(0) && l == 2) { moe_convert(X, 1); __syncthreads(); }
            pg8::StaticOrder S; S.init(H, (const bf16_t*)wmix, DM, NPANEL, DINP / 256, X.G, X.bid);
            EpiWin E{X.ws, l};
            pg8::gemm_phase<EpiWin, pg8::StaticOrder, false>(ring, X.tid, DM, S, E);
            SEAM(pb);
        }
        if (PH_ON(2) && IN(pb + 1)) {
            PHASE_CTX unsigned char* wmix = X.ws + WS_WMIX + (size_t)l * SZ_WMIX; (void)wmix;
            if (PH_ON(15)) { pg8::StaticOrder S; S.init(X.sb(S_CQ), (const bf16_t*)(wmix + SZ_WIN), QLORA, NPANEL, 3, X.G, X.bid);
              EpiQ E{X.ws, l};
              pg8::gemm_phase<EpiQ, pg8::StaticOrder, false>(ring, X.tid, QLORA, S, E); }
            if (PH_ON(16)) { pg8::StaticOrder S; S.init(X.sb(S_CKV), (const bf16_t*)(wmix + SZ_WIN + SZ_WQ), KVLORA, NPANEL, 4, X.G, X.bid);
              EpiKV E{X.ws, l};
              pg8::gemm_phase<EpiKV, pg8::StaticOrder, false>(ring, X.tid, KVLORA, S, E); }
            SEAM(pb + 1);
        }
        if (PH_ON(3) && IN(pb + 2)) {
            PHASE_CTX unsigned char* wmix = X.ws + WS_WMIX + (size_t)l * SZ_WMIX; (void)wmix;
            MixP P{X.sb(S_Q), X.sb(S_KN), X.sb(S_V), X.sb(S_KR), X.sb(S_XP), X.sb(S_MQK), X.sb(S_MV), X.sb(S_MO), (const float*)(X.ws + WS_S + S_GATES), X.sb(S_CAT),
                   inp(IN_CONV_W) + (size_t)l * 4 * 512, inp(IN_CONV_B) + l * 512, inp(IN_MLSTM_NORM) + l * 256};
            if (PH_ON(12)) for (int it = X.bid; it < NBATCH * 32 + 1; it += X.G) { if (it < NBATCH * 32) pool_unit(P, X0.wave * 64 + lane_id(), it >> 5, (it & 31) + 1); else pool_unit(P, X0.wave * 64 + lane_id(), 0, 0); }
            if (PH_ON(13)) for (int u = X.bid; u < NBATCH * MH; u += X.G) mlstm_unit(ring, P, X0.wave * 64 + lane_id(), u >> 2, u & 3);
            unsigned* qhead = (unsigned*)(X.ws + CTL_QUEUE_B) + l * 64;
            if (PH_ON(14)) for (;;) {
                __syncthreads();
                if (X0.wave == 0 && lane_id() == 0) MISC[16] = atomicAdd(qhead, 1u);
                __syncthreads();
                const int idx = (int)MISC[16];
                if (idx >= ATT_UNITS) break;
                if (idx < NBATCH * NHEAD * 8) { const int qt = 7 - (idx >> 8), bh = idx & 255; attn_unit(ring, P, X0.wave * 64 + lane_id(), bh >> 3, bh & 7, qt); }
                else attn_unit(ring, P, X0.wave * 64 + lane_id(), 0, idx - NBATCH * NHEAD * 8, -1);
            }
            SEAM(pb + 2);
        }
        if (PH_ON(4) && IN(pb + 3)) {
            PHASE_CTX unsigned char* wmix = X.ws + WS_WMIX + (size_t)l * SZ_WMIX; (void)wmix;
            pg8::StaticOrder S; S.init(X.sb(S_CAT), (const bf16_t*)(wmix + SZ_WIN + SZ_WQ + SZ_WKV), DM, NPANEL, 4, X.G, X.bid);
            EpiRes E{X.ws, 4 * l + 3};
            pg8::gemm_phase<EpiRes, pg8::StaticOrder, false>(ring, X.tid, DM, S, E);
            SEAM(pb + 3);
        }
        if ((l & 1) == 0) {
            if (PH_ON(5) && IN(pb + 4)) {
                PHASE_CTX unsigned char* wd = X.ws + WS_WDENSE + (size_t)(l >> 1) * SZ_DENSE;
                pg8::StaticOrder S; S.init(H, (const bf16_t*)wd, DM, NPANEL, 2 * DFF / 256, X.G, X.bid);
                EpiGU E{X.ws, 4 * l + 3};
                pg8::gemm_phase<EpiGU, pg8::StaticOrder, false>(ring, X.tid, DM, S, E);
                SEAM(pb + 4);
            }
            if (PH_ON(6) && IN(pb + 5)) {
                PHASE_CTX unsigned char* wd = X.ws + WS_WDENSE + (size_t)(l >> 1) * SZ_DENSE;
                pg8::StaticOrder S; S.init(X.sb(S_ACT), (const bf16_t*)(wd + SZ_DGU), DFF, NPANEL, 4, X.G, X.bid);
                EpiRes E{X.ws, 4 * (l + 1)};
                pg8::gemm_phase<EpiRes, pg8::StaticOrder, false>(ring, X.tid, DFF, S, E);
                SEAM(pb + 5);
            }
        } else {
            if (PH_ON(7) && IN(pb + 4)) { PHASE_CTX moe_route(X, l); SEAM(pb + 4); }
            if (PH_ON(8) && IN(pb + 5)) { PHASE_CTX moe_scatter(X, l); SEAM(pb + 5); }
#pragma unroll 1
            for (int ci = 0; ci < 4; ++ci) {
                if (IN(pb + 6 + 2 * ci) || IN(pb + 7 + 2 * ci)) {
                    PHASE_CTX const int* minfo = (const int*)(X.ws + WS_S + S_MINFO);
                    const int nblk = minfo[0];
                    const int blk_lo = MOE_CHUNK * ci; int blk_hi = (ci == 3) ? nblk : (nblk < MOE_CHUNK * (ci + 1) ? nblk : MOE_CHUNK * (ci + 1));
                    if (blk_hi > blk_lo + MOE_CHUNK_CAP) blk_hi = blk_lo + MOE_CHUNK_CAP;
                    const int nb = blk_hi > blk_lo ? blk_hi - blk_lo : 0;
                    if (PH_ON(9) && IN(pb + 6 + 2 * ci)) {
                        MoeOrder S{blk_lo, nb, 2 * DFFE / 256, X.G, X.bid, (const char*)H, (const char*)(X.ws + WS_WMOE), 0, (size_t)256 * DM * 2, (const int*)(X.ws + WS_S + S_STOK), minfo + 16, true};
                        EpiMoeGU E{X.ws, blk_lo};
                        pg8::gemm_phase<EpiMoeGU, MoeOrder, true>(ring, X.tid, DM, S, E);
                        SEAM(pb + 6 + 2 * ci);
                    }
                    if (PH_ON(10) && IN(pb + 7 + 2 * ci)) {
                        MoeOrder S{blk_lo, nb, 4, X.G, X.bid, (const char*)X.sb(S_ACTE), (const char*)(X.ws + WS_WMOE + SZ_EGU), (size_t)256 * DFFE * 2, (size_t)256 * DFFE * 2, (const int*)(X.ws + WS_S + S_STOK), minfo + 16, false};
                        EpiMoeDown E{X.ws};
                        pg8::gemm_phase<EpiMoeDown, MoeOrder, false>(ring, X.tid, DFFE, S, E);
                        SEAM(pb + 7 + 2 * ci);
                    }
                }
            }
            if (PH_ON(11) && IN(pb + 14)) { PHASE_CTX moe_combine(X, l); SEAM(pb + 14); }
        }
    }
#undef IN
#undef SEAM
}

extern "C" void kernel_launch(void* const* d_in, const int* in_sizes, int n_in, void* d_out, int out_size, void* d_ws, size_t ws_size, hipStream_t stream) {
    static int grid = 0;
    if (grid == 0) {
        if (n_in != N_IN || in_sizes[0] != MMAIN * DM || out_size != MMAIN * DM || ws_size < WS_END) {
            fprintf(stderr, "kernel_launch: unexpected shapes (n_in %d, in0 %d, out %d, ws %zu < %zu); nothing launched\n", n_in, n_in > 0 ? in_sizes[0] : -1, out_size, ws_size, (size_t)WS_END); grid = -1; return; }
        int dev = 0, cus = 0, per_cu = 0;
        if (hipGetDevice(&dev) != hipSuccess || hipDeviceGetAttribute(&cus, hipDeviceAttributeMultiprocessorCount, dev) != hipSuccess) { grid = -1; return; }
        if (hipFuncSetAttribute((const void*)fwd, hipFuncAttributeMaxDynamicSharedMemorySize, LDS_BYTES) != hipSuccess) { fprintf(stderr, "kernel_launch: hipFuncSetAttribute failed\n"); grid = -1; return; }
        if (hipOccupancyMaxActiveBlocksPerMultiprocessor(&per_cu, (const void*)fwd, 512, LDS_BYTES) != hipSuccess || per_cu < 1) { fprintf(stderr, "kernel_launch: occupancy query says %d\n", per_cu); }
        (void)hipGetLastError();
        grid = cus;
    }
    if (grid < 0) return;
    (void)hipMemsetAsync((char*)d_ws + WS_CTL, 0, CTL_BYTES, stream);
    Args a{};
    for (int i = 0; i < N_IN; ++i) a.in[i] = (const float*)d_in[i];
    a.out = (float*)d_out; a.ws = (unsigned char*)d_ws;
#if ONE_LAUNCH
    a.ph_lo = 0; a.ph_hi = N_PHASES;
    hipLaunchKernelGGL(fwd, dim3(grid), dim3(512), LDS_BYTES, stream, a);
#else
    for (int ph = 0; ph < N_PHASES; ++ph) {
        if (ph > 0) { const int l = (ph - 1) / PH_PER_LAYER, r = (ph - 1) % PH_PER_LAYER; if ((l & 1) == 0 && r > 5) continue; }
        a.ph_lo = ph; a.ph_hi = ph + 1;
        hipLaunchKernelGGL(fwd, dim3(grid), dim3(512), LDS_BYTES, stream, a);
    }
#endif
    const hipError_t le = hipPeekAtLastError();
    if (le != hipSuccess) fprintf(stderr, "kernel_launch: launch failed: %s\n", hipGetErrorName(le));
}
```

```cpp
#include <hip/hip_runtime.h>
#include <cstdio>
#include <cstdint>

#define LAS __attribute__((address_space(3)))
#define GAS __attribute__((address_space(1)))
typedef unsigned short bf16_t;
typedef short bf16x8 __attribute__((ext_vector_type(8)));
typedef short s16x4 __attribute__((ext_vector_type(4)));
typedef float f32x4 __attribute__((ext_vector_type(4)));
typedef float f32x2 __attribute__((ext_vector_type(2)));
typedef float f32x16 __attribute__((ext_vector_type(16)));
typedef unsigned u32x4 __attribute__((ext_vector_type(4)));
typedef unsigned u32x2 __attribute__((ext_vector_type(2)));
typedef unsigned long long u64;

constexpr int NBATCH = 32, SEQ = 2048, DM = 1024, DEPTH = 4, NMETA = 16, LTOT = SEQ + NMETA;
constexpr int MMAIN = NBATCH * SEQ;
constexpr int MREAL = MMAIN + NMETA;
constexpr int NPANEL = 257, MPAD = NPANEL * 256;
constexpr int QLORA = 768, KVLORA = 256, NHEAD = 8, QKN = 64, QKR = 32, VH = 64;
constexpr int DIN = 2344, DINP = 2560;
constexpr int DFF = 2816, DFFE = 3584, NEXP = 8;
constexpr int MH = 4, MHD = 64;
constexpr float EPS = 1e-6f;
constexpr float QSCALE = 0.10206207261596577f * 1.4426950408889634f;
constexpr float SSFIX = 1048576.0f;

__device__ __forceinline__ unsigned f2bf(float f) { unsigned u = __builtin_bit_cast(unsigned, f); return (u + 0x7fffu + ((u >> 16) & 1u)) >> 16; }
__device__ __forceinline__ unsigned pk2(float lo, float hi) { f32x2 v = {lo, hi}; typedef __bf16 bf2 __attribute__((ext_vector_type(2))); bf2 b = __builtin_convertvector(v, bf2); return __builtin_bit_cast(unsigned, b); }
__device__ __forceinline__ float bf2f(unsigned short h) { return __builtin_bit_cast(float, (unsigned)h << 16); }
__device__ __forceinline__ float bflo(unsigned w) { return __builtin_bit_cast(float, w << 16); }
__device__ __forceinline__ float bfhi(unsigned w) { return __builtin_bit_cast(float, w & 0xffff0000u); }
__device__ __forceinline__ float fexp2(float x) { return __builtin_amdgcn_exp2f(x); }
__device__ __forceinline__ float fexp(float x) { return __builtin_amdgcn_exp2f(x * 1.4426950408889634f); }
__device__ __forceinline__ float frcp(float x) { return __builtin_amdgcn_rcpf(x); }
__device__ __forceinline__ float sigmoidf_(float x) { return frcp(1.0f + fexp(-x)); }
__device__ __forceinline__ float siluf_(float x) { return x * sigmoidf_(x); }
__device__ __forceinline__ float rstd_of(u64 ss, float inv_n) { return rsqrtf((float)ss * (1.0f / SSFIX) * inv_n + EPS); }
__device__ __forceinline__ u64 ss_fix(float s) { return (u64)(s * SSFIX + 0.5f); }
__device__ __forceinline__ int lane_id() { int l; asm volatile("v_mbcnt_lo_u32_b32 %0, -1, 0\n\tv_mbcnt_hi_u32_b32 %0, -1, %0" : "=v"(l)); return l; }
__device__ __forceinline__ int seqrow(int b, int pos) { return pos < NMETA ? MMAIN + pos : b * SEQ + (pos - NMETA); }
__device__ __forceinline__ int rowpos(int row) { return row < MMAIN ? NMETA + (row & (SEQ - 1)) : row - MMAIN; }

#define XB_TMO      128
#define XB_XCNT(j)  (256  + 64 * (j))
#define XB_XSUB(j)  (1280 + 64 * (j))
#define XB_XGEN(j)  (2304 + 64 * (j))
#define XB_TOP      3328
#define XB_TOPGEN   3392
#define XCD_BAR_WORDS 3456
#define XB_SPIN_CAP (1u << 22)

__device__ __forceinline__ unsigned xb_ld(unsigned* p)              { return __hip_atomic_load(p, __ATOMIC_RELAXED, __HIP_MEMORY_SCOPE_AGENT); }
__device__ __forceinline__ unsigned xb_add(unsigned* p, unsigned v) { return __hip_atomic_fetch_add(p, v, __ATOMIC_RELAXED, __HIP_MEMORY_SCOPE_AGENT); }
__device__ __forceinline__ unsigned xb_xcc_id() { return (unsigned)__builtin_amdgcn_s_getreg((3 << 11) | 20) & 0xFu; }
#define XB_SPIN(cond, bar) do { unsigned _sp = 0; while (cond) { __builtin_amdgcn_s_sleep(1); \
    if ((++_sp & 255u) == 0u) { if (xb_ld(&(bar)[XB_TMO])) break; if (_sp > XB_SPIN_CAP) { atomicAdd(&(bar)[XB_TMO], 1u); break; } } } } while (0)

struct XcdBarrier { unsigned* bar; unsigned x; volatile LAS unsigned* st; };

__device__ __forceinline__ XcdBarrier xcd_barrier_post(unsigned* bar, volatile LAS unsigned* st, bool leader) {
    XcdBarrier b; b.bar = bar; b.x = xb_xcc_id(); b.st = st;
    if (leader) (void)xb_add(&bar[XB_XCNT(b.x)], 1u);
    return b;
}
__device__ __forceinline__ void xcd_barrier_complete(unsigned* bar, unsigned x, unsigned& nloc, unsigned& nx) {
    const unsigned G = gridDim.x * gridDim.y * gridDim.z;
    unsigned sum, cnt, mine, sp = 0u;
    for (;;) {
        sum = 0u; cnt = 0u; mine = 0u;
#pragma unroll
        for (unsigned j = 0; j < 16; ++j) { const unsigned c = xb_ld(&bar[XB_XCNT(j)]); sum += c; cnt += (c > 0u) ? 1u : 0u; mine = (j == x) ? c : mine; }
        if (sum == G) break;
        __builtin_amdgcn_s_sleep(1);
        if ((++sp & 255u) == 0u) { if (xb_ld(&bar[XB_TMO])) break; if (sp > XB_SPIN_CAP) { atomicAdd(&bar[XB_TMO], 1u); break; } }
    }
    nloc = mine > 0u ? mine : 1u; nx = cnt > 0u ? cnt : 1u;
}
__device__ __forceinline__ void xcd_barrier(const XcdBarrier& b, bool leader) {
    asm volatile("s_waitcnt vmcnt(0)" ::: "memory");
    __syncthreads();
    if (leader) {
        unsigned* bar = b.bar;
        __builtin_amdgcn_s_waitcnt(0);
        unsigned nloc = b.st[0], nx = b.st[1];
        if (nloc == 0u) { xcd_barrier_complete(bar, b.x, nloc, nx); b.st[0] = nloc; b.st[1] = nx; }
        const unsigned old = xb_add(&bar[XB_XSUB(b.x)], 1u);
        const unsigned gen = old / nloc;
        if (old + 1u == (gen + 1u) * nloc) {
            __builtin_amdgcn_fence(__ATOMIC_RELEASE, "agent");
            asm volatile("s_waitcnt vmcnt(0)" ::: "memory");
            const unsigned og = xb_add(&bar[XB_TOP], 1u);
            const unsigned tg = og / nx;
            if (og + 1u == (tg + 1u) * nx) xb_add(&bar[XB_TOPGEN], 1u);
            else XB_SPIN(xb_ld(&bar[XB_TOPGEN]) == tg, bar);
            __builtin_amdgcn_fence(__ATOMIC_ACQUIRE, "agent");
            xb_add(&bar[XB_XGEN(b.x)], 1u);
            asm volatile("s_waitcnt vmcnt(0)" ::: "memory");
        } else {
            XB_SPIN(xb_ld(&bar[XB_XGEN(b.x)]) == gen, bar);
            __builtin_amdgcn_fence(__ATOMIC_ACQUIRE, "agent");
            asm volatile("s_waitcnt vmcnt(0)" ::: "memory");
        }
    }
    __syncthreads();
}

__device__ __forceinline__ const char* uni_ptr(const char* p) { const unsigned long long v = (unsigned long long)p; const unsigned lo = __builtin_amdgcn_readfirstlane((unsigned)v), hi = __builtin_amdgcn_readfirstlane((unsigned)(v >> 32)); return (const char*)(((unsigned long long)hi << 32) | lo); }
namespace pg8 {
constexpr int BM = 256, BK = 64, HALF = 128, HTB = HALF * BK * 2, STAGE_BYTES = 8 * HTB, NXCD = 8, WGM = 8;
__host__ __device__ __forceinline__ int lds_byte(int r, int c) { const int st = (r >> 4) * 2 + (c >> 5), rr = r & 15, cc = c & 31, ob = rr * 64 + cc * 2; return st * 1024 + (ob ^ (((ob >> 9) & 1) << 5)); }
__host__ __device__ __forceinline__ void stage_rc(int b, int& R, int& C) { const int st = b / 1024, sb = b % 1024, swz = sb ^ (((sb >> 9) & 1) << 5); R = (st >> 1) * 16 + swz / 64; C = (st & 1) * 32 + (swz % 64) / 2; }
__host__ __device__ __forceinline__ int perm32(int rho) { const int n = rho >> 4, i = rho & 15; return 8 * (i >> 2) + 4 * n + (i & 3); }

struct Unit { int pm, pn; };

struct StaticOrder {
    int nM, nN, nwg, G, c; const char* A; const char* B; size_t tstep;
    __device__ __forceinline__ void init(const bf16_t* A_, const bf16_t* B_, int K, int nM_, int nN_, int G_, int c_) { A = (const char*)A_; B = (const char*)B_; tstep = (size_t)BM * K * 2; nM = nM_; nN = nN_; nwg = nM * nN; G = G_; c = c_; }
    __device__ __forceinline__ bool next(int i, Unit& u) const {
        const long L = (long)i * G + c; if (L >= nwg) return false;
        int wgid = (int)L; { const int q = nwg / NXCD, r = nwg % NXCD, xcd = wgid % NXCD, off = wgid / NXCD; wgid = (xcd < r ? xcd * (q + 1) : r * (q + 1) + (xcd - r) * q) + off; }
        const int nig = WGM * nN, gid = wgid / nig, fm = gid * WGM, gsz = (nM - fm) < WGM ? (nM - fm) : WGM;
        u.pm = fm + ((wgid % nig) % gsz); u.pn = (wgid % nig) / gsz; return true;
    }
    __device__ __forceinline__ const char* a_ptr(const Unit& u) const { return A + (size_t)u.pm * tstep; }
    __device__ __forceinline__ const char* b_ptr(const Unit& u) const { return B + (size_t)u.pn * tstep; }
    __device__ __forceinline__ int a_row(const Unit&, int) const { return 0; }
    __device__ __forceinline__ const int* a_row_ptr(const Unit&, int) const { return nullptr; }
};

template <class Epi, class Sched, bool GATHER>
__device__ __forceinline__ void gemm_phase(LAS unsigned char* lds, const int tid_, const int K_, const Sched& S, const Epi& E) {
    int tid = tid_, K = K_;
    asm volatile("" : "+v"(tid)); asm volatile("" : "+s"(K));
    const int wid = __builtin_amdgcn_readfirstlane(tid >> 6), lane = tid & 63, wr = wid >> 2, wc = wid & 3, fr = lane & 15, fq = lane >> 4;
    const int nt = K / BK;
    unsigned voffA[2], voffB[2]; int RA[2], CA2[2];
#pragma unroll
    for (int i = 0; i < 2; ++i) { int R, C; stage_rc(tid * 16 + i * 8192, R, C); const int Rb = Epi::PERM ? ((R & ~31) + perm32(R & 31)) : R;
        voffA[i] = (unsigned)(R * K + C) * 2u; voffB[i] = (unsigned)(Rb * K + C) * 2u; RA[i] = R; CA2[i] = C * 2; }
    const size_t kstep = (size_t)(BK * 2);
    const size_t hstep = GATHER ? (size_t)0 : (size_t)HALF * K * 2;
    const size_t hstepB = (size_t)HALF * K * 2;
    const unsigned ldsw = (unsigned)wid * 1024u;
    const int aoff = lds_byte(wr * 64 + fr, fq * 8), boff = lds_byte(wc * 32 + fr, fq * 8);
#define PG8_SA(b, h) (((b) * 2 + (h)) * HTB)
#define PG8_SB(b, h) ((4 + (b) * 2 + (h)) * HTB)
#define PG8_STAGE(bufoff, gbase, voff) do { const char* _gb = uni_ptr((const char*)(gbase)); _Pragma("unroll") for (int _i = 0; _i < 2; ++_i) \
        __builtin_amdgcn_global_load_lds((const unsigned*)(_gb + (voff)[_i]), (LAS unsigned*)(lds + (bufoff) + ldsw + _i * 8192), 16, 0, 0); } while (0)
#define PG8_LDA(dst, b, h) do { _Pragma("unroll") for (int m = 0; m < 4; ++m) _Pragma("unroll") for (int k = 0; k < 2; ++k) dst[m][k] = *(const LAS bf16x8*)(lds + PG8_SA(b, h) + aoff + m * 2048 + k * 1024); } while (0)
#define PG8_LDB(dst, b, h) do { _Pragma("unroll") for (int n = 0; n < 2; ++n) _Pragma("unroll") for (int k = 0; k < 2; ++k) dst[n][k] = *(const LAS bf16x8*)(lds + PG8_SB(b, h) + boff + n * 2048 + k * 1024); } while (0)
#define PG8_MMA(ai, bj, At, Bt) do { __builtin_amdgcn_s_setprio(1); _Pragma("unroll") for (int m = 0; m < 4; ++m) _Pragma("unroll") for (int n = 0; n < 2; ++n) _Pragma("unroll") for (int k = 0; k < 2; ++k) \
        acc[ai][bj][m][n] = __builtin_amdgcn_mfma_f32_16x16x32_bf16(Bt[n][k], At[m][k], acc[ai][bj][m][n], 0, 0, 0); __builtin_amdgcn_s_setprio(0); } while (0)
#define PG8_WAIT_V(n) asm volatile("s_waitcnt vmcnt(" #n ")" ::: "memory")
#define PG8_WAIT_L(n) asm volatile("s_waitcnt lgkmcnt(" #n ")" ::: "memory")
#define PG8_BAR __builtin_amdgcn_s_barrier()
#define PG8_SCHED __builtin_amdgcn_sched_barrier(0)
    Unit cur, nxt; int ui = 0;
    if (!S.next(0, cur)) return;
    f32x4 acc[2][2][4][2];
#pragma unroll
    for (int a = 0; a < 2; ++a)
#pragma unroll
        for (int b = 0; b < 2; ++b)
#pragma unroll
            for (int m = 0; m < 4; ++m)
#pragma unroll
                for (int n = 0; n < 2; ++n) acc[a][b][m][n] = (f32x4){0.f, 0.f, 0.f, 0.f};
    bf16x8 At[4][2], B0[2][2], B1[2][2];
    unsigned gc0[2], gc1[2];
    const char* cA = S.a_ptr(cur); const char* cB = S.b_ptr(cur);
    LAS int* gtab = (LAS int*)(lds + STAGE_BYTES + 1024);
    if constexpr (GATHER) {
#pragma unroll
        for (int i = 0; i < 2; ++i) { gc0[i] = (unsigned)S.a_row(cur, RA[i]) * (unsigned)(K * 2) + CA2[i]; gc1[i] = (unsigned)S.a_row(cur, HALF + RA[i]) * (unsigned)(K * 2) + CA2[i]; }
    } else {
#pragma unroll
        for (int i = 0; i < 2; ++i) { gc0[i] = voffA[i]; gc1[i] = voffA[i]; }
    }
    PG8_STAGE(PG8_SB(0, 0), cB, voffB); PG8_STAGE(PG8_SB(0, 1), cB + hstepB, voffB); PG8_STAGE(PG8_SA(0, 0), cA, gc0); PG8_STAGE(PG8_SA(0, 1), cA + hstep, gc1);
    if (wr == 1) PG8_BAR;
    PG8_WAIT_V(2); PG8_BAR;
    PG8_STAGE(PG8_SB(1, 0), cB + kstep, voffB); PG8_STAGE(PG8_SA(1, 0), cA + kstep, gc0); PG8_STAGE(PG8_SB(1, 1), cB + hstepB + kstep, voffB);
    PG8_WAIT_V(6); PG8_BAR;
    for (;;) {
        const bool has_next = S.next(ui + 1, nxt);
        const char* nA = has_next ? S.a_ptr(nxt) : cA; const char* nB = has_next ? S.b_ptr(nxt) : cB;
        if constexpr (GATHER) { if (has_next && wid < 4)
            __builtin_amdgcn_global_load_lds((const unsigned*)S.a_row_ptr(nxt, tid), (LAS unsigned*)(gtab + ((ui + 1) & 1) * 256 + wid * 64), 4, 0, 0); }
        for (int t = 0; t < nt; t += 2) {
            const bool last = (t == nt - 2);
            const char* a1 = cA + (size_t)(t + 1) * kstep;
            const char* a2 = last ? nA : cA + (size_t)(t + 2) * kstep; const char* b2 = last ? nB : cB + (size_t)(t + 2) * kstep;
            const char* a3 = a2 + kstep; const char* b3 = b2 + kstep;
            unsigned s0[2], s1[2];
#pragma unroll
            for (int i = 0; i < 2; ++i) { s0[i] = gc0[i]; s1[i] = gc1[i]; }
            if constexpr (GATHER) { if (last && has_next) {
#pragma unroll
                for (int i = 0; i < 2; ++i) { const LAS int* tb = gtab + ((ui + 1) & 1) * 256; int r0 = tb[RA[i]], r1 = tb[HALF + RA[i]]; r0 = r0 < 0 ? 0 : r0; r1 = r1 < 0 ? 0 : r1;
                    s0[i] = (unsigned)r0 * (unsigned)(K * 2) + CA2[i]; s1[i] = (unsigned)r1 * (unsigned)(K * 2) + CA2[i]; } } }
            PG8_LDB(B0, 0, 0); PG8_LDB(B1, 0, 1); PG8_SCHED; PG8_LDA(At, 0, 0); PG8_STAGE(PG8_SA(1, 1), a1 + hstep, gc1);
            PG8_WAIT_V(8); PG8_WAIT_L(0); PG8_BAR; PG8_MMA(0, 0, At, B0); PG8_MMA(0, 1, At, B1); PG8_BAR; PG8_SCHED;
            PG8_LDA(At, 0, 1); PG8_STAGE(PG8_SB(0, 0), b2, voffB); PG8_STAGE(PG8_SB(0, 1), b2 + hstepB, voffB); PG8_STAGE(PG8_SA(0, 0), a2, s0);
            PG8_WAIT_V(8); PG8_WAIT_L(0); PG8_BAR; PG8_MMA(1, 0, At, B0); PG8_MMA(1, 1, At, B1); PG8_BAR; PG8_SCHED;
            PG8_LDB(B0, 1, 0); PG8_LDB(B1, 1, 1); PG8_SCHED; PG8_LDA(At, 1, 0); PG8_STAGE(PG8_SA(0, 1), a2 + hstep, s1);
            PG8_WAIT_V(8); PG8_WAIT_L(0); PG8_BAR; PG8_MMA(0, 0, At, B0); PG8_MMA(0, 1, At, B1); PG8_BAR; PG8_SCHED;
            PG8_LDA(At, 1, 1); PG8_STAGE(PG8_SB(1, 0), b3, voffB); PG8_STAGE(PG8_SB(1, 1), b3 + hstepB, voffB); PG8_STAGE(PG8_SA(1, 0), a3, s0);
            PG8_WAIT_V(8); PG8_WAIT_L(0); PG8_BAR; PG8_MMA(1, 0, At, B0); PG8_MMA(1, 1, At, B1); PG8_BAR; PG8_SCHED;
        }
        if (wr == 0) PG8_BAR;
        E(acc, cur, wr, wc, fr, fq);
        if (!has_next) break;
#pragma unroll
        for (int a = 0; a < 2; ++a)
#pragma unroll
            for (int b = 0; b < 2; ++b)
#pragma unroll
                for (int m = 0; m < 4; ++m)
#pragma unroll
                    for (int n = 0; n < 2; ++n) acc[a][b][m][n] = (f32x4){0.f, 0.f, 0.f, 0.f};
        cur = nxt; cA = nA; cB = nB; ++ui;
        if constexpr (GATHER) {
#pragma unroll
            for (int i = 0; i < 2; ++i) { const LAS int* tb = gtab + (ui & 1) * 256; int r0 = tb[RA[i]], r1 = tb[HALF + RA[i]]; r0 = r0 < 0 ? 0 : r0; r1 = r1 < 0 ? 0 : r1;
                gc0[i] = (unsigned)r0 * (unsigned)(K * 2) + CA2[i]; gc1[i] = (unsigned)r1 * (unsigned)(K * 2) + CA2[i]; }
        }
        if (wr == 1) PG8_BAR;
    }
    PG8_WAIT_V(0);
    PG8_BAR;
#undef PG8_SA
#undef PG8_SB
#undef PG8_STAGE
#undef PG8_LDA
#undef PG8_LDB
#undef PG8_MMA
#undef PG8_WAIT_V
#undef PG8_WAIT_L
#undef PG8_BAR
#undef PG8_SCHED
}
}
constexpr size_t AL256(size_t x) { return (x + 255) & ~(size_t)255; }
constexpr size_t WS_CTL = 0;
constexpr size_t CTL_BAR_W = 4096;
constexpr size_t CTL_QUEUE_B = 32768;
constexpr size_t CTL_MOECNT_B = 40960;
constexpr size_t CTL_SS_B = 65536;
constexpr size_t SS_BYTES = (size_t)MPAD * 8;
constexpr size_t CTL_BYTES = 9437184;
static_assert(CTL_SS_B + 17 * SS_BYTES <= CTL_BYTES, "ctl");
constexpr size_t WS_ROPE = CTL_BYTES;
constexpr size_t WS_ROUTER = WS_ROPE + 524288;
constexpr size_t WS_WMIX = WS_ROUTER + 65536;
constexpr size_t SZ_WIN = (size_t)DINP * DM * 2, SZ_WQ = (size_t)768 * QLORA * 2, SZ_WKV = (size_t)1024 * KVLORA * 2, SZ_WO = (size_t)DM * DM * 2;
constexpr size_t SZ_WMIX = SZ_WIN + SZ_WQ + SZ_WKV + SZ_WO;
constexpr size_t WS_WDENSE = WS_WMIX + DEPTH * SZ_WMIX;
constexpr size_t SZ_DGU = (size_t)2 * DFF * DM * 2, SZ_DD = (size_t)DM * DFF * 2, SZ_DENSE = SZ_DGU + SZ_DD;
constexpr size_t WS_WMOE = WS_WDENSE + 2 * SZ_DENSE;
constexpr size_t SZ_EGU = (size_t)2 * DFFE * DM * 2, SZ_ED = (size_t)DM * DFFE * 2, SZ_EXP = SZ_EGU + SZ_ED;
constexpr size_t WS_H = WS_WMOE + NEXP * SZ_EXP;
constexpr size_t WS_S = WS_H + (size_t)MPAD * DM * 2;
constexpr size_t S_CQ = 0, S_CKV = S_CQ + (size_t)MPAD * QLORA * 2, S_CAT = 0  ;
constexpr size_t S_XP = S_CKV + (size_t)MPAD * 256 * 2, S_MQK = S_XP + (size_t)MPAD * 256 * 2, S_MV = S_MQK + (size_t)MPAD * 512 * 2, S_MO = S_MV + (size_t)MPAD * 256 * 2;
constexpr size_t S_KR = S_MO + (size_t)MPAD * 256 * 2, S_GATES = S_KR + (size_t)MPAD * 32 * 2, S_Q = S_GATES + (size_t)MPAD * 8 * 4;
constexpr size_t S_KN = S_Q + (size_t)MPAD * 768 * 2, S_V = S_KN + (size_t)MPAD * 512 * 2, S_MIX_END = S_V + (size_t)MPAD * 512 * 2;
constexpr size_t S_ACT = 0;
constexpr int MOE_CHUNK = 128, MOE_CHUNK_CAP = 136, MOE_RCAP = 520 * 256, MOE_NASG = MREAL * 2;
constexpr size_t S_ACTE = 0;
constexpr size_t S_Y = S_ACTE + (size_t)MOE_CHUNK_CAP * 256 * DFFE * 2;
constexpr size_t S_STOK = S_Y + (size_t)MOE_NASG * DM * 2;
constexpr size_t S_SSLOT = S_STOK + (size_t)MOE_RCAP * 4, S_SGATE = S_SSLOT + (size_t)MOE_RCAP * 4, S_SRSTD = S_SGATE + (size_t)MOE_RCAP * 4;
constexpr size_t S_AE = S_SRSTD + (size_t)MOE_RCAP * 4;
constexpr size_t S_APOS = S_AE + AL256((size_t)MOE_NASG * 4), S_AGATE = S_APOS + AL256((size_t)MOE_NASG * 4);
constexpr size_t S_MINFO = S_AGATE + AL256((size_t)MOE_NASG * 4);
constexpr size_t S_MOE_END = S_MINFO + 4096;
static_assert(S_MOE_END <= S_MIX_END && (size_t)MPAD * DFF * 2 <= S_MIX_END, "overlays fit the mixer scratch");
constexpr size_t WS_END = WS_S + S_MIX_END;

constexpr int RING_BYTES = 131072;
constexpr int LDS_MISC = RING_BYTES;
constexpr int LDS_BYTES = 147456;

enum { IN_X = 0, IN_META, IN_ATTN_NORM, IN_W_IN, IN_Q_NORM, IN_W_Q_UP, IN_KV_NORM, IN_W_KV_UP, IN_POOL_W, IN_POOL_SCALE, IN_CONV_W, IN_CONV_B, IN_GATE_BIAS, IN_MLSTM_NORM,
       IN_W_OUT, IN_FFN_NORM, IN_DGATE, IN_DUP, IN_DDOWN, IN_ROUTER, IN_MGATE, IN_MUP, IN_MDOWN, IN_FINAL_NORM, N_IN };
struct Args { const float* in[N_IN]; float* out; unsigned char* ws; int ph_lo, ph_hi; };
__device__ __forceinline__ const float* inp(int i) { return ((const float* const __attribute__((address_space(4)))*)__builtin_amdgcn_kernarg_segment_ptr())[i]; }
__device__ __forceinline__ float* outp() { return ((float* const __attribute__((address_space(4)))*)__builtin_amdgcn_kernarg_segment_ptr())[N_IN]; }
__device__ __forceinline__ unsigned char* wsp() { return ((unsigned char* const __attribute__((address_space(4)))*)__builtin_amdgcn_kernarg_segment_ptr())[N_IN + 1]; }
__device__ __forceinline__ int argi(int i) { return ((const int __attribute__((address_space(4)))*)__builtin_amdgcn_kernarg_segment_ptr())[2 * (N_IN + 2) + i]; }

struct Ctx {
    LAS unsigned char* lds; unsigned char* ws; int tid, lane, wave, G, bid;
    __device__ __forceinline__ u64* ss(int idx) const { return (u64*)(ws + CTL_SS_B) + (size_t)idx * MPAD; }
    __device__ __forceinline__ bf16_t* sb(size_t off) const { return (bf16_t*)(ws + WS_S + off); }
};
__device__ __forceinline__ Ctx fresh(const Ctx& X) { Ctx Y = X; asm volatile("" : "+s"(Y.ws)); Y.tid = Y.wave * 64 + lane_id(); asm volatile("" : "+v"(Y.tid)); Y.lane = Y.tid & 63; return Y; }

enum { KIND_ID = 0, KIND_WIN, KIND_QUP, KIND_KVUP, KIND_GU, KIND_WO };
struct Cvt { const float* W; const float* W2; const float* gain; bf16_t* dst; int ldw, K, NP, kind; };
__device__ __forceinline__ int cvt_srccol(int kind, int n, int ldw, bool& second) {
    second = false;
    switch (kind) {
    case KIND_WIN:
        if (n < 1024) return n; if (n < 1280) return 1056 + (n - 1024); if (n < 1792) return 1312 + (n - 1280); if (n < 2048) return 1824 + (n - 1792);
        if (n < 2304) return 2080 + (n - 2048); if (n < 2336) return 1024 + (n - 2304); if (n < 2344) return n; return -1;
    case KIND_QUP: return n < 512 ? (n >> 6) * 96 + (n & 63) : ((n - 512) >> 5) * 96 + 64 + ((n - 512) & 31);
    case KIND_KVUP: return n < 512 ? (n >> 6) * 128 + (n & 63) : ((n - 512) >> 6) * 128 + 64 + ((n - 512) & 63);
    case KIND_GU: { const int t = n >> 8, r = n & 255; if (r >= 128) { second = true; return 128 * t + r - 128; } return 128 * t + r; }
    default: return n < ldw ? n : -1;
    }
}
__device__ __forceinline__ void cvt_item(const Cvt& c, int item, LAS float* scr, int lane) {
    const int nblk = c.NP / 32, kb = item / nblk, nb = item % nblk, k0 = 64 * kb, n0 = 32 * nb;
    if (c.kind == KIND_WO && k0 >= 512 && k0 < 768) return;
    bool second; const int sc = cvt_srccol(c.kind, n0 + (lane & 31), c.ldw, second);
    const float* src = second ? c.W2 : c.W;
#pragma unroll 8
    for (int i = 0; i < 32; ++i) { const int kk = 2 * i + (lane >> 5); float v = 0.f; if (sc >= 0) v = src[(size_t)(k0 + kk) * c.ldw + sc]; if (c.gain) v *= c.gain[k0 + kk]; scr[kk * 33 + (lane & 31)] = v; }
    asm volatile("s_waitcnt lgkmcnt(0)" ::: "memory");
    const int ch = lane & 7;
#pragma unroll
    for (int j = 0; j < 4; ++j) { const int n = (lane >> 3) + 8 * j; const LAS float* s = scr + (8 * ch) * 33 + n;
        u32x4 o; o.x = pk2(s[0 * 33], s[1 * 33]); o.y = pk2(s[2 * 33], s[3 * 33]); o.z = pk2(s[4 * 33], s[5 * 33]); o.w = pk2(s[6 * 33], s[7 * 33]);
        *(u32x4*)(c.dst + (size_t)(n0 + n) * c.K + k0 + 8 * ch) = o; }
    asm volatile("s_waitcnt lgkmcnt(0)" ::: "memory");
}
__device__ __forceinline__ int cvt_nitems(const Cvt& c) { return (c.K / 64) * (c.NP / 32); }
__device__ __forceinline__ void pool_prep_item(const Ctx& X, int l, int item) {
    const int g = item >> 4, nb = item & 15, n = nb * 64 + X.lane;
    const float* pw = inp(IN_POOL_W) + ((size_t)l * 4 + g) * 4096; const float* ps = inp(IN_POOL_SCALE) + l * 256 + g * 64;
    const float* wo = inp(IN_W_OUT) + (size_t)l * DM * DM + (size_t)(512 + 64 * g) * DM + n;
    bf16_t* dst = (bf16_t*)(X.ws + WS_WMIX + (size_t)l * SZ_WMIX + SZ_WIN + SZ_WQ + SZ_WKV) + (size_t)n * DM + 512 + 64 * g;
    float wv[64];
#pragma unroll
    for (int d = 0; d < 64; ++d) wv[d] = ps[d] * wo[(size_t)d * DM];
#pragma unroll 1
    for (int c8 = 0; c8 < 8; ++c8) {
        float o[8];
#pragma unroll
        for (int cc = 0; cc < 8; ++cc) { const float* pr = pw + (c8 * 8 + cc) * 64; float s = 0.f;
#pragma unroll
            for (int d = 0; d < 64; ++d) s += pr[d] * wv[d];
            o[cc] = s; }
        u32x4 w; w.x = pk2(o[0], o[1]); w.y = pk2(o[2], o[3]); w.z = pk2(o[4], o[5]); w.w = pk2(o[6], o[7]);
        *(u32x4*)(dst + c8 * 8) = w;
    }
}
__device__ __forceinline__ float wave_sum(float v) {
#pragma unroll
    for (int o = 1; o < 64; o <<= 1) v += __shfl_xor(v, o);
    return v;
}
__device__ __forceinline__ void moe_convert(const Ctx& X, int lm) {
    const float* fg = inp(IN_FFN_NORM) + (2 * lm + 1) * DM;
    LAS float* scr = (LAS float*)(X.lds + X.wave * 8448);
    const int gw = X.bid * 8 + X.wave, NGW = X.G * 8;
    constexpr int NI_GU = (DM / 64) * (2 * DFFE / 32), NI_D = (DFFE / 64) * (DM / 32), NI_E = NI_GU + NI_D;
    for (int it = gw; it < NEXP * NI_E; it += NGW) {
        const int e = it / NI_E, r = it % NI_E; Cvt c;
        if (r < NI_GU) { c.W = inp(IN_MGATE) + ((size_t)lm * NEXP + e) * DM * DFFE; c.W2 = inp(IN_MUP) + ((size_t)lm * NEXP + e) * DM * DFFE; c.gain = fg;
            c.dst = (bf16_t*)(X.ws + WS_WMOE + (size_t)e * SZ_EXP); c.ldw = DFFE; c.K = DM; c.NP = 2 * DFFE; c.kind = KIND_GU; cvt_item(c, r, scr, X.lane); }
        else { c.W = inp(IN_MDOWN) + ((size_t)lm * NEXP + e) * DFFE * DM; c.W2 = nullptr; c.gain = nullptr;
            c.dst = (bf16_t*)(X.ws + WS_WMOE + (size_t)e * SZ_EXP + SZ_EGU); c.ldw = DM; c.K = DFFE; c.NP = DM; c.kind = KIND_ID; cvt_item(c, r - NI_GU, scr, X.lane); }
    }
}
__device__ __forceinline__ void prologue(const Ctx& X) {
        LAS float* scr = (LAS float*)(X.lds + X.wave * 8448);
    const int gw = X.bid * 8 + X.wave, NGW = X.G * 8;
    constexpr int NI_WIN = (DM / 64) * (DINP / 32), NI_WQ = (QLORA / 64) * (768 / 32), NI_WKV = (KVLORA / 64) * (1024 / 32), NI_WO = (DM / 64) * (DM / 32);
    constexpr int NI_MIX = NI_WIN + NI_WQ + NI_WKV + NI_WO;
    constexpr int NI_DGU = (DM / 64) * (2 * DFF / 32), NI_DD = (DFF / 64) * (DM / 32), NI_DENSE = NI_DGU + NI_DD;
    for (int it = gw; it < DEPTH * NI_MIX + 2 * NI_DENSE; it += NGW) {
        Cvt c; c.W2 = nullptr; c.gain = nullptr;
        if (it < DEPTH * NI_MIX) {
            const int l = it / NI_MIX; int r = it % NI_MIX; unsigned char* wb = X.ws + WS_WMIX + (size_t)l * SZ_WMIX;
            if (r < NI_WIN) { c.W = inp(IN_W_IN) + (size_t)l * DM * DIN; c.gain = inp(IN_ATTN_NORM) + l * DM; c.dst = (bf16_t*)wb; c.ldw = DIN; c.K = DM; c.NP = DINP; c.kind = KIND_WIN; }
            else if ((r -= NI_WIN) < NI_WQ) { c.W = inp(IN_W_Q_UP) + (size_t)l * QLORA * 768; c.gain = inp(IN_Q_NORM) + l * QLORA; c.dst = (bf16_t*)(wb + SZ_WIN); c.ldw = 768; c.K = QLORA; c.NP = 768; c.kind = KIND_QUP; }
            else if ((r -= NI_WQ) < NI_WKV) { c.W = inp(IN_W_KV_UP) + (size_t)l * KVLORA * 1024; c.gain = inp(IN_KV_NORM) + l * KVLORA; c.dst = (bf16_t*)(wb + SZ_WIN + SZ_WQ); c.ldw = 1024; c.K = KVLORA; c.NP = 1024; c.kind = KIND_KVUP; }
            else { r -= NI_WKV; c.W = inp(IN_W_OUT) + (size_t)l * DM * DM; c.dst = (bf16_t*)(wb + SZ_WIN + SZ_WQ + SZ_WKV); c.ldw = DM; c.K = DM; c.NP = DM; c.kind = KIND_WO; }
            cvt_item(c, r, scr, X.lane);
        } else {
            const int q = it - DEPTH * NI_MIX, j = q / NI_DENSE; int r = q % NI_DENSE; unsigned char* wb = X.ws + WS_WDENSE + (size_t)j * SZ_DENSE;
            if (r < NI_DGU) { c.W = inp(IN_DGATE) + (size_t)j * DM * DFF; c.W2 = inp(IN_DUP) + (size_t)j * DM * DFF; c.gain = inp(IN_FFN_NORM) + (2 * j) * DM; c.dst = (bf16_t*)wb; c.ldw = DFF; c.K = DM; c.NP = 2 * DFF; c.kind = KIND_GU; }
            else { r -= NI_DGU; c.W = inp(IN_DDOWN) + (size_t)j * DFF * DM; c.dst = (bf16_t*)(wb + SZ_DGU); c.ldw = DM; c.K = DFF; c.NP = DM; c.kind = KIND_ID; }
            cvt_item(c, r, scr, X.lane);
        }
    }
    for (int it = gw; it < DEPTH * 64; it += NGW) pool_prep_item(X, it >> 6, it & 63);
    { float* rope = (float*)(X.ws + WS_ROPE); const int gt = X.bid * 512 + X.tid, NT = X.G * 512;
      for (int i = gt; i < LTOT * 16; i += NT) { const int pos = i >> 4, j = i & 15; const float inv = powf(10000.0f, -(float)(2 * j) / 32.0f); const float ang = (float)pos * inv;
          rope[pos * 32 + j] = cosf(ang); rope[pos * 32 + 16 + j] = sinf(ang); }
      float* gr = (float*)(X.ws + WS_ROUTER);
      for (int i = gt; i < 2 * DM * NEXP; i += NT) { const int lm = i / (DM * NEXP), k = (i / NEXP) % DM; gr[i] = inp(IN_ROUTER)[i] * inp(IN_FFN_NORM)[(2 * lm + 1) * DM + k]; } }
    { bf16_t* h = (bf16_t*)(X.ws + WS_H); u64* ss0 = X.ss(0);
      for (int row = gw; row < MREAL; row += NGW) {
          const float* src = row < MMAIN ? inp(IN_X) + (size_t)row * DM : inp(IN_META) + (size_t)(row - MMAIN) * DM;
          float s = 0.f;
#pragma unroll
          for (int j = 0; j < 4; ++j) { const f32x4 v = *(const f32x4*)(src + j * 256 + X.lane * 4); u32x2 w; w.x = pk2(v[0], v[1]); w.y = pk2(v[2], v[3]);
              *(u32x2*)(h + (size_t)row * DM + j * 256 + X.lane * 4) = w; s += (bflo(w.x) * bflo(w.x) + bfhi(w.x) * bfhi(w.x)) + (bflo(w.y) * bflo(w.y) + bfhi(w.y) * bfhi(w.y)); }
          s = wave_sum(s); if (X.lane == 0) ss0[row] = ss_fix(s);
      } }
    moe_convert(X, 0);
}
typedef f32x4 AccT[2][2][4][2];
#define EPI_ROWS_BEGIN  _Pragma("unroll") for (int ai = 0; ai < 2; ++ai) _Pragma("unroll") for (int m = 0; m < 4; ++m) { const int row = row0 + ai * 128 + m * 16;
#define EPI_ROWS_END    }
template <class T> __device__ __forceinline__ T ldo(const void* base, unsigned off) { return *(const T*)((const char*)base + off); }
template <class T> __device__ __forceinline__ void sto(void* base, unsigned off, T v) { *(T*)((char*)base + off) = v; }
__device__ __forceinline__ u32x2 bf4(f32x4 v) { u32x2 w; w.x = pk2(v[0], v[1]); w.y = pk2(v[2], v[3]); return w; }
__device__ __forceinline__ u32x4 bf8(f32x4 a, f32x4 b) { u32x4 w; w.x = pk2(a[0], a[1]); w.y = pk2(a[2], a[3]); w.z = pk2(b[0], b[1]); w.w = pk2(b[2], b[3]); return w; }
__device__ __forceinline__ float sq4(f32x4 v) { return (v[0] * v[0] + v[1] * v[1]) + (v[2] * v[2] + v[3] * v[3]); }
__device__ __forceinline__ float red_fq(float s) { s += __shfl_xor(s, 16); s += __shfl_xor(s, 32); return s; }
__device__ __forceinline__ float sqw(unsigned w) { return bflo(w) * bflo(w) + bfhi(w) * bfhi(w); }
#define EPI_LAUNDER int fr = fr_, fq = fq_; asm volatile("" : "+v"(fr), "+v"(fq));
constexpr size_t SSOFF(int idx) { return CTL_SS_B + (size_t)idx * SS_BYTES; }

struct EpiWin {
    static constexpr bool PERM = false;
    unsigned char* ws; int l;
    __device__ __forceinline__ void operator()(const AccT& acc, const pg8::Unit& u, int wr, int wc, int fr_, int fq_) const {
        EPI_LAUNDER
        const int row0 = u.pm * 256 + wr * 64 + fr, pn = u.pn;
        const unsigned char* ssin = ws + CTL_SS_B + (size_t)(4 * l) * SS_BYTES;
        if (pn <= 8) {
            unsigned char* dst; int pitch, coff; unsigned char* ssacc = nullptr;
            if (pn < 3) { dst = ws + WS_S + S_CQ; pitch = QLORA; coff = pn * 256; ssacc = ws + CTL_SS_B + (size_t)(4 * l + 1) * SS_BYTES; }
            else if (pn == 3) { dst = ws + WS_S + S_CKV; pitch = 256; coff = 0; ssacc = ws + CTL_SS_B + (size_t)(4 * l + 2) * SS_BYTES; }
            else if (pn == 4) { dst = ws + WS_S + S_XP; pitch = 256; coff = 0; }
            else if (pn <= 6) { dst = ws + WS_S + S_MQK; pitch = 512; coff = (pn - 5) * 256; }
            else if (pn == 7) { dst = ws + WS_S + S_MV; pitch = 256; coff = 0; }
            else { dst = ws + WS_S + S_MO; pitch = 256; coff = 0; }
            EPI_ROWS_BEGIN
                const float r = rstd_of(ldo<u64>(ssin, (unsigned)row * 8u), 1.0f / DM); float s = 0.f;
                const unsigned ro = ((unsigned)row * (unsigned)pitch + (unsigned)(coff + wc * 32 + fq * 4)) * 2u;
#pragma unroll
                for (int bj = 0; bj < 2; ++bj)
#pragma unroll
                    for (int n = 0; n < 2; ++n) { const f32x4 v = acc[ai][bj][m][n] * r; s += sq4(v); sto<u32x2>(dst, ro + (bj * 128 + n * 16) * 2, bf4(v)); }
                if (ssacc) { s = red_fq(s); if (fq == 0) atomicAdd((u64*)(ssacc + (unsigned)row * 8u), ss_fix(s)); }
            EPI_ROWS_END
        } else {
            if (wc == 0) {
                const unsigned char* rope = ws + WS_ROPE; unsigned char* zkr = ws + WS_S + S_KR;
                EPI_ROWS_BEGIN
                    const float r = rstd_of(ldo<u64>(ssin, (unsigned)row * 8u), 1.0f / DM);
                    const f32x4 x1 = acc[ai][0][m][0] * r, x2 = acc[ai][0][m][1] * r;
                    const unsigned co = ((unsigned)rowpos(row) * 32u + fq * 4) * 4u;
                    const f32x4 c = ldo<f32x4>(rope, co), sn = ldo<f32x4>(rope, co + 64);
                    sto<u32x2>(zkr, ((unsigned)row * 32u + fq * 4) * 2u, bf4(x1 * c - x2 * sn));
                    sto<u32x2>(zkr, ((unsigned)row * 32u + 16 + fq * 4) * 2u, bf4(x2 * c + x1 * sn));
                EPI_ROWS_END
            } else if (wc == 1) {
                if (fq < 2) {
                    const f32x4 gb = *(const f32x4*)(inp(IN_GATE_BIAS) + l * 8 + fq * 4); unsigned char* gates = ws + WS_S + S_GATES;
                    EPI_ROWS_BEGIN
                        const float r = rstd_of(ldo<u64>(ssin, (unsigned)row * 8u), 1.0f / DM);
                        sto<f32x4>(gates, ((unsigned)row * 8u + fq * 4) * 4u, acc[ai][0][m][0] * r + gb);
                    EPI_ROWS_END
                }
            }
        }
    }
};
struct EpiQ {
    static constexpr bool PERM = false;
    unsigned char* ws; int l;
    __device__ __forceinline__ void operator()(const AccT& acc, const pg8::Unit& u, int wr, int wc, int fr_, int fq_) const {
        EPI_LAUNDER
        const int row0 = u.pm * 256 + wr * 64 + fr, pn = u.pn;
        const unsigned char* ssin = ws + CTL_SS_B + (size_t)(4 * l + 1) * SS_BYTES; unsigned char* q = ws + WS_S + S_Q; const unsigned char* rope = ws + WS_ROPE;
        EPI_ROWS_BEGIN
            const float r = rstd_of(ldo<u64>(ssin, (unsigned)row * 8u), 1.0f / QLORA) * QSCALE;
            const unsigned ro = ((unsigned)row * 768u + (unsigned)(pn * 256 + wc * 32 + fq * 4)) * 2u;
            if (pn < 2) {
#pragma unroll
                for (int bj = 0; bj < 2; ++bj)
#pragma unroll
                    for (int n = 0; n < 2; ++n) sto<u32x2>(q, ro + (bj * 128 + n * 16) * 2, bf4(acc[ai][bj][m][n] * r));
            } else {
                const unsigned co = ((unsigned)rowpos(row) * 32u + fq * 4) * 4u;
                const f32x4 c = ldo<f32x4>(rope, co), sn = ldo<f32x4>(rope, co + 64);
#pragma unroll
                for (int bj = 0; bj < 2; ++bj) { const f32x4 x1 = acc[ai][bj][m][0] * r, x2 = acc[ai][bj][m][1] * r;
                    sto<u32x2>(q, ro + bj * 256, bf4(x1 * c - x2 * sn)); sto<u32x2>(q, ro + bj * 256 + 32, bf4(x2 * c + x1 * sn)); }
            }
        EPI_ROWS_END
    }
};
struct EpiKV {
    static constexpr bool PERM = true;
    unsigned char* ws; int l;
    __device__ __forceinline__ void operator()(const AccT& acc, const pg8::Unit& u, int wr, int wc, int fr_, int fq_) const {
        EPI_LAUNDER
        const int row0 = u.pm * 256 + wr * 64 + fr, pn = u.pn;
        const unsigned char* ssin = ws + CTL_SS_B + (size_t)(4 * l + 2) * SS_BYTES;
        unsigned char* dst = ws + WS_S + ((pn < 2) ? S_KN : S_V); const int coff = (pn & 1) * 256 + wc * 32 + fq * 8;
        EPI_ROWS_BEGIN
            const float r = rstd_of(ldo<u64>(ssin, (unsigned)row * 8u), 1.0f / KVLORA);
            const unsigned ro = ((unsigned)row * 512u + (unsigned)coff) * 2u;
#pragma unroll
            for (int bj = 0; bj < 2; ++bj) sto<u32x4>(dst, ro + bj * 256, bf8(acc[ai][bj][m][0] * r, acc[ai][bj][m][1] * r));
        EPI_ROWS_END
    }
};
struct EpiRes {
    static constexpr bool PERM = true;
    unsigned char* ws; int ssidx;
    __device__ __forceinline__ void operator()(const AccT& acc, const pg8::Unit& u, int wr, int wc, int fr_, int fq_) const {
        EPI_LAUNDER
        const int row0 = u.pm * 256 + wr * 64 + fr, pn = u.pn;
        unsigned char* h = ws + WS_H; unsigned char* ssout = ws + CTL_SS_B + (size_t)ssidx * SS_BYTES;
        EPI_ROWS_BEGIN
            const unsigned ro = ((unsigned)row * (unsigned)DM + (unsigned)(pn * 256 + wc * 32 + fq * 8)) * 2u; float s = 0.f;
#pragma unroll
            for (int bj = 0; bj < 2; ++bj) {
                const u32x4 o = ldo<u32x4>(h, ro + bj * 256);
                const f32x4 a = acc[ai][bj][m][0], b = acc[ai][bj][m][1];
                u32x4 w;
                w.x = pk2(bflo(o.x) + a[0], bfhi(o.x) + a[1]); w.y = pk2(bflo(o.y) + a[2], bfhi(o.y) + a[3]);
                w.z = pk2(bflo(o.z) + b[0], bfhi(o.z) + b[1]); w.w = pk2(bflo(o.w) + b[2], bfhi(o.w) + b[3]);
                sto<u32x4>(h, ro + bj * 256, w);
                s += (sqw(w.x) + sqw(w.y)) + (sqw(w.z) + sqw(w.w));
            }
            s = red_fq(s); if (fq == 0) atomicAdd((u64*)(ssout + (unsigned)row * 8u), ss_fix(s));
        EPI_ROWS_END
    }
};
struct EpiGU {
    static constexpr bool PERM = true;
    unsigned char* ws; int ssidx;
    __device__ __forceinline__ void operator()(const AccT& acc, const pg8::Unit& u, int wr, int wc, int fr_, int fq_) const {
        EPI_LAUNDER
        const int row0 = u.pm * 256 + wr * 64 + fr, pn = u.pn;
        const unsigned char* ssin = ws + CTL_SS_B + (size_t)ssidx * SS_BYTES; unsigned char* act = ws + WS_S + S_ACT;
        EPI_ROWS_BEGIN
            const float r = rstd_of(ldo<u64>(ssin, (unsigned)row * 8u), 1.0f / DM);
            f32x4 o[2];
#pragma unroll
            for (int n = 0; n < 2; ++n) { const f32x4 g = acc[ai][0][m][n] * r, uu = acc[ai][1][m][n] * r;
#pragma unroll
                for (int e = 0; e < 4; ++e) o[n][e] = siluf_(g[e]) * uu[e]; }
            sto<u32x4>(act, ((unsigned)row * (unsigned)DFF + (unsigned)(pn * 128 + wc * 32 + fq * 8)) * 2u, bf8(o[0], o[1]));
        EPI_ROWS_END
    }
};
struct EpiMoeGU {
    static constexpr bool PERM = true;
    unsigned char* ws; int blk0;
    __device__ __forceinline__ void operator()(const AccT& acc, const pg8::Unit& u, int wr, int wc, int fr_, int fq_) const {
        EPI_LAUNDER
        const int row0 = wr * 64 + fr, pn = u.pn;
        const unsigned char* srstd = ws + WS_S + S_SRSTD; unsigned char* act = ws + WS_S + S_ACTE;
        EPI_ROWS_BEGIN
            const float r = ldo<float>(srstd, ((unsigned)u.pm * 256u + row) * 4u);
            f32x4 o[2];
#pragma unroll
            for (int n = 0; n < 2; ++n) { const f32x4 g = acc[ai][0][m][n] * r, uu = acc[ai][1][m][n] * r;
#pragma unroll
                for (int e = 0; e < 4; ++e) o[n][e] = siluf_(g[e]) * uu[e]; }
            sto<u32x4>(act, (((unsigned)(u.pm - blk0) * 256u + row) * (unsigned)DFFE + (unsigned)(pn * 128 + wc * 32 + fq * 8)) * 2u, bf8(o[0], o[1]));
        EPI_ROWS_END
    }
};
struct EpiMoeDown {
    static constexpr bool PERM = true;
    unsigned char* ws;
    __device__ __forceinline__ void operator()(const AccT& acc, const pg8::Unit& u, int wr, int wc, int fr_, int fq_) const {
        EPI_LAUNDER
        const int row0 = wr * 64 + fr, pn = u.pn;
        const unsigned char* sslot = ws + WS_S + S_SSLOT; const unsigned char* sgate = ws + WS_S + S_SGATE; unsigned char* y = ws + WS_S + S_Y;
        EPI_ROWS_BEGIN
            const unsigned so = ((unsigned)u.pm * 256u + row) * 4u;
            const int slot = ldo<int>(sslot, so); const float g = ldo<float>(sgate, so);
            if (slot >= 0) {
                const unsigned ro = ((unsigned)slot * (unsigned)DM + (unsigned)(pn * 256 + wc * 32 + fq * 8)) * 2u;
#pragma unroll
                for (int bj = 0; bj < 2; ++bj) sto<u32x4>(y, ro + bj * 256, bf8(acc[ai][bj][m][0] * g, acc[ai][bj][m][1] * g));
            }
        EPI_ROWS_END
    }
};
struct MixP { const bf16_t *q, *kn, *v, *kr, *xp, *mqk, *mv, *mo; const float* gates; bf16_t* cat; const float *conv_w, *conv_b, *mnorm; };
#define MFMA32(a, b, c) __builtin_amdgcn_mfma_f32_32x32x16_bf16((a), (b), (c), 0, 0, 0)
__device__ __forceinline__ int crow(int r, int hi) { return (r & 3) + 8 * (r >> 2) + 4 * hi; }
__device__ __forceinline__ float swap_max(float m) { auto rr = __builtin_amdgcn_permlane32_swap(__float_as_uint(m), __float_as_uint(m), false, false); return fmaxf(__uint_as_float(rr[0]), __uint_as_float(rr[1])); }
__device__ __forceinline__ float swap_sum(float m) { auto rr = __builtin_amdgcn_permlane32_swap(__float_as_uint(m), __float_as_uint(m), false, false); return __uint_as_float(rr[0]) + __uint_as_float(rr[1]); }
__device__ __forceinline__ s16x4 vtr(const LAS char* p) { typedef short v4i16_t __attribute__((ext_vector_type(4))); return __builtin_bit_cast(s16x4, __builtin_amdgcn_ds_read_tr16_b64_v4i16((LAS v4i16_t*)p)); }

constexpr int AK_PITCH = 208, AK_BYTES = 64 * AK_PITCH, A_K0 = 0, A_V0 = 2 * AK_BYTES, A_WS = A_V0 + 2 * 8192, A_OST = A_WS + 8 * 256, A_END = A_OST + 8 * 4096;
static_assert(A_END <= RING_BYTES, "attention LDS");

__device__ __forceinline__ void attn_ld(const MixP& P, int b, int hd, int j, int tid, u32x4& k0, u32x4& k1, u32x4& v0) {
    const int rowbase = (j == 0) ? MMAIN : b * SEQ + 64 * (j - 1), valid = (j == 0) ? 16 : 64;
    const u32x4 z = {0u, 0u, 0u, 0u}; k0 = z; k1 = z; v0 = z;
    { const int key = tid / 12, ch = tid % 12;
      if (key < valid) k0 = ch < 8 ? *(const u32x4*)(P.kn + (size_t)(rowbase + key) * 512 + hd * 64 + ch * 8) : *(const u32x4*)(P.kr + (size_t)(rowbase + key) * 32 + (ch - 8) * 8); }
    if (tid < 256) { const int id = tid + 512, key = id / 12, ch = id % 12;
      if (key < valid) k1 = ch < 8 ? *(const u32x4*)(P.kn + (size_t)(rowbase + key) * 512 + hd * 64 + ch * 8) : *(const u32x4*)(P.kr + (size_t)(rowbase + key) * 32 + (ch - 8) * 8); }
    { const int key = tid >> 3, ch = tid & 7; if (key < valid) v0 = *(const u32x4*)(P.v + (size_t)(rowbase + key) * 512 + hd * 64 + ch * 8); }
}
__device__ __forceinline__ void attn_st(LAS unsigned char* lds, int buf, int tid, const u32x4& k0, const u32x4& k1, const u32x4& v0) {
    LAS unsigned char* kb = lds + A_K0 + buf * AK_BYTES; LAS unsigned char* vb = lds + A_V0 + buf * 8192;
    { const int key = tid / 12, ch = tid % 12; *(LAS u32x4*)(kb + key * AK_PITCH + ch * 16) = k0; }
    if (tid < 256) { const int id = tid + 512, key = id / 12, ch = id % 12; *(LAS u32x4*)(kb + key * AK_PITCH + ch * 16) = k1; }
    { const int key = tid >> 3, ch = tid & 7; *(LAS u32x4*)(vb + (ch >> 2) * 4096 + (key >> 4) * 1024 + (key & 15) * 64 + (ch & 3) * 16) = v0; }
}
__device__ __forceinline__ void attn_unit(LAS unsigned char* lds, const MixP& P, int tid_, int b, int hd, int qt) {
    int tid = tid_; asm volatile("" : "+v"(tid));
    const int lane = tid & 63, wid = __builtin_amdgcn_readfirstlane(tid >> 6), r32 = lane & 31, hh = lane >> 5;
    const bool meta = qt < 0;
    const int qbase = meta ? MMAIN + wid * 32 : b * SEQ + qt * 256 + wid * 32;
    const int cw = meta ? 0 : qt * 4 + (wid >> 1) + 1, NT = meta ? 1 : qt * 4 + 5;
    const bool active = !meta || wid == 0;
    bf16x8 qf[6];
    { const bf16_t* qr = P.q + (size_t)(qbase + r32) * 768;
#pragma unroll
      for (int d0 = 0; d0 < 4; ++d0) qf[d0] = *(const bf16x8*)(qr + hd * 64 + d0 * 16 + hh * 8);
#pragma unroll
      for (int d0 = 0; d0 < 2; ++d0) qf[4 + d0] = *(const bf16x8*)(qr + 512 + hd * 32 + d0 * 16 + hh * 8); }
    f32x16 o0, o1;
#pragma unroll
    for (int i = 0; i < 16; ++i) { o0[i] = 0.f; o1[i] = 0.f; }
    float m_run = -1e30f, l_run = 0.f;
    LAS float* wsf = (LAS float*)(lds + A_WS + wid * 256);
    u32x4 k0, k1, v0;
    attn_ld(P, b, hd, 0, tid, k0, k1, v0); attn_st(lds, 0, tid, k0, k1, v0);
    __syncthreads();
    for (int j = 0; j < NT; ++j) {
        if (j + 1 < NT) attn_ld(P, b, hd, j + 1, tid, k0, k1, v0);
        if (active && j <= cw) {
            const LAS unsigned char* Kb = lds + A_K0 + (j & 1) * AK_BYTES; const LAS char* Vb = (const LAS char*)(lds + A_V0 + (j & 1) * 8192);
            f32x16 p0, p1;
#pragma unroll
            for (int i = 0; i < 16; ++i) { p0[i] = 0.f; p1[i] = 0.f; }
#pragma unroll
            for (int d0 = 0; d0 < 6; ++d0) {
                const bf16x8 a0 = *(const LAS bf16x8*)(Kb + r32 * AK_PITCH + (2 * d0 + hh) * 16);
                const bf16x8 a1 = *(const LAS bf16x8*)(Kb + (32 + r32) * AK_PITCH + (2 * d0 + hh) * 16);
                p0 = MFMA32(a0, qf[d0], p0); p1 = MFMA32(a1, qf[d0], p1);
            }
            if (j == 0) {
#pragma unroll
                for (int i = 0; i < 16; ++i) { if (i >= 8) p0[i] = -1e30f; p1[i] = -1e30f; }
            }
            float mx = fmaxf(p0[0], p1[0]);
#pragma unroll
            for (int i = 1; i < 16; ++i) mx = fmaxf(mx, fmaxf(p0[i], p1[i]));
            mx = swap_max(mx);
            if (__any(mx > m_run)) {
                const float m_new = fmaxf(m_run, mx), sc = fexp2(m_run - m_new);
                l_run *= sc; m_run = m_new;
                if (hh == 0) wsf[r32] = sc;
#pragma unroll
                for (int i = 0; i < 16; ++i) { const float f = wsf[crow(i, hh)]; o0[i] *= f; o1[i] *= f; }
            }
            float ls = 0.f;
#pragma unroll
            for (int i = 0; i < 16; ++i) { p0[i] = fexp2(p0[i] - m_run); p1[i] = fexp2(p1[i] - m_run); ls += p0[i] + p1[i]; }
            l_run += ls;
            const int q4 = (lane & 15) >> 2, p4 = lane & 3, blk = (lane >> 4) & 1;
            const LAS char* vp = Vb + (4 * hh + q4) * 64 + blk * 32 + p4 * 8;
#pragma unroll
            for (int s = 0; s < 4; ++s) {
                u32x4 pw;
                if (s < 2) { pw.x = pk2(p0[8 * s], p0[8 * s + 1]); pw.y = pk2(p0[8 * s + 2], p0[8 * s + 3]); pw.z = pk2(p0[8 * s + 4], p0[8 * s + 5]); pw.w = pk2(p0[8 * s + 6], p0[8 * s + 7]); }
                else { const int t = s - 2; pw.x = pk2(p1[8 * t], p1[8 * t + 1]); pw.y = pk2(p1[8 * t + 2], p1[8 * t + 3]); pw.z = pk2(p1[8 * t + 4], p1[8 * t + 5]); pw.w = pk2(p1[8 * t + 6], p1[8 * t + 7]); }
                const bf16x8 pa = __builtin_bit_cast(bf16x8, pw);
                { const s16x4 lo = vtr(vp + s * 1024), hi = vtr(vp + s * 1024 + 512);
                  const bf16x8 vf = {lo[0], lo[1], lo[2], lo[3], hi[0], hi[1], hi[2], hi[3]}; o0 = MFMA32(pa, vf, o0); }
                { const s16x4 lo = vtr(vp + 4096 + s * 1024), hi = vtr(vp + 4096 + s * 1024 + 512);
                  const bf16x8 vf = {lo[0], lo[1], lo[2], lo[3], hi[0], hi[1], hi[2], hi[3]}; o1 = MFMA32(pa, vf, o1); }
            }
        }
        if (j + 1 < NT) attn_st(lds, (j + 1) & 1, tid, k0, k1, v0);
        __syncthreads();
    }
    if (active) {
        const float lt = swap_sum(l_run);
        if (hh == 0) wsf[32 + r32] = lt;
        LAS bf16_t* stg = (LAS bf16_t*)(lds + A_OST + wid * 4096);
#pragma unroll
        for (int i = 0; i < 16; ++i) { const int orow = crow(i, hh); const float rl = frcp(wsf[32 + orow]);
            stg[orow * 64 + r32] = (bf16_t)f2bf(o0[i] * rl); stg[orow * 64 + 32 + r32] = (bf16_t)f2bf(o1[i] * rl); }
        const int nvalid = meta ? 16 : 32;
#pragma unroll
        for (int it = 0; it < 4; ++it) { const int row = it * 8 + (lane >> 3), ch = lane & 7; const u32x4 val = *(const LAS u32x4*)(stg + row * 64 + ch * 8);
            if (row < nvalid) *(u32x4*)(P.cat + (size_t)(qbase + row) * DM + hd * 64 + ch * 8) = val; }
    }
    __syncthreads();
}

__device__ __forceinline__ void pool_unit(const MixP& P, int tid_, int b, int grp) {
    int tid = tid_; asm volatile("" : "+v"(tid));
    const int t = tid >> 3, seg = tid & 7, g = seg >> 1, w = 2 << g;
    const int pos = (grp == 0) ? t : NMETA + 64 * (grp - 1) + t;
    if (grp == 0 && t >= NMETA) return;
    const int row = seqrow(b, pos), cnt = (pos + 1 < w) ? pos + 1 : w; const float inv = 1.0f / (float)cnt;
#pragma unroll 1
    for (int pc = 0; pc < 4; ++pc) {
        const int ch = seg * 32 + pc * 8; float a[8];
#pragma unroll
        for (int e = 0; e < 8; ++e) a[e] = 0.f;
        u32x4 self = {0u, 0u, 0u, 0u};
        for (int jj = 0; jj < cnt; ++jj) { const u32x4 x = *(const u32x4*)(P.xp + (size_t)seqrow(b, pos - jj) * 256 + ch); if (jj == 0) self = x;
            a[0] += bflo(x.x); a[1] += bfhi(x.x); a[2] += bflo(x.y); a[3] += bfhi(x.y); a[4] += bflo(x.z); a[5] += bfhi(x.z); a[6] += bflo(x.w); a[7] += bfhi(x.w); }
        u32x4 o; o.x = pk2(a[0] * inv - bflo(self.x), a[1] * inv - bfhi(self.x)); o.y = pk2(a[2] * inv - bflo(self.y), a[3] * inv - bfhi(self.y));
        o.z = pk2(a[4] * inv - bflo(self.z), a[5] * inv - bfhi(self.z)); o.w = pk2(a[6] * inv - bflo(self.w), a[7] * inv - bfhi(self.w));
        *(u32x4*)(P.cat + (size_t)row * DM + 512 + ch) = o;
    }
}

constexpr int ML_Q = 0, ML_K = ML_Q + 16 * 64 * 4, ML_V = ML_K + 16 * 65 * 4, ML_MO = ML_V + 16 * 64 * 4, ML_SX = ML_MO + 16 * 64 * 4, ML_H = ML_SX + 16 * 16 * 4, ML_N = ML_H + 16 * 64 * 4,
              ML_LF = ML_N + 256, ML_LI = ML_LF + 64, ML_NQ = ML_LI + 64, ML_WG = ML_NQ + 64, ML_SC = ML_WG + 64, ML_END = ML_SC + 64;
__device__ __forceinline__ float log_sigmoid_(float x) { return fminf(x, 0.f) - log1pf(__expf(-fabsf(x))); }
__device__ __forceinline__ void mlstm_unit(LAS unsigned char* lds, const MixP& P, int tid_, int b, int hd) {
    int tid = tid_; asm volatile("" : "+v"(tid));
    const int v = tid >> 3, ksg = tid & 7;
    LAS float* qs = (LAS float*)(lds + ML_Q); LAS float* ks = (LAS float*)(lds + ML_K); LAS float* vs = (LAS float*)(lds + ML_V); LAS float* mos = (LAS float*)(lds + ML_MO);
    LAS float* Sx = (LAS float*)(lds + ML_SX); LAS float* hb = (LAS float*)(lds + ML_H); LAS float* nst = (LAS float*)(lds + ML_N);
    LAS float* lf = (LAS float*)(lds + ML_LF); LAS float* li = (LAS float*)(lds + ML_LI); LAS float* nq = (LAS float*)(lds + ML_NQ); LAS float* wg = (LAS float*)(lds + ML_WG); LAS float* sc = (LAS float*)(lds + ML_SC);
    float C[8];
#pragma unroll
    for (int j = 0; j < 8; ++j) C[j] = 0.f;
    if (tid < 64) nst[tid] = 0.f;
    float m = 0.f;
    const int ct = tid >> 5, cc = (tid & 31) * 4;
    const int gcol = (cc < 64) ? hd * 64 + cc : 256 + hd * 64 + (cc - 64);
    f32x4 cw4[4], cb4;
#pragma unroll
    for (int j = 0; j < 4; ++j) cw4[j] = *(const f32x4*)(P.conv_w + j * 512 + gcol);
    cb4 = *(const f32x4*)(P.conv_b + gcol);
    __syncthreads();
    for (int c = 0; c <= 128; ++c) {
        const int pos0 = 16 * c;
        { const int pos = pos0 + ct; f32x4 a = cb4;
#pragma unroll
          for (int j = 0; j < 4; ++j) { const int pp = pos - 3 + j; if (pp >= 0) { const u32x2 x = *(const u32x2*)(P.mqk + (size_t)seqrow(b, pp) * 512 + gcol);
              a[0] += cw4[j][0] * bflo(x.x); a[1] += cw4[j][1] * bfhi(x.x); a[2] += cw4[j][2] * bflo(x.y); a[3] += cw4[j][3] * bfhi(x.y); } }
#pragma unroll
          for (int e = 0; e < 4; ++e) a[e] = siluf_(a[e]);
          if (cc < 64) { *(LAS f32x4*)(qs + ct * 64 + cc) = a; } else { ks[ct * 65 + cc - 64] = a[0] * 0.125f; ks[ct * 65 + cc - 63] = a[1] * 0.125f; ks[ct * 65 + cc - 62] = a[2] * 0.125f; ks[ct * 65 + cc - 61] = a[3] * 0.125f; }
          const int row = seqrow(b, pos), c2 = (tid & 31) * 2;
          const unsigned xv = *(const unsigned*)(P.mv + (size_t)row * 256 + hd * 64 + c2); vs[ct * 64 + c2] = bflo(xv); vs[ct * 64 + c2 + 1] = bfhi(xv);
          const unsigned xo = *(const unsigned*)(P.mo + (size_t)row * 256 + hd * 64 + c2); mos[ct * 64 + c2] = bflo(xo); mos[ct * 64 + c2 + 1] = bfhi(xo);
          if (tid < 16) { const int r2 = seqrow(b, pos0 + tid); li[tid] = P.gates[(size_t)r2 * 8 + hd]; lf[tid] = log_sigmoid_(P.gates[(size_t)r2 * 8 + 4 + hd]); } }
        __syncthreads();
        if (tid < 256) { const int t = tid >> 4, s = tid & 15;
            float bt = 0.f, bs = 0.f, mx = -1e30f, run = 0.f;
            for (int r = 0; r <= t; ++r) { run += lf[r]; if (r == s) bs = run; }
            bt = run; run = 0.f;
            for (int r = 0; r <= t; ++r) { run += lf[r]; mx = fmaxf(mx, bt - run + li[r]); }
            const float mt = fmaxf(bt + m, mx);
            float dot = 0.f;
#pragma unroll 8
            for (int d = 0; d < 64; ++d) dot += qs[t * 64 + d] * ks[s * 65 + d];
            Sx[t * 16 + s] = (s <= t) ? dot * __expf(bt - bs + li[s] - mt) : 0.f;
            if (s == 0) { sc[t] = mt; sc[16 + t] = __expf(bt + m - mt); }
        } else if (tid < 272) { const int t = tid - 256; float d = 0.f;
#pragma unroll 8
            for (int k = 0; k < 64; ++k) d += nst[k] * qs[t * 64 + k];
            nq[t] = d;
        } else if (tid < 288) { const int s = tid - 272; float bl = 0.f, bs = 0.f, mx = -1e30f, run = 0.f;
            for (int r = 0; r < 16; ++r) { run += lf[r]; if (r == s) bs = run; }
            bl = run; run = 0.f;
            for (int r = 0; r < 16; ++r) { run += lf[r]; mx = fmaxf(mx, bl - run + li[r]); }
            const float mn = fmaxf(bl + m, mx);
            wg[s] = __expf(bl - bs + li[s] - mn);
            if (s == 0) { sc[32] = mn; sc[33] = __expf(bl + m - mn); }
        }
        __syncthreads();
        { float sel0 = 0.f, sel1 = 0.f;
#pragma unroll
          for (int t = 0; t < 16; ++t) { float s = 0.f;
#pragma unroll
              for (int j = 0; j < 8; ++j) s += C[j] * qs[t * 64 + ksg * 8 + j];
              s += __shfl_xor(s, 1); s += __shfl_xor(s, 2); s += __shfl_xor(s, 4); if (t == ksg) sel0 = s; if (t == ksg + 8) sel1 = s; }
#pragma unroll
          for (int tt = 0; tt < 2; ++tt) { const int t = ksg + 8 * tt; float num = 0.f, den = 0.f;
#pragma unroll
              for (int s = 0; s < 16; ++s) { const float x = Sx[t * 16 + s]; num += x * vs[s * 64 + v]; den += x; }
              const float dec = sc[16 + t], mt = sc[t];
              num += dec * (tt == 0 ? sel0 : sel1); den += dec * nq[t];
              hb[t * 64 + v] = num / fmaxf(fabsf(den), __expf(-mt)); }
          const float cd = sc[33];
          float vw[16];
#pragma unroll
          for (int s = 0; s < 16; ++s) vw[s] = vs[s * 64 + v] * wg[s];
#pragma unroll
          for (int j = 0; j < 8; ++j) { float a = cd * C[j];
#pragma unroll
              for (int s = 0; s < 16; ++s) a += vw[s] * ks[s * 65 + ksg * 8 + j];
              C[j] = a; }
          m = sc[32]; }
        __syncthreads();
        if (tid < 64) { float a = sc[33] * nst[tid];
#pragma unroll
            for (int s = 0; s < 16; ++s) a += wg[s] * ks[s * 65 + tid];
            nst[tid] = a; }
        { const int t = tid >> 5, vp = (tid & 31) * 2; const float h0 = hb[t * 64 + vp], h1 = hb[t * 64 + vp + 1];
          float s = h0 * h0 + h1 * h1;
          s += __shfl_xor(s, 1); s += __shfl_xor(s, 2); s += __shfl_xor(s, 4); s += __shfl_xor(s, 8); s += __shfl_xor(s, 16);
          const float r = rsqrtf(s * (1.0f / 64.0f) + EPS);
          const float y0 = h0 * r * P.mnorm[hd * 64 + vp] * sigmoidf_(mos[t * 64 + vp]), y1 = h1 * r * P.mnorm[hd * 64 + vp + 1] * sigmoidf_(mos[t * 64 + vp + 1]);
          if (c > 0 || b == 0) *(unsigned*)(P.cat + (size_t)seqrow(b, pos0 + t) * DM + 768 + hd * 64 + vp) = pk2(y0, y1); }
        __syncthreads();
    }
}
constexpr int R1_GR = 0, R1_E = 32768, R1_LP = R1_E + 2048, R1_G = R1_LP + 2048, R1_CNT = R1_G + 2048, R1_BASE = R1_CNT + 64, R1_END = R1_BASE + 64;
__device__ __forceinline__ void moe_route(const Ctx& X, int l) {
    const int lm = l >> 1, tid = X.tid, lane = X.lane, wid = X.wave;
    LAS float* gr = (LAS float*)(X.lds + R1_GR); LAS int* le = (LAS int*)(X.lds + R1_E); LAS int* lp = (LAS int*)(X.lds + R1_LP); LAS float* lg = (LAS float*)(X.lds + R1_G);
    LAS unsigned* lcnt = (LAS unsigned*)(X.lds + R1_CNT); LAS unsigned* lbase = (LAS unsigned*)(X.lds + R1_BASE);
    const float* grg = (const float*)(X.ws + WS_ROUTER) + (size_t)lm * DM * NEXP;
    for (int i = tid; i < DM * NEXP; i += 512) gr[i] = grg[i];
    { int* stok = (int*)(X.ws + WS_S + S_STOK); int* sslot = (int*)(X.ws + WS_S + S_SSLOT); float* sgate = (float*)(X.ws + WS_S + S_SGATE); float* srstd = (float*)(X.ws + WS_S + S_SRSTD);
      for (int i = X.bid * 512 + tid; i < MOE_RCAP; i += X.G * 512) { stok[i] = 0; sslot[i] = -1; sgate[i] = 0.f; srstd[i] = 0.f; } }
    const bf16_t* h = (const bf16_t*)(X.ws + WS_H); const u64* ssf = X.ss(4 * l + 3);
    unsigned* gcnt = (unsigned*)(X.ws + CTL_MOECNT_B) + (size_t)lm * 8 * 64;
    int* ae = (int*)(X.ws + WS_S + S_AE); int* apos = (int*)(X.ws + WS_S + S_APOS); float* agate = (float*)(X.ws + WS_S + S_AGATE);
    for (int p = X.bid; p < NPANEL; p += X.G) {
        if (tid < 8) lcnt[tid] = 0u;
        __syncthreads();
        for (int rr = 0; rr < 32; ++rr) {
            const int r = wid * 32 + rr, row = p * 256 + r;
            if (row >= MREAL) break;
            const u32x4 x0 = *(const u32x4*)(h + (size_t)row * DM + lane * 16), x1 = *(const u32x4*)(h + (size_t)row * DM + lane * 16 + 8);
            float xv[16] = {bflo(x0.x), bfhi(x0.x), bflo(x0.y), bfhi(x0.y), bflo(x0.z), bfhi(x0.z), bflo(x0.w), bfhi(x0.w), bflo(x1.x), bfhi(x1.x), bflo(x1.y), bfhi(x1.y), bflo(x1.z), bfhi(x1.z), bflo(x1.w), bfhi(x1.w)};
            float lg8[8];
#pragma unroll
            for (int e = 0; e < 8; ++e) lg8[e] = 0.f;
#pragma unroll
            for (int k = 0; k < 16; ++k) { const f32x4 w0 = *(const LAS f32x4*)(gr + (lane * 16 + k) * 8), w1 = *(const LAS f32x4*)(gr + (lane * 16 + k) * 8 + 4);
                lg8[0] += xv[k] * w0[0]; lg8[1] += xv[k] * w0[1]; lg8[2] += xv[k] * w0[2]; lg8[3] += xv[k] * w0[3]; lg8[4] += xv[k] * w1[0]; lg8[5] += xv[k] * w1[1]; lg8[6] += xv[k] * w1[2]; lg8[7] += xv[k] * w1[3]; }
            const float rs = rstd_of(ssf[row], 1.0f / DM);
#pragma unroll
            for (int e = 0; e < 8; ++e) lg8[e] = wave_sum(lg8[e]) * rs;
            int i0 = 0; float v0 = lg8[0];
#pragma unroll
            for (int e = 1; e < 8; ++e) if (lg8[e] > v0) { v0 = lg8[e]; i0 = e; }
            int i1 = -1; float v1 = -3.0e38f;
#pragma unroll
            for (int e = 0; e < 8; ++e) if (e != i0 && lg8[e] > v1) { v1 = lg8[e]; i1 = e; }
            if (i1 < 0) { i1 = (i0 == 0) ? 1 : 0; v1 = v0; }
            if (lane == 0) { const float ex = __expf(v1 - v0), g0 = 1.0f / (1.0f + ex);
                le[r * 2] = i0; le[r * 2 + 1] = i1; lg[r * 2] = g0; lg[r * 2 + 1] = ex * g0;
                lp[r * 2] = (int)__hip_atomic_fetch_add(&lcnt[i0], 1u, __ATOMIC_RELAXED, __HIP_MEMORY_SCOPE_WORKGROUP); lp[r * 2 + 1] = (int)__hip_atomic_fetch_add(&lcnt[i1], 1u, __ATOMIC_RELAXED, __HIP_MEMORY_SCOPE_WORKGROUP); }
        }
        __syncthreads();
        if (tid < 8) lbase[tid] = atomicAdd(gcnt + tid * 64, lcnt[tid]);
        __syncthreads();
        if (tid < 256 && p * 256 + tid < MREAL) { const int row = p * 256 + tid;
#pragma unroll
            for (int k = 0; k < 2; ++k) { const int e = le[tid * 2 + k]; ae[row * 2 + k] = e; apos[row * 2 + k] = (int)lbase[e] + lp[tid * 2 + k]; agate[row * 2 + k] = lg[tid * 2 + k]; } }
        __syncthreads();
    }
}
__device__ __forceinline__ void moe_scatter(const Ctx& X, int l) {
    const int lm = l >> 1, tid = X.tid;
    const unsigned* gcnt = (const unsigned*)(X.ws + CTL_MOECNT_B) + (size_t)lm * 8 * 64;
    int pstart[8]; int acc = 0;
#pragma unroll
    for (int e = 0; e < 8; ++e) { const int c = (int)__hip_atomic_load(gcnt + e * 64, __ATOMIC_RELAXED, __HIP_MEMORY_SCOPE_AGENT); pstart[e] = acc; acc += ((c + 255) >> 8) << 8; }
    const int nblk = acc >> 8;
    int* minfo = (int*)(X.ws + WS_S + S_MINFO);
    if (X.bid == 0) { if (tid == 0) minfo[0] = nblk;
        for (int blk = tid; blk < nblk; blk += 512) { int e = 0;
#pragma unroll
            for (int k = 1; k < 8; ++k) if (blk * 256 >= pstart[k]) e = k;
            minfo[16 + blk] = e; } }
    int* stok = (int*)(X.ws + WS_S + S_STOK); int* sslot = (int*)(X.ws + WS_S + S_SSLOT); float* sgate = (float*)(X.ws + WS_S + S_SGATE); float* srstd = (float*)(X.ws + WS_S + S_SRSTD);
    const int* ae = (const int*)(X.ws + WS_S + S_AE); const int* apos = (const int*)(X.ws + WS_S + S_APOS); const float* agate = (const float*)(X.ws + WS_S + S_AGATE);
    const u64* ssf = X.ss(4 * l + 3);
    for (int a = X.bid * 512 + tid; a < MOE_NASG; a += X.G * 512) {
        const int e = ae[a]; int ps = 0;
#pragma unroll
        for (int k = 0; k < 8; ++k) if (k == e) ps = pstart[k];
        const int dest = ps + apos[a], row = a >> 1;
        stok[dest] = row; sslot[dest] = a; sgate[dest] = agate[a]; srstd[dest] = rstd_of(ssf[row], 1.0f / DM);
    }
}
struct MoeOrder {
    int blk_lo, nb, nN, G, c; const char* A; const char* W; size_t tstepA, tstepB; const int* stok; const int* bexp; bool gather;
    __device__ __forceinline__ bool next(int i, pg8::Unit& u) const { const long L = (long)i * G + c; if (L >= (long)nb * nN) return false; u.pn = (int)(L / nb); u.pm = blk_lo + (int)(L % nb); return true; }
    __device__ __forceinline__ const char* a_ptr(const pg8::Unit& u) const { return gather ? A : A + (size_t)(u.pm - blk_lo) * tstepA; }
    __device__ __forceinline__ const char* b_ptr(const pg8::Unit& u) const { const int e = __builtin_amdgcn_readfirstlane(bexp[u.pm]); return W + (size_t)e * SZ_EXP + (size_t)u.pn * tstepB; }
    __device__ __forceinline__ int a_row(const pg8::Unit& u, int r) const { return stok[(size_t)u.pm * 256 + r]; }
    __device__ __forceinline__ const int* a_row_ptr(const pg8::Unit& u, int r) const { return stok + (size_t)u.pm * 256 + r; }
};
__device__ __forceinline__ void moe_combine(const Ctx& X, int l) {
    const bool lastl = (l == DEPTH - 1);
    bf16_t* h = (bf16_t*)(X.ws + WS_H); const bf16_t* y = X.sb(S_Y); u64* ssn = X.ss(lastl ? 16 : 4 * (l + 1)); const float* fn = inp(IN_FINAL_NORM); float* out = outp();
    const int gw = X.bid * 8 + X.wave, NGW = X.G * 8, lane = X.lane;
    for (int row = gw; row < MREAL; row += NGW) {
        float vv[16]; float s = 0.f;
#pragma unroll
        for (int j = 0; j < 4; ++j) { const size_t c = (size_t)j * 256 + lane * 4;
            const u32x2 a = *(const u32x2*)(h + (size_t)row * DM + c), b0 = *(const u32x2*)(y + (size_t)(2 * row) * DM + c), b1 = *(const u32x2*)(y + (size_t)(2 * row + 1) * DM + c);
            vv[4 * j] = bflo(a.x) + (bflo(b0.x) + bflo(b1.x)); vv[4 * j + 1] = bfhi(a.x) + (bfhi(b0.x) + bfhi(b1.x)); vv[4 * j + 2] = bflo(a.y) + (bflo(b0.y) + bflo(b1.y)); vv[4 * j + 3] = bfhi(a.y) + (bfhi(b0.y) + bfhi(b1.y)); }
        if (!lastl) {
#pragma unroll
            for (int j = 0; j < 4; ++j) { u32x2 w; w.x = pk2(vv[4 * j], vv[4 * j + 1]); w.y = pk2(vv[4 * j + 2], vv[4 * j + 3]); *(u32x2*)(h + (size_t)row * DM + j * 256 + lane * 4) = w;
                s += (bflo(w.x) * bflo(w.x) + bfhi(w.x) * bfhi(w.x)) + (bflo(w.y) * bflo(w.y) + bfhi(w.y) * bfhi(w.y)); }
            s = wave_sum(s); if (lane == 0) ssn[row] = ss_fix(s);
        } else {
#pragma unroll
            for (int k = 0; k < 16; ++k) s += vv[k] * vv[k];
            s = wave_sum(s); const float r = rsqrtf(s * (1.0f / DM) + EPS);
            if (row < MMAIN) {
#pragma unroll
                for (int j = 0; j < 4; ++j) { const f32x4 g = *(const f32x4*)(fn + j * 256 + lane * 4); f32x4 o = {vv[4 * j] * r * g[0], vv[4 * j + 1] * r * g[1], vv[4 * j + 2] * r * g[2], vv[4 * j + 3] * r * g[3]};
                    *(f32x4*)(out + (size_t)row * DM + j * 256 + lane * 4) = o; } }
        }
    }
}
#ifndef SKIP
#define SKIP 0
#endif
#define PH_ON(bit) (!((SKIP >> (bit)) & 1))
#ifndef ONE_LAUNCH
#define ONE_LAUNCH 1
#endif
constexpr int PH_PER_LAYER = 15, N_PHASES = 1 + DEPTH * PH_PER_LAYER;
constexpr int ATT_UNITS = NBATCH * NHEAD * 8 + NHEAD;

__global__ void __launch_bounds__(512, 2) fwd(Args args) {
    extern __shared__ __attribute__((aligned(16))) unsigned char lds_raw[];
    Ctx X0; X0.lds = (LAS unsigned char*)lds_raw; X0.ws = wsp(); X0.wave = __builtin_amdgcn_readfirstlane((int)threadIdx.x >> 6); X0.lane = lane_id(); X0.tid = X0.wave * 64 + X0.lane; X0.G = gridDim.x; X0.bid = blockIdx.x;
    volatile LAS unsigned* MISC = (volatile LAS unsigned*)(X0.lds + LDS_MISC);
    for (int u = X0.tid; u < (LDS_BYTES - LDS_MISC) / 4; u += 512) MISC[u] = 0u;
    __syncthreads();
    const int lo = argi(0), hi = argi(1);
    const bool use_bar = (hi - lo) > 1;
    XcdBarrier bar; bar.bar = (unsigned*)(X0.ws + WS_CTL) + CTL_BAR_W; bar.x = 0; bar.st = MISC + 8;
    if (use_bar) bar = xcd_barrier_post((unsigned*)(X0.ws + WS_CTL) + CTL_BAR_W, MISC + 8, X0.wave == 0 && lane_id() == 0);
#define IN(k) (lo <= (k) && (k) < hi)
#define SEAM(k) do { if ((k) + 1 < hi) xcd_barrier(bar, X0.wave == 0 && lane_id() == 0); } while (0)
    LAS unsigned char* ring = X0.lds;
#define PHASE_CTX const Ctx X = fresh(X0); bf16_t* H = (bf16_t*)(X.ws + WS_H); const float* rope = (const float*)(X.ws + WS_ROPE); (void)H; (void)rope;

    if (PH_ON(0) && IN(0)) { PHASE_CTX prologue(X); SEAM(0); }

#pragma unroll 1
    for (int l = 0; l < DEPTH; ++l) {
        const int pb = 1 + l * PH_PER_LAYER;
        if (PH_ON(1) && IN(pb)) {
            PHASE_CTX unsigned char* wmix = X.ws + WS_WMIX + (size_t)l * SZ_WMIX; (void)wmix;
            if (PH_ON(0) && l == 2) { moe_convert(X, 1); __syncthreads(); }
            pg8::StaticOrder S; S.init(H, (const bf16_t*)wmix, DM, NPANEL, DINP / 256, X.G, X.bid);
            EpiWin E{X.ws, l};
            pg8::gemm_phase<EpiWin, pg8::StaticOrder, false>(ring, X.tid, DM, S, E);
            SEAM(pb);
        }
        if (PH_ON(2) && IN(pb + 1)) {
            PHASE_CTX unsigned char* wmix = X.ws + WS_WMIX + (size_t)l * SZ_WMIX; (void)wmix;
            if (PH_ON(15)) { pg8::StaticOrder S; S.init(X.sb(S_CQ), (const bf16_t*)(wmix + SZ_WIN), QLORA, NPANEL, 3, X.G, X.bid);
              EpiQ E{X.ws, l};
              pg8::gemm_phase<EpiQ, pg8::StaticOrder, false>(ring, X.tid, QLORA, S, E); }
            if (PH_ON(16)) { pg8::StaticOrder S; S.init(X.sb(S_CKV), (const bf16_t*)(wmix + SZ_WIN + SZ_WQ), KVLORA, NPANEL, 4, X.G, X.bid);
              EpiKV E{X.ws, l};
              pg8::gemm_phase<EpiKV, pg8::StaticOrder, false>(ring, X.tid, KVLORA, S, E); }
            SEAM(pb + 1);
        }
        if (PH_ON(3) && IN(pb + 2)) {
            PHASE_CTX unsigned char* wmix = X.ws + WS_WMIX + (size_t)l * SZ_WMIX; (void)wmix;
            MixP P{X.sb(S_Q), X.sb(S_KN), X.sb(S_V), X.sb(S_KR), X.sb(S_XP), X.sb(S_MQK), X.sb(S_MV), X.sb(S_MO), (const float*)(X.ws + WS_S + S_GATES), X.sb(S_CAT),
                   inp(IN_CONV_W) + (size_t)l * 4 * 512, inp(IN_CONV_B) + l * 512, inp(IN_MLSTM_NORM) + l * 256};
            if (PH_ON(12)) for (int it = X.bid; it < NBATCH * 32 + 1; it += X.G) { if (it < NBATCH * 32) pool_unit(P, X0.wave * 64 + lane_id(), it >> 5, (it & 31) + 1); else pool_unit(P, X0.wave * 64 + lane_id(), 0, 0); }
            if (PH_ON(13)) for (int u = X.bid; u < NBATCH * MH; u += X.G) mlstm_unit(ring, P, X0.wave * 64 + lane_id(), u >> 2, u & 3);
            unsigned* qhead = (unsigned*)(X.ws + CTL_QUEUE_B) + l * 64;
            if (PH_ON(14)) for (;;) {
                __syncthreads();
                if (X0.wave == 0 && lane_id() == 0) MISC[16] = atomicAdd(qhead, 1u);
                __syncthreads();
                const int idx = (int)MISC[16];
                if (idx >= ATT_UNITS) break;
                if (idx < NBATCH * NHEAD * 8) { const int qt = 7 - (idx >> 8), bh = idx & 255; attn_unit(ring, P, X0.wave * 64 + lane_id(), bh >> 3, bh & 7, qt); }
                else attn_unit(ring, P, X0.wave * 64 + lane_id(), 0, idx - NBATCH * NHEAD * 8, -1);
            }
            SEAM(pb + 2);
        }
        if (PH_ON(4) && IN(pb + 3)) {
            PHASE_CTX unsigned char* wmix = X.ws + WS_WMIX + (size_t)l * SZ_WMIX; (void)wmix;
            pg8::StaticOrder S; S.init(X.sb(S_CAT), (const bf16_t*)(wmix + SZ_WIN + SZ_WQ + SZ_WKV), DM, NPANEL, 4, X.G, X.bid);
            EpiRes E{X.ws, 4 * l + 3};
            pg8::gemm_phase<EpiRes, pg8::StaticOrder, false>(ring, X.tid, DM, S, E);
            SEAM(pb + 3);
        }
        if ((l & 1) == 0) {
            if (PH_ON(5) && IN(pb + 4)) {
                PHASE_CTX unsigned char* wd = X.ws + WS_WDENSE + (size_t)(l >> 1) * SZ_DENSE;
                pg8::StaticOrder S; S.init(H, (const bf16_t*)wd, DM, NPANEL, 2 * DFF / 256, X.G, X.bid);
                EpiGU E{X.ws, 4 * l + 3};
                pg8::gemm_phase<EpiGU, pg8::StaticOrder, false>(ring, X.tid, DM, S, E);
                SEAM(pb + 4);
            }
            if (PH_ON(6) && IN(pb + 5)) {
                PHASE_CTX unsigned char* wd = X.ws + WS_WDENSE + (size_t)(l >> 1) * SZ_DENSE;
                pg8::StaticOrder S; S.init(X.sb(S_ACT), (const bf16_t*)(wd + SZ_DGU), DFF, NPANEL, 4, X.G, X.bid);
                EpiRes E{X.ws, 4 * (l + 1)};
                pg8::gemm_phase<EpiRes, pg8::StaticOrder, false>(ring, X.tid, DFF, S, E);
                SEAM(pb + 5);
            }
        } else {
            if (PH_ON(7) && IN(pb + 4)) { PHASE_CTX moe_route(X, l); SEAM(pb + 4); }
            if (PH_ON(8) && IN(pb + 5)) { PHASE_CTX moe_scatter(X, l); SEAM(pb + 5); }
#pragma unroll 1
            for (int ci = 0; ci < 4; ++ci) {
                if (IN(pb + 6 + 2 * ci) || IN(pb + 7 + 2 * ci)) {
                    PHASE_CTX const int* minfo = (const int*)(X.ws + WS_S + S_MINFO);
                    const int nblk = minfo[0];
                    const int blk_lo = MOE_CHUNK * ci; int blk_hi = (ci == 3) ? nblk : (nblk < MOE_CHUNK * (ci + 1) ? nblk : MOE_CHUNK * (ci + 1));
                    if (blk_hi > blk_lo + MOE_CHUNK_CAP) blk_hi = blk_lo + MOE_CHUNK_CAP;
                    const int nb = blk_hi > blk_lo ? blk_hi - blk_lo : 0;
                    if (PH_ON(9) && IN(pb + 6 + 2 * ci)) {
                        MoeOrder S{blk_lo, nb, 2 * DFFE / 256, X.G, X.bid, (const char*)H, (const char*)(X.ws + WS_WMOE), 0, (size_t)256 * DM * 2, (const int*)(X.ws + WS_S + S_STOK), minfo + 16, true};
                        EpiMoeGU E{X.ws, blk_lo};
                        pg8::gemm_phase<EpiMoeGU, MoeOrder, true>(ring, X.tid, DM, S, E);
                        SEAM(pb + 6 + 2 * ci);
                    }
                    if (PH_ON(10) && IN(pb + 7 + 2 * ci)) {
                        MoeOrder S{blk_lo, nb, 4, X.G, X.bid, (const char*)X.sb(S_ACTE), (const char*)(X.ws + WS_WMOE + SZ_EGU), (size_t)256 * DFFE * 2, (size_t)256 * DFFE * 2, (const int*)(X.ws + WS_S + S_STOK), minfo + 16, false};
                        EpiMoeDown E{X.ws};
                        pg8::gemm_phase<EpiMoeDown, MoeOrder, false>(ring, X.tid, DFFE, S, E);
                        SEAM(pb + 7 + 2 * ci);
                    }
                }
            }
            if (PH_ON(11) && IN(pb + 14)) { PHASE_CTX moe_combine(X, l); SEAM(pb + 14); }
        }
    }
#undef IN
#undef SEAM
}

extern "C" void kernel_launch(void* const* d_in, const int* in_sizes, int n_in, void* d_out, int out_size, void* d_ws, size_t ws_size, hipStream_t stream) {
    static int grid = 0;
    if (grid == 0) {
        if (n_in != N_IN || in_sizes[0] != MMAIN * DM || out_size != MMAIN * DM || ws_size < WS_END) {
            fprintf(stderr, "kernel_launch: unexpected shapes (n_in %d, in0 %d, out %d, ws %zu < %zu); nothing launched\n", n_in, n_in > 0 ? in_sizes[0] : -1, out_size, ws_size, (size_t)WS_END); grid = -1; return; }
        int dev = 0, cus = 0, per_cu = 0;
        if (hipGetDevice(&dev) != hipSuccess || hipDeviceGetAttribute(&cus, hipDeviceAttributeMultiprocessorCount, dev) != hipSuccess) { grid = -1; return; }
        if (hipFuncSetAttribute((const void*)fwd, hipFuncAttributeMaxDynamicSharedMemorySize, LDS_BYTES) != hipSuccess) { fprintf(stderr, "kernel_launch: hipFuncSetAttribute failed\n"); grid = -1; return; }
        if (hipOccupancyMaxActiveBlocksPerMultiprocessor(&per_cu, (const void*)fwd, 512, LDS_BYTES) != hipSuccess || per_cu < 1) { fprintf(stderr, "kernel_launch: occupancy query says %d\n", per_cu); }
        (void)hipGetLastError();
        grid = cus;
    }
    if (grid < 0) return;
    (void)hipMemsetAsync((char*)d_ws + WS_CTL, 0, CTL_BYTES, stream);
    Args a{};
    for (int i = 0; i < N_IN; ++i) a.in[i] = (const float*)d_in[i];
    a.out = (float*)d_out; a.ws = (unsigned char*)d_ws;
#if ONE_LAUNCH
    a.ph_lo = 0; a.ph_hi = N_PHASES;
    hipLaunchKernelGGL(fwd, dim3(grid), dim3(512), LDS_BYTES, stream, a);
#else
    for (int ph = 0; ph < N_PHASES; ++ph) {
        if (ph > 0) { const int l = (ph - 1) / PH_PER_LAYER, r = (ph - 1) % PH_PER_LAYER; if ((l & 1) == 0 && r > 5) continue; }
        a.ph_lo = ph; a.ph_hi = ph + 1;
        hipLaunchKernelGGL(fwd, dim3(grid), dim3(512), LDS_BYTES, stream, a);
    }
#endif
    const hipError_t le = hipPeekAtLastError();
    if (le != hipSuccess) fprintf(stderr, "kernel_launch: launch failed: %s\n", hipGetErrorName(le));
}
```

```cpp
#include <hip/hip_runtime.h>
#include <cstdio>
#include <cstdint>

#define LAS __attribute__((address_space(3)))
#define GAS __attribute__((address_space(1)))
typedef unsigned short bf16_t;
typedef short bf16x8 __attribute__((ext_vector_type(8)));
typedef short s16x4 __attribute__((ext_vector_type(4)));
typedef float f32x4 __attribute__((ext_vector_type(4)));
typedef float f32x2 __attribute__((ext_vector_type(2)));
typedef float f32x16 __attribute__((ext_vector_type(16)));
typedef unsigned u32x4 __attribute__((ext_vector_type(4)));
typedef unsigned u32x2 __attribute__((ext_vector_type(2)));
typedef unsigned long long u64;
typedef int v8i __attribute__((ext_vector_type(8)));

constexpr int NBATCH = 32, SEQ = 2048, DM = 1024, DEPTH = 4, NMETA = 16, LTOT = SEQ + NMETA;
constexpr int MMAIN = NBATCH * SEQ;
constexpr int MREAL = MMAIN + NMETA;
constexpr int NPANEL = 257, MPAD = NPANEL * 256;
constexpr int QLORA = 768, KVLORA = 256, NHEAD = 8, QKN = 64, QKR = 32, VH = 64;
constexpr int DIN = 2344, DINP = 2560;
constexpr int DFF = 2816, DFFE = 3584, NEXP = 8;
constexpr int MH = 4, MHD = 64;
constexpr float EPS = 1e-6f;
constexpr float QSCALE = 0.10206207261596577f * 1.4426950408889634f;
constexpr float SSFIX = 1048576.0f;

__device__ __forceinline__ unsigned f2bf(float f) { unsigned u = __builtin_bit_cast(unsigned, f); return (u + 0x7fffu + ((u >> 16) & 1u)) >> 16; }
__device__ __forceinline__ unsigned pk2(float lo, float hi) { f32x2 v = {lo, hi}; typedef __bf16 bf2 __attribute__((ext_vector_type(2))); bf2 b = __builtin_convertvector(v, bf2); return __builtin_bit_cast(unsigned, b); }
__device__ __forceinline__ float bf2f(unsigned short h) { return __builtin_bit_cast(float, (unsigned)h << 16); }
__device__ __forceinline__ float bflo(unsigned w) { return __builtin_bit_cast(float, w << 16); }
__device__ __forceinline__ float bfhi(unsigned w) { return __builtin_bit_cast(float, w & 0xffff0000u); }
__device__ __forceinline__ float fexp2(float x) { return __builtin_amdgcn_exp2f(x); }
__device__ __forceinline__ float fexp(float x) { return __builtin_amdgcn_exp2f(x * 1.4426950408889634f); }
__device__ __forceinline__ float frcp(float x) { return __builtin_amdgcn_rcpf(x); }
__device__ __forceinline__ float sigmoidf_(float x) { return frcp(1.0f + fexp(-x)); }
__device__ __forceinline__ float siluf_(float x) { return x * sigmoidf_(x); }
__device__ __forceinline__ float rstd_of(u64 ss, float inv_n) { return rsqrtf((float)ss * (1.0f / SSFIX) * inv_n + EPS); }
__device__ __forceinline__ u64 ss_fix(float s) { return (u64)(s * SSFIX + 0.5f); }
__device__ __forceinline__ int lane_id() { int l; asm volatile("v_mbcnt_lo_u32_b32 %0, -1, 0\n\tv_mbcnt_hi_u32_b32 %0, -1, %0" : "=v"(l)); return l; }
__device__ __forceinline__ int seqrow(int b, int pos) { return pos < NMETA ? MMAIN + pos : b * SEQ + (pos - NMETA); }
__device__ __forceinline__ int rowpos(int row) { return row < MMAIN ? NMETA + (row & (SEQ - 1)) : row - MMAIN; }

#define XB_TMO      128
#define XB_XCNT(j)  (256  + 64 * (j))
#define XB_XSUB(j)  (1280 + 64 * (j))
#define XB_XGEN(j)  (2304 + 64 * (j))
#define XB_TOP      3328
#define XB_TOPGEN   3392
#define XCD_BAR_WORDS 3456
#define XB_SPIN_CAP (1u << 22)

__device__ __forceinline__ unsigned xb_ld(unsigned* p)              { return __hip_atomic_load(p, __ATOMIC_RELAXED, __HIP_MEMORY_SCOPE_AGENT); }
__device__ __forceinline__ unsigned xb_add(unsigned* p, unsigned v) { return __hip_atomic_fetch_add(p, v, __ATOMIC_RELAXED, __HIP_MEMORY_SCOPE_AGENT); }
__device__ __forceinline__ unsigned xb_xcc_id() { return (unsigned)__builtin_amdgcn_s_getreg((3 << 11) | 20) & 0xFu; }
#define XB_SPIN(cond, bar) do { unsigned _sp = 0; while (cond) { __builtin_amdgcn_s_sleep(1); \
    if ((++_sp & 255u) == 0u) { if (xb_ld(&(bar)[XB_TMO])) break; if (_sp > XB_SPIN_CAP) { atomicAdd(&(bar)[XB_TMO], 1u); break; } } } } while (0)

struct XcdBarrier { unsigned* bar; unsigned x; volatile LAS unsigned* st; };

__device__ __forceinline__ XcdBarrier xcd_barrier_post(unsigned* bar, volatile LAS unsigned* st, bool leader) {
    XcdBarrier b; b.bar = bar; b.x = xb_xcc_id(); b.st = st;
    if (leader) (void)xb_add(&bar[XB_XCNT(b.x)], 1u);
    return b;
}
__device__ __forceinline__ void xcd_barrier_complete(unsigned* bar, unsigned x, unsigned& nloc, unsigned& nx) {
    const unsigned G = gridDim.x * gridDim.y * gridDim.z;
    unsigned sum, cnt, mine, sp = 0u;
    for (;;) {
        sum = 0u; cnt = 0u; mine = 0u;
#pragma unroll
        for (unsigned j = 0; j < 16; ++j) { const unsigned c = xb_ld(&bar[XB_XCNT(j)]); sum += c; cnt += (c > 0u) ? 1u : 0u; mine = (j == x) ? c : mine; }
        if (sum == G) break;
        __builtin_amdgcn_s_sleep(1);
        if ((++sp & 255u) == 0u) { if (xb_ld(&bar[XB_TMO])) break; if (sp > XB_SPIN_CAP) { atomicAdd(&bar[XB_TMO], 1u); break; } }
    }
    nloc = mine > 0u ? mine : 1u; nx = cnt > 0u ? cnt : 1u;
}
__device__ __forceinline__ void xcd_barrier(const XcdBarrier& b, bool leader) {
    asm volatile("s_waitcnt vmcnt(0)" ::: "memory");
    __syncthreads();
    if (leader) {
        unsigned* bar = b.bar;
        __builtin_amdgcn_s_waitcnt(0);
        unsigned nloc = b.st[0], nx = b.st[1];
        if (nloc == 0u) { xcd_barrier_complete(bar, b.x, nloc, nx); b.st[0] = nloc; b.st[1] = nx; }
        const unsigned old = xb_add(&bar[XB_XSUB(b.x)], 1u);
        const unsigned gen = old / nloc;
        if (old + 1u == (gen + 1u) * nloc) {
            __builtin_amdgcn_fence(__ATOMIC_RELEASE, "agent");
            asm volatile("s_waitcnt vmcnt(0)" ::: "memory");
            const unsigned og = xb_add(&bar[XB_TOP], 1u);
            const unsigned tg = og / nx;
            if (og + 1u == (tg + 1u) * nx) xb_add(&bar[XB_TOPGEN], 1u);
            else XB_SPIN(xb_ld(&bar[XB_TOPGEN]) == tg, bar);
            __builtin_amdgcn_fence(__ATOMIC_ACQUIRE, "agent");
            xb_add(&bar[XB_XGEN(b.x)], 1u);
            asm volatile("s_waitcnt vmcnt(0)" ::: "memory");
        } else {
            XB_SPIN(xb_ld(&bar[XB_XGEN(b.x)]) == gen, bar);
            __builtin_amdgcn_fence(__ATOMIC_ACQUIRE, "agent");
            asm volatile("s_waitcnt vmcnt(0)" ::: "memory");
        }
    }
    __syncthreads();
}

__device__ __forceinline__ const char* uni_ptr(const char* p) { const unsigned long long v = (unsigned long long)p; const unsigned lo = __builtin_amdgcn_readfirstlane((unsigned)v), hi = __builtin_amdgcn_readfirstlane((unsigned)(v >> 32)); return (const char*)(((unsigned long long)hi << 32) | lo); }
__device__ __forceinline__ void glds16_s(const char* sbase, unsigned voff, unsigned lds_dst) {
    unsigned keep;
    asm volatile("s_mov_b32 %0, m0\n\ts_mov_b32 m0, %1\n\ts_nop 0\n\tglobal_load_lds_dwordx4 %2, %3\n\ts_mov_b32 m0, %0" : "=&s"(keep) : "s"(lds_dst), "v"(voff), "s"(sbase) : "memory");
}
namespace pg8 {
constexpr int BM = 256, BK = 64, HALF = 128, HTB = HALF * BK * 2, STAGE_BYTES = 8 * HTB, NXCD = 8, WGM = 8;
__host__ __device__ __forceinline__ int lds_byte(int r, int c) { const int st = (r >> 4) * 2 + (c >> 5), rr = r & 15, cc = c & 31, ob = rr * 64 + cc * 2; return st * 1024 + (ob ^ (((ob >> 9) & 1) << 5)); }
__host__ __device__ __forceinline__ void stage_rc(int b, int& R, int& C) { const int st = b / 1024, sb = b % 1024, swz = sb ^ (((sb >> 9) & 1) << 5); R = (st >> 1) * 16 + swz / 64; C = (st & 1) * 32 + (swz % 64) / 2; }
__host__ __device__ __forceinline__ int perm32(int rho) { const int n = rho >> 4, i = rho & 15; return 8 * (i >> 2) + 4 * n + (i & 3); }

struct Unit { int pm, pn; bool dup; };

struct StaticOrder {
    int nM, nN, nwg, G, c, rep; const char* A; const char* B; size_t tstep;
    __device__ __forceinline__ void init(const bf16_t* A_, const bf16_t* B_, int K, int nM_, int nN_, int G_, int c_, int rep_ = 1) { A = (const char*)A_; B = (const char*)B_; tstep = (size_t)BM * K * 2; nM = nM_; nN = nN_; nwg = nM * nN; G = G_; c = c_; rep = rep_; }
    __device__ __forceinline__ bool next(int i, Unit& u) const {
        long L = (long)i * G + c; if (L >= (long)nwg * rep) return false;
        u.dup = L >= nwg; if (u.dup) L -= nwg;
        int wgid = (int)L; { const int q = nwg / NXCD, r = nwg % NXCD, xcd = wgid % NXCD, off = wgid / NXCD; wgid = (xcd < r ? xcd * (q + 1) : r * (q + 1) + (xcd - r) * q) + off; }
        const int nig = WGM * nN, gid = wgid / nig, fm = gid * WGM, gsz = (nM - fm) < WGM ? (nM - fm) : WGM;
        u.pm = fm + ((wgid % nig) % gsz); u.pn = (wgid % nig) / gsz; return true;
    }
    __device__ __forceinline__ const char* a_ptr(const Unit& u) const { return A + (size_t)u.pm * tstep; }
    __device__ __forceinline__ const char* b_ptr(const Unit& u) const { return B + (size_t)u.pn * tstep; }
    __device__ __forceinline__ int a_row(const Unit&, int) const { return 0; }
    __device__ __forceinline__ const int* a_row_ptr(const Unit&, int) const { return nullptr; }
};

template <class Epi, class Sched, bool GATHER, bool ALIGN_EPI = true>
__device__ __forceinline__ void gemm_phase(LAS unsigned char* lds, const int tid_, const int K_, const Sched& S, const Epi& E) {
    int tid = tid_, K = K_;
    asm volatile("" : "+v"(tid)); asm volatile("" : "+s"(K));
    const int wid = __builtin_amdgcn_readfirstlane(tid >> 6), lane = tid & 63, wr = wid >> 2, wc = wid & 3, fr = lane & 15, fq = lane >> 4;
    const int nt = K / BK;
    unsigned voffA[2], voffB[2]; int RA[2], CA2[2];
#pragma unroll
    for (int i = 0; i < 2; ++i) { int R, C; stage_rc(tid * 16 + i * 8192, R, C); const int Rb = Epi::PERM ? ((R & ~31) + perm32(R & 31)) : R;
        voffA[i] = (unsigned)(R * K + C) * 2u; voffB[i] = (unsigned)(Rb * K + C) * 2u; RA[i] = R; CA2[i] = C * 2; }
    const size_t kstep = (size_t)(BK * 2);
    const size_t hstep = GATHER ? (size_t)0 : (size_t)HALF * K * 2;
    const size_t hstepB = (size_t)HALF * K * 2;
    const unsigned ldsw = (unsigned)wid * 1024u;
    const int aoff = lds_byte(wr * 64 + fr, fq * 8), boff = lds_byte(wc * 32 + fr, fq * 8);
#define PG8_SA(b, h) (((b) * 2 + (h)) * HTB)
#define PG8_SB(b, h) ((4 + (b) * 2 + (h)) * HTB)
#define PG8_STAGE(bufoff, gbase, voff) do { const char* _gb = uni_ptr((const char*)(gbase)); _Pragma("unroll") for (int _i = 0; _i < 2; ++_i) \
        __builtin_amdgcn_global_load_lds((const unsigned*)(_gb + (voff)[_i]), (LAS unsigned*)(lds + (bufoff) + ldsw + _i * 8192), 16, 0, 0); } while (0)
#define PG8_LDA(dst, b, h) do { _Pragma("unroll") for (int m = 0; m < 4; ++m) _Pragma("unroll") for (int k = 0; k < 2; ++k) dst[m][k] = *(const LAS bf16x8*)(lds + PG8_SA(b, h) + aoff + m * 2048 + k * 1024); } while (0)
#define PG8_LDB(dst, b, h) do { _Pragma("unroll") for (int n = 0; n < 2; ++n) _Pragma("unroll") for (int k = 0; k < 2; ++k) dst[n][k] = *(const LAS bf16x8*)(lds + PG8_SB(b, h) + boff + n * 2048 + k * 1024); } while (0)
#define PG8_MMA(ai, bj, At, Bt) do { __builtin_amdgcn_s_setprio(1); _Pragma("unroll") for (int m = 0; m < 4; ++m) _Pragma("unroll") for (int n = 0; n < 2; ++n) _Pragma("unroll") for (int k = 0; k < 2; ++k) \
        acc[ai][bj][m][n] = __builtin_amdgcn_mfma_f32_16x16x32_bf16(Bt[n][k], At[m][k], acc[ai][bj][m][n], 0, 0, 0); __builtin_amdgcn_s_setprio(0); } while (0)
#define PG8_MMA0(ai, bj, At, Bt) do { __builtin_amdgcn_s_setprio(1); _Pragma("unroll") for (int m = 0; m < 4; ++m) _Pragma("unroll") for (int n = 0; n < 2; ++n) { \
        acc[ai][bj][m][n] = __builtin_amdgcn_mfma_f32_16x16x32_bf16(Bt[n][0], At[m][0], (f32x4){0.f, 0.f, 0.f, 0.f}, 0, 0, 0); \
        acc[ai][bj][m][n] = __builtin_amdgcn_mfma_f32_16x16x32_bf16(Bt[n][1], At[m][1], acc[ai][bj][m][n], 0, 0, 0); } __builtin_amdgcn_s_setprio(0); } while (0)
#define PG8_MMAF(ai, bj, At, Bt) do { if (t == 0) PG8_MMA0(ai, bj, At, Bt); else PG8_MMA(ai, bj, At, Bt); } while (0)
#define PG8_WAIT_V(n) asm volatile("s_waitcnt vmcnt(" #n ")" ::: "memory")
#define PG8_WAIT_V8R() do { if (Epi::NST > 0 && relax) asm volatile("s_waitcnt vmcnt(%0)" :: "n"(8 + Epi::NST) : "memory"); else asm volatile("s_waitcnt vmcnt(8)" ::: "memory"); } while (0)
#define PG8_WAIT_L(n) asm volatile("s_waitcnt lgkmcnt(" #n ")" ::: "memory")
#define PG8_BAR __builtin_amdgcn_s_barrier()
#define PG8_SCHED __builtin_amdgcn_sched_barrier(0)
    Unit cur, nxt; int ui = 0; bool prev_ok = false;
    if (!S.next(0, cur)) return;
    f32x4 acc[2][2][4][2];
    bf16x8 At[4][2], B0[2][2], B1[2][2];
    unsigned gc0[2], gc1[2];
    const char* cA = S.a_ptr(cur); const char* cB = S.b_ptr(cur);
    LAS int* gtab = (LAS int*)(lds + STAGE_BYTES + 1024);
    LAS unsigned char* rtab = lds + STAGE_BYTES + 4096;
#define PG8_RT(U, SLOT) do { if constexpr (Epi::RT) { if (wid == 4 || wid == 5) \
        __builtin_amdgcn_global_load_lds((const unsigned*)(uni_ptr((const char*)E.rt_src((U), wid - 4)) + (unsigned)lane * 16u), (LAS unsigned*)(rtab + (SLOT) * 2048 + (wid - 4) * 1024), 16, 0, 0); } } while (0)
    PG8_RT(cur, 0);
    if constexpr (GATHER) {
#pragma unroll
        for (int i = 0; i < 2; ++i) { gc0[i] = (unsigned)S.a_row(cur, RA[i]) * (unsigned)(K * 2) + CA2[i]; gc1[i] = (unsigned)S.a_row(cur, HALF + RA[i]) * (unsigned)(K * 2) + CA2[i]; }
    } else {
#pragma unroll
        for (int i = 0; i < 2; ++i) { gc0[i] = voffA[i]; gc1[i] = voffA[i]; }
    }
    PG8_STAGE(PG8_SB(0, 0), cB, voffB); PG8_STAGE(PG8_SB(0, 1), cB + hstepB, voffB); PG8_STAGE(PG8_SA(0, 0), cA, gc0); PG8_STAGE(PG8_SA(0, 1), cA + hstep, gc1);
    if (wr == 1) PG8_BAR;
    PG8_WAIT_V(2); PG8_BAR;
    PG8_STAGE(PG8_SB(1, 0), cB + kstep, voffB); PG8_STAGE(PG8_SA(1, 0), cA + kstep, gc0); PG8_STAGE(PG8_SB(1, 1), cB + hstepB + kstep, voffB);
    PG8_WAIT_V(6); PG8_BAR;
    for (;;) {
        const bool has_next = S.next(ui + 1, nxt);
        const char* nA = has_next ? S.a_ptr(nxt) : cA; const char* nB = has_next ? S.b_ptr(nxt) : cB;
        if (has_next) PG8_RT(nxt, (ui + 1) & 1);
        if constexpr (GATHER) { if (has_next && wid < 4)
            __builtin_amdgcn_global_load_lds((const unsigned*)(uni_ptr((const char*)S.a_row_ptr(nxt, 0)) + (unsigned)tid * 4u), (LAS unsigned*)(gtab + ((ui + 1) & 1) * 256 + wid * 64), 4, 0, 0); }
        for (int t = 0; t < nt; t += 2) {
            const bool last = (t == nt - 2);
            const bool relax = (t == 0) && prev_ok;
            const char* a1 = cA + (size_t)(t + 1) * kstep;
            const char* a2 = last ? nA : cA + (size_t)(t + 2) * kstep; const char* b2 = last ? nB : cB + (size_t)(t + 2) * kstep;
            const char* a3 = a2 + kstep; const char* b3 = b2 + kstep;
            unsigned s0[2], s1[2];
#pragma unroll
            for (int i = 0; i < 2; ++i) { s0[i] = gc0[i]; s1[i] = gc1[i]; }
            if constexpr (GATHER) { if (last && has_next) {
#pragma unroll
                for (int i = 0; i < 2; ++i) { const LAS int* tb = gtab + ((ui + 1) & 1) * 256; int r0 = tb[RA[i]], r1 = tb[HALF + RA[i]]; r0 = r0 < 0 ? 0 : r0; r1 = r1 < 0 ? 0 : r1;
                    s0[i] = (unsigned)r0 * (unsigned)(K * 2) + CA2[i]; s1[i] = (unsigned)r1 * (unsigned)(K * 2) + CA2[i]; } } }
            PG8_LDB(B0, 0, 0); PG8_LDB(B1, 0, 1); PG8_SCHED; PG8_LDA(At, 0, 0); PG8_STAGE(PG8_SA(1, 1), a1 + hstep, gc1);
            PG8_WAIT_V8R(); PG8_WAIT_L(0); PG8_BAR; PG8_MMAF(0, 0, At, B0); PG8_MMAF(0, 1, At, B1); PG8_BAR; PG8_SCHED;
            PG8_LDA(At, 0, 1); PG8_STAGE(PG8_SB(0, 0), b2, voffB); PG8_STAGE(PG8_SB(0, 1), b2 + hstepB, voffB); PG8_STAGE(PG8_SA(0, 0), a2, s0);
            PG8_WAIT_V8R(); PG8_WAIT_L(0); PG8_BAR; PG8_MMAF(1, 0, At, B0); PG8_MMAF(1, 1, At, B1); PG8_BAR; PG8_SCHED;
            PG8_LDB(B0, 1, 0); PG8_LDB(B1, 1, 1); PG8_SCHED; PG8_LDA(At, 1, 0); PG8_STAGE(PG8_SA(0, 1), a2 + hstep, s1);
            PG8_WAIT_V8R(); PG8_WAIT_L(0); PG8_BAR; PG8_MMA(0, 0, At, B0); PG8_MMA(0, 1, At, B1); PG8_BAR; PG8_SCHED;
            PG8_LDA(At, 1, 1); PG8_STAGE(PG8_SB(1, 0), b3, voffB); PG8_STAGE(PG8_SB(1, 1), b3 + hstepB, voffB); PG8_STAGE(PG8_SA(1, 0), a3, s0);
            PG8_WAIT_V8R(); PG8_WAIT_L(0); PG8_BAR; PG8_MMA(1, 0, At, B0); PG8_MMA(1, 1, At, B1); PG8_BAR; PG8_SCHED;
        }
        if constexpr (ALIGN_EPI) { if (wr == 0) PG8_BAR; }
        E(acc, cur, wr, wc, fr, fq, (const LAS unsigned char*)(rtab + (ui & 1) * 2048));
        if (!has_next) break;
        prev_ok = E.nst_ok(cur); cur = nxt; cA = nA; cB = nB; ++ui;
        if constexpr (GATHER) {
#pragma unroll
            for (int i = 0; i < 2; ++i) { const LAS int* tb = gtab + (ui & 1) * 256; int r0 = tb[RA[i]], r1 = tb[HALF + RA[i]]; r0 = r0 < 0 ? 0 : r0; r1 = r1 < 0 ? 0 : r1;
                gc0[i] = (unsigned)r0 * (unsigned)(K * 2) + CA2[i]; gc1[i] = (unsigned)r1 * (unsigned)(K * 2) + CA2[i]; }
        }
        if constexpr (ALIGN_EPI) { if (wr == 1) PG8_BAR; }
    }
    PG8_WAIT_V(0);
    if constexpr (!ALIGN_EPI) { if (wr == 0) PG8_BAR; }
    PG8_BAR;
#undef PG8_RT
#undef PG8_SA
#undef PG8_SB
#undef PG8_STAGE
#undef PG8_LDA
#undef PG8_LDB
#undef PG8_MMA
#undef PG8_MMA0
#undef PG8_MMAF
#undef PG8_WAIT_V
#undef PG8_WAIT_V8R
#undef PG8_WAIT_L
#undef PG8_BAR
#undef PG8_SCHED
}
template <class Epi, class Sched, bool GATHER, bool ALIGN_EPI = true>
__device__ __forceinline__ void gemm_phase8(LAS unsigned char* lds, const int tid_, const int K_, const Sched& S, const Epi& E) {
    int tid = tid_, K = K_;
    asm volatile("" : "+v"(tid)); asm volatile("" : "+s"(K));
    const int wid = __builtin_amdgcn_readfirstlane(tid >> 6), lane = tid & 63, wr = wid >> 2, wc = wid & 3, fr = lane & 15, fq = lane >> 4;
    const int nt = K / 128;
    unsigned voffA[2], voffB[2]; int RA[2], CA2[2];
#pragma unroll
    for (int i = 0; i < 2; ++i) { int R, C; stage_rc(tid * 16 + i * 8192, R, C); const int Rb = Epi::PERM ? ((R & ~31) + perm32(R & 31)) : R;
        voffA[i] = (unsigned)(R * K + C * 2); voffB[i] = (unsigned)(Rb * K + C * 2); RA[i] = R; CA2[i] = C * 2; }
    const size_t kstep = (size_t)(BK * 2);
    const size_t hstep = GATHER ? (size_t)0 : (size_t)HALF * K;
    const size_t hstepB = (size_t)HALF * K;
    const unsigned ldsw = (unsigned)wid * 1024u; const unsigned ldsb_ = (unsigned)(uintptr_t)lds + ldsw;
    const int aoff = lds_byte(wr * 64 + fr, fq * 16), boff = lds_byte(wc * 32 + fr, fq * 16);
#define PG8_SA(b, h) (((b) * 2 + (h)) * HTB)
#define PG8_SB(b, h) ((4 + (b) * 2 + (h)) * HTB)
#define PG8_STAGE(bufoff, gbase, voff) do { const char* _gb = uni_ptr((const char*)(gbase)); _Pragma("unroll") for (int _i = 0; _i < 2; ++_i) \
        glds16_s(_gb, (voff)[_i], ldsb_ + (unsigned)((bufoff) + _i * 8192)); } while (0)
#define PG8_LD32(p) (*(const LAS v8i*)(p))
#define PG8_LDA(dst, b, h) do { _Pragma("unroll") for (int m = 0; m < 4; ++m) dst[m] = PG8_LD32(lds + PG8_SA(b, h) + aoff + m * 2048); } while (0)
#define PG8_LDB(dst, b, h) do { _Pragma("unroll") for (int n = 0; n < 2; ++n) dst[n] = PG8_LD32(lds + PG8_SB(b, h) + boff + n * 2048); } while (0)
#define PG8_MMA(ai, bj, At, Bt) do { __builtin_amdgcn_s_setprio(1); _Pragma("unroll") for (int m = 0; m < 4; ++m) _Pragma("unroll") for (int n = 0; n < 2; ++n) \
        asm volatile("v_mfma_scale_f32_16x16x128_f8f6f4 %0, %1, %2, %0, %3, %3 op_sel_hi:[0,0,0]" : "+v"(acc[ai][bj][m][n]) : "v"(Bt[n]), "v"(At[m]), "v"(sc1_)); __builtin_amdgcn_s_setprio(0); } while (0)
#define PG8_MMA0(ai, bj, At, Bt) do { __builtin_amdgcn_s_setprio(1); _Pragma("unroll") for (int m = 0; m < 4; ++m) _Pragma("unroll") for (int n = 0; n < 2; ++n) \
        asm volatile("v_mfma_scale_f32_16x16x128_f8f6f4 %0, %1, %2, 0, %3, %3 op_sel_hi:[0,0,0]" : "=&v"(acc[ai][bj][m][n]) : "v"(Bt[n]), "v"(At[m]), "v"(sc1_)); __builtin_amdgcn_s_setprio(0); } while (0)
#define PG8_MMAF(ai, bj, At, Bt) do { if (t == 0) PG8_MMA0(ai, bj, At, Bt); else PG8_MMA(ai, bj, At, Bt); } while (0)
#define PG8_WAIT_V(n) asm volatile("s_waitcnt vmcnt(" #n ")" ::: "memory")
#define PG8_WAIT_V8R() do { if (Epi::NST > 0 && relax) asm volatile("s_waitcnt vmcnt(%0)" :: "n"(8 + Epi::NST) : "memory"); else asm volatile("s_waitcnt vmcnt(8)" ::: "memory"); } while (0)
#define PG8_WAIT_L(n) asm volatile("s_waitcnt lgkmcnt(" #n ")" ::: "memory")
#define PG8_BAR __builtin_amdgcn_s_barrier()
#define PG8_SCHED __builtin_amdgcn_sched_barrier(0)
    Unit cur, nxt; int ui = 0; bool prev_ok = false;
    if (!S.next(0, cur)) return;
    const unsigned sc1_ = 0x7F7F7F7Fu;
    f32x4 acc[2][2][4][2];
    unsigned gc0[2], gc1[2];
    const char* cA = S.a_ptr(cur); const char* cB = S.b_ptr(cur);
    LAS int* gtab = (LAS int*)(lds + STAGE_BYTES + 1024);
    LAS unsigned char* rtab = lds + STAGE_BYTES + 4096;
#define PG8_RT(U, SLOT) do { if constexpr (Epi::RT) { if (wid == 4 || wid == 5) \
        __builtin_amdgcn_global_load_lds((const unsigned*)(uni_ptr((const char*)E.rt_src((U), wid - 4)) + (unsigned)lane * 16u), (LAS unsigned*)(rtab + (SLOT) * 2048 + (wid - 4) * 1024), 16, 0, 0); } } while (0)
    PG8_RT(cur, 0);
    if constexpr (GATHER) {
#pragma unroll
        for (int i = 0; i < 2; ++i) { gc0[i] = (unsigned)S.a_row(cur, RA[i]) * (unsigned)K + CA2[i]; gc1[i] = (unsigned)S.a_row(cur, HALF + RA[i]) * (unsigned)K + CA2[i]; }
    } else {
#pragma unroll
        for (int i = 0; i < 2; ++i) { gc0[i] = voffA[i]; gc1[i] = voffA[i]; }
    }
    PG8_STAGE(PG8_SB(0, 0), cB, voffB); PG8_STAGE(PG8_SB(0, 1), cB + hstepB, voffB); PG8_STAGE(PG8_SA(0, 0), cA, gc0); PG8_STAGE(PG8_SA(0, 1), cA + hstep, gc1);
    if (wr == 1) PG8_BAR;
    PG8_WAIT_V(2); PG8_BAR;
    PG8_STAGE(PG8_SB(1, 0), cB + kstep, voffB); PG8_STAGE(PG8_SA(1, 0), cA + kstep, gc0); PG8_STAGE(PG8_SB(1, 1), cB + hstepB + kstep, voffB);
    PG8_WAIT_V(6); PG8_BAR;
    for (;;) {
        const bool has_next = S.next(ui + 1, nxt);
        const char* nA = has_next ? S.a_ptr(nxt) : cA; const char* nB = has_next ? S.b_ptr(nxt) : cB;
        if (has_next) PG8_RT(nxt, (ui + 1) & 1);
        if constexpr (GATHER) { if (has_next && wid < 4)
            __builtin_amdgcn_global_load_lds((const unsigned*)(uni_ptr((const char*)S.a_row_ptr(nxt, 0)) + (unsigned)tid * 4u), (LAS unsigned*)(gtab + ((ui + 1) & 1) * 256 + wid * 64), 4, 0, 0); }
        for (int t = 0; t < nt; t += 2) {
            const bool last = (t == nt - 2);
            const bool relax = (t == 0) && prev_ok;
            v8i At[4], B0[2], B1[2];
            const char* a1 = cA + (size_t)(t + 1) * kstep;
            const char* a2 = last ? nA : cA + (size_t)(t + 2) * kstep; const char* b2 = last ? nB : cB + (size_t)(t + 2) * kstep;
            const char* a3 = a2 + kstep; const char* b3 = b2 + kstep;
            unsigned s0[2], s1[2];
#pragma unroll
            for (int i = 0; i < 2; ++i) { s0[i] = gc0[i]; s1[i] = gc1[i]; }
            if constexpr (GATHER) { if (last && has_next) { int t2 = tid; asm volatile("" : "+v"(t2));
#pragma unroll
                for (int i = 0; i < 2; ++i) { int R_, C_; stage_rc(t2 * 16 + i * 8192, R_, C_); const LAS int* tb = gtab + ((ui + 1) & 1) * 256; int r0 = tb[R_], r1 = tb[HALF + R_]; r0 = r0 < 0 ? 0 : r0; r1 = r1 < 0 ? 0 : r1;
                    s0[i] = (unsigned)r0 * (unsigned)K + (unsigned)(C_ * 2); s1[i] = (unsigned)r1 * (unsigned)K + (unsigned)(C_ * 2); } } }
            PG8_LDB(B0, 0, 0); PG8_LDB(B1, 0, 1); PG8_SCHED; PG8_LDA(At, 0, 0); PG8_STAGE(PG8_SA(1, 1), a1 + hstep, gc1);
            PG8_WAIT_V8R(); PG8_WAIT_L(0); PG8_BAR; PG8_MMAF(0, 0, At, B0); PG8_MMAF(0, 1, At, B1); PG8_BAR; PG8_SCHED;
            PG8_LDA(At, 0, 1); PG8_STAGE(PG8_SB(0, 0), b2, voffB); PG8_STAGE(PG8_SB(0, 1), b2 + hstepB, voffB); PG8_STAGE(PG8_SA(0, 0), a2, s0);
            PG8_WAIT_V8R(); PG8_WAIT_L(0); PG8_BAR; PG8_MMAF(1, 0, At, B0); PG8_MMAF(1, 1, At, B1); PG8_BAR; PG8_SCHED;
            PG8_LDB(B0, 1, 0); PG8_LDB(B1, 1, 1); PG8_SCHED; PG8_LDA(At, 1, 0); PG8_STAGE(PG8_SA(0, 1), a2 + hstep, s1);
            PG8_WAIT_V8R(); PG8_WAIT_L(0); PG8_BAR; PG8_MMA(0, 0, At, B0); PG8_MMA(0, 1, At, B1); PG8_BAR; PG8_SCHED;
            PG8_LDA(At, 1, 1); PG8_STAGE(PG8_SB(1, 0), b3, voffB); PG8_STAGE(PG8_SB(1, 1), b3 + hstepB, voffB); PG8_STAGE(PG8_SA(1, 0), a3, s0);
            PG8_WAIT_V8R(); PG8_WAIT_L(0); PG8_BAR; PG8_MMA(1, 0, At, B0); PG8_MMA(1, 1, At, B1); PG8_BAR; PG8_SCHED;
        }
        if constexpr (ALIGN_EPI) { if (wr == 0) PG8_BAR; }
        asm volatile("s_nop 15\n\ts_nop 15" ::: "memory");
        E(acc, cur, wr, wc, fr, fq, (const LAS unsigned char*)(rtab + (ui & 1) * 2048));
        if (!has_next) break;
        prev_ok = E.nst_ok(cur); cur = nxt; cA = nA; cB = nB; ++ui;
        if constexpr (GATHER) { int t2 = tid; asm volatile("" : "+v"(t2));
#pragma unroll
            for (int i = 0; i < 2; ++i) { int R_, C_; stage_rc(t2 * 16 + i * 8192, R_, C_); const LAS int* tb = gtab + (ui & 1) * 256; int r0 = tb[R_], r1 = tb[HALF + R_]; r0 = r0 < 0 ? 0 : r0; r1 = r1 < 0 ? 0 : r1;
                gc0[i] = (unsigned)r0 * (unsigned)K + (unsigned)(C_ * 2); gc1[i] = (unsigned)r1 * (unsigned)K + (unsigned)(C_ * 2); }
        }
        if constexpr (ALIGN_EPI) { if (wr == 1) PG8_BAR; }
    }
    PG8_WAIT_V(0);
    if constexpr (!ALIGN_EPI) { if (wr == 0) PG8_BAR; }
    PG8_BAR;
#undef PG8_RT
#undef PG8_SA
#undef PG8_SB
#undef PG8_STAGE
#undef PG8_LDA
#undef PG8_LDB
#undef PG8_MMA
#undef PG8_MMA0
#undef PG8_MMAF
#undef PG8_WAIT_V
#undef PG8_WAIT_V8R
#undef PG8_WAIT_L
#undef PG8_BAR
#undef PG8_SCHED
#undef PG8_LD32
}
template <class Epi>
__device__ __forceinline__ void thin_gemm(LAS unsigned char* lds, const int tid_, const bf16_t* A, const bf16_t* Bt, const int K_, const int nN, const int bid, const Epi& E) {
    if (bid >= 4 * nN) return;
    int tid = tid_, K = K_; asm volatile("" : "+v"(tid)); asm volatile("" : "+s"(K));
    const int wid = __builtin_amdgcn_readfirstlane(tid >> 6), lane = tid & 63, fr = lane & 15, fq = lane >> 4;
    const int wc = bid & 3, pn = bid >> 2;
    LAS unsigned char* rtab = lds + STAGE_BYTES + 4096;
    { Unit u0; u0.pm = NPANEL - 1; u0.pn = pn; u0.dup = false;
      if constexpr (Epi::RT) { if (wid == 7) __builtin_amdgcn_global_load_lds((const unsigned*)(uni_ptr((const char*)E.rt_src(u0, 0)) + (unsigned)lane * 16u), (LAS unsigned*)rtab, 16, 0, 0); } }
    f32x4 part[2][2];
#pragma unroll
    for (int b = 0; b < 2; ++b)
#pragma unroll
        for (int n = 0; n < 2; ++n) part[b][n] = (f32x4){0.f, 0.f, 0.f, 0.f};
    const char* ab = uni_ptr((const char*)A); const char* bb = uni_ptr((const char*)Bt);
    const int kw = K >> 3;
    const unsigned aoff = ((unsigned)(MMAIN + fr) * (unsigned)K + (unsigned)(wid * kw) + fq * 8) * 2u;
    unsigned boff[2][2];
#pragma unroll
    for (int bj = 0; bj < 2; ++bj)
#pragma unroll
        for (int n = 0; n < 2; ++n) { const int rho = 16 * n + fr; const int col = pn * 256 + bj * 128 + wc * 32 + (Epi::PERM ? perm32(rho) : rho); boff[bj][n] = ((unsigned)col * (unsigned)K + (unsigned)(wid * kw) + fq * 8) * 2u; }
    for (int k0 = 0; k0 < kw; k0 += 128) {
        bf16x8 a[4], b[4][2][2];
#pragma unroll
        for (int j = 0; j < 4; ++j) { const bool ok = k0 + 32 * j < kw; const int kc = ok ? k0 + 32 * j : k0;
            a[j] = *(const bf16x8*)(ab + aoff + kc * 2);
            if (!ok) a[j] = (bf16x8){0, 0, 0, 0, 0, 0, 0, 0};
#pragma unroll
            for (int bj = 0; bj < 2; ++bj)
#pragma unroll
                for (int n = 0; n < 2; ++n) b[j][bj][n] = *(const bf16x8*)(bb + boff[bj][n] + kc * 2); }
#pragma unroll
        for (int j = 0; j < 4; ++j)
#pragma unroll
            for (int bj = 0; bj < 2; ++bj)
#pragma unroll
                for (int n = 0; n < 2; ++n) part[bj][n] = __builtin_amdgcn_mfma_f32_16x16x32_bf16(b[j][bj][n], a[j], part[bj][n], 0, 0, 0);
    }
    LAS f32x4* px = (LAS f32x4*)lds;
#pragma unroll
    for (int bj = 0; bj < 2; ++bj)
#pragma unroll
        for (int n = 0; n < 2; ++n) px[(wid * 4 + bj * 2 + n) * 64 + lane] = part[bj][n];
    asm volatile("s_waitcnt vmcnt(0)" ::: "memory");
    __syncthreads();
    if (wid == 0) {
        f32x4 acc[2][2][4][2];
#pragma unroll
        for (int a = 0; a < 2; ++a)
#pragma unroll
            for (int b = 0; b < 2; ++b)
#pragma unroll
                for (int m = 0; m < 4; ++m)
#pragma unroll
                    for (int n = 0; n < 2; ++n) acc[a][b][m][n] = (f32x4){0.f, 0.f, 0.f, 0.f};
#pragma unroll
        for (int bj = 0; bj < 2; ++bj)
#pragma unroll
            for (int n = 0; n < 2; ++n) { f32x4 s = px[(bj * 2 + n) * 64 + lane];
#pragma unroll
                for (int w = 1; w < 8; ++w) s += px[(w * 4 + bj * 2 + n) * 64 + lane];
                acc[0][bj][0][n] = s; }
        Unit u; u.pm = NPANEL - 1; u.pn = pn; u.dup = false;
        E(acc, u, 0, wc, fr, fq, Epi::RT ? (const LAS unsigned char*)rtab : (const LAS unsigned char*)nullptr);
    }
    __syncthreads();
}
template <class Epi>
__device__ __forceinline__ void thin_gemm8(LAS unsigned char* lds, const int tid_, const unsigned char* A8, const unsigned char* Bt8, const int K_, const int nN, const int bid, const Epi& E) {
    if (bid >= 4 * nN) return;
    int tid = tid_, K = K_; asm volatile("" : "+v"(tid)); asm volatile("" : "+s"(K));
    const int wid = __builtin_amdgcn_readfirstlane(tid >> 6), lane = tid & 63, fr = lane & 15, fq = lane >> 4;
    const int wc = bid & 3, pn = bid >> 2;
    LAS unsigned char* rtab = lds + STAGE_BYTES + 4096;
    { Unit u0; u0.pm = NPANEL - 1; u0.pn = pn; u0.dup = false;
      if constexpr (Epi::RT) { if (wid == 7) __builtin_amdgcn_global_load_lds((const unsigned*)(uni_ptr((const char*)E.rt_src(u0, 0)) + (unsigned)lane * 16u), (LAS unsigned*)rtab, 16, 0, 0); } }
    f32x4 part[2][2];
#pragma unroll
    for (int b = 0; b < 2; ++b)
#pragma unroll
        for (int n = 0; n < 2; ++n) part[b][n] = (f32x4){0.f, 0.f, 0.f, 0.f};
    const char* ab = uni_ptr((const char*)A8); const char* bb = uni_ptr((const char*)Bt8);
    const unsigned aoff = (unsigned)(MMAIN + fr) * (unsigned)K + fq * 32;
    unsigned boff[2][2];
#pragma unroll
    for (int bj = 0; bj < 2; ++bj)
#pragma unroll
        for (int n = 0; n < 2; ++n) { const int rho = 16 * n + fr; const int col = pn * 256 + bj * 128 + wc * 32 + (Epi::PERM ? perm32(rho) : rho); boff[bj][n] = (unsigned)col * (unsigned)K + fq * 32; }
    const unsigned sc1_ = 0x7F7F7F7Fu;
    for (int k0 = wid * 128; k0 < K; k0 += 1024) {
        const v8i a = *(const v8i*)(ab + aoff + k0);
#pragma unroll
        for (int bj = 0; bj < 2; ++bj)
#pragma unroll
            for (int n = 0; n < 2; ++n) { const v8i b = *(const v8i*)(bb + boff[bj][n] + k0);
                asm volatile("v_mfma_scale_f32_16x16x128_f8f6f4 %0, %1, %2, %0, %3, %3 op_sel_hi:[0,0,0]" : "+v"(part[bj][n]) : "v"(b), "v"(a), "v"(sc1_)); }
    }
    asm volatile("s_nop 15\n\ts_nop 15" ::: "memory");
    LAS f32x4* px = (LAS f32x4*)lds;
#pragma unroll
    for (int bj = 0; bj < 2; ++bj)
#pragma unroll
        for (int n = 0; n < 2; ++n) px[(wid * 4 + bj * 2 + n) * 64 + lane] = part[bj][n];
    asm volatile("s_waitcnt vmcnt(0)" ::: "memory");
    __syncthreads();
    if (wid == 0) {
        f32x4 acc[2][2][4][2];
#pragma unroll
        for (int a = 0; a < 2; ++a)
#pragma unroll
            for (int b = 0; b < 2; ++b)
#pragma unroll
                for (int m = 0; m < 4; ++m)
#pragma unroll
                    for (int n = 0; n < 2; ++n) acc[a][b][m][n] = (f32x4){0.f, 0.f, 0.f, 0.f};
#pragma unroll
        for (int bj = 0; bj < 2; ++bj)
#pragma unroll
            for (int n = 0; n < 2; ++n) { f32x4 s = px[(bj * 2 + n) * 64 + lane];
#pragma unroll
                for (int w = 1; w < 8; ++w) s += px[(w * 4 + bj * 2 + n) * 64 + lane];
                acc[0][bj][0][n] = s; }
        Unit u; u.pm = NPANEL - 1; u.pn = pn; u.dup = false;
        E(acc, u, 0, wc, fr, fq, Epi::RT ? (const LAS unsigned char*)rtab : (const LAS unsigned char*)nullptr);
    }
    __syncthreads();
}
}
constexpr size_t AL256(size_t x) { return (x + 255) & ~(size_t)255; }
constexpr size_t WS_CTL = 0;
constexpr size_t CTL_BAR_W = 4096;
constexpr size_t CTL_QUEUE_B = 32768;
constexpr size_t CTL_MOECNT_B = 40960;
constexpr size_t CTL_SS_B = 65536;
constexpr size_t SS_BYTES = (size_t)MPAD * 8;
constexpr size_t CTL_BYTES = 9437184;
static_assert(CTL_SS_B + 17 * SS_BYTES <= CTL_BYTES, "ctl");
constexpr size_t WS_ROPE = CTL_BYTES;
constexpr size_t WS_ROUTER = WS_ROPE + 524288;
constexpr size_t WS_WMIX = WS_ROUTER + 65536;
constexpr size_t SZ_WIN = (size_t)DINP * DM * 2, SZ_WQ = (size_t)768 * QLORA * 2, SZ_WKV = (size_t)1024 * KVLORA * 2, SZ_WO = (size_t)DM * DM * 2;
constexpr size_t SZ_WMIX = SZ_WIN + SZ_WQ + SZ_WKV + SZ_WO;
constexpr size_t WS_WDENSE = WS_WMIX + DEPTH * SZ_WMIX;
constexpr size_t SZ_DGU = (size_t)2 * DFF * DM * 2, SZ_DD = (size_t)DM * DFF * 2, SZ_DENSE = SZ_DGU + SZ_DD;
constexpr size_t WS_WMOE = WS_WDENSE + 2 * SZ_DENSE;
constexpr size_t SZ_EGU = (size_t)2 * DFFE * DM * 2, SZ_ED = (size_t)DM * DFFE * 2, SZ_EXP = SZ_EGU + SZ_ED;
constexpr size_t WS_H = WS_WMOE + NEXP * SZ_EXP;
constexpr size_t WS_S = WS_H + (size_t)MPAD * DM * 2;
constexpr size_t S_CQ = 0, S_CKV = S_CQ + (size_t)MPAD * QLORA * 2, S_CAT = 0  ;
constexpr size_t S_XP = S_CKV + (size_t)MPAD * 256 * 2, S_MQK = S_XP + (size_t)MPAD * 256 * 2, S_MV = S_MQK + (size_t)MPAD * 512 * 2, S_MO = S_MV + (size_t)MPAD * 256 * 2;
constexpr size_t S_KR = S_MO + (size_t)MPAD * 256 * 2, S_GATES = S_KR + (size_t)MPAD * 32 * 2, S_Q = S_GATES + (size_t)MPAD * 8 * 4;
constexpr size_t S_KN = S_Q + (size_t)MPAD * 768 * 2, S_V = S_KN + (size_t)MPAD * 512 * 2, S_MIX_END = S_V + (size_t)MPAD * 512 * 2;
constexpr size_t S_ACT = 0;
#ifndef FP8_MOE_MASK
#define FP8_MOE_MASK 0xA
#endif
constexpr int MOE_NCHUNK = (FP8_MOE_MASK == 0xA) ? 2 : 4, MOE_CHUNK = 512 / MOE_NCHUNK, MOE_CHUNK_CAP = (FP8_MOE_MASK == 0xA) ? 272 : 136, MOE_RCAP = 520 * 256, MOE_NASG = MREAL * 2;
constexpr size_t S_ACTE = 0;
constexpr size_t S_Y = S_ACTE + (size_t)136 * 256 * DFFE * 2;
constexpr size_t S_STOK = S_Y + (size_t)MOE_NASG * DM * 2;
constexpr size_t S_SSLOT = S_STOK + (size_t)MOE_RCAP * 4, S_SGATE = S_SSLOT + (size_t)MOE_RCAP * 4, S_SRSTD = S_SGATE + (size_t)MOE_RCAP * 4;
constexpr size_t S_AE = S_SRSTD + (size_t)MOE_RCAP * 4;
constexpr size_t S_APOS = S_AE + AL256((size_t)MOE_NASG * 4), S_AGATE = S_APOS + AL256((size_t)MOE_NASG * 4);
constexpr size_t S_MINFO = S_AGATE + AL256((size_t)MOE_NASG * 4);
constexpr size_t S_MOE_END = S_MINFO + 4096;
static_assert(S_MOE_END <= S_MIX_END && (size_t)MPAD * DFF * 2 <= S_MIX_END, "overlays fit the mixer scratch");
constexpr size_t WS_END = WS_S + S_MIX_END;
constexpr size_t WS_XS8 = WS_END;
constexpr size_t WS_END8 = WS_XS8 + (size_t)MOE_RCAP * DM;
constexpr size_t SZ_EGU8 = (size_t)2 * DFFE * DM, SZ_ED8 = (size_t)DM * DFFE, SZ_EXP8 = SZ_EGU8 + SZ_ED8;
constexpr float W8_SCALE = 64.0f, ACT8_SCALE = 8.0f;
#ifndef FP8_DENSE_MASK
#define FP8_DENSE_MASK 0x4
#endif
#define DENSE_F8(l) ((((FP8_DENSE_MASK) >> (l)) & 1) != 0)
#ifndef FP8_WIN_MASK
#define FP8_WIN_MASK 0xC
#endif
#define WIN_F8(l) ((((FP8_WIN_MASK) >> (l)) & 1) != 0)
#ifndef FP8_WINP_MASK
#define FP8_WINP_MASK 0x3
#endif
#define WINP_F8(l) ((((FP8_WINP_MASK) >> (l)) & 1) != 0 && !WIN_F8(l))
#define H8_IN(l) ((l) < DEPTH && (WIN_F8(l) || WINP_F8(l)))
#ifndef FP8_WOUT_MASK
#define FP8_WOUT_MASK 0xC
#endif
#define WOUT_F8(l) ((((FP8_WOUT_MASK) >> (l)) & 1) != 0)
#ifndef FP8_QKV_MASK
#define FP8_QKV_MASK 0xF
#endif
#define QKV_F8(l) ((((FP8_QKV_MASK) >> (l)) & 1) != 0)
constexpr size_t WS_H8 = WS_XS8;
constexpr size_t SZ_DGU8 = (size_t)2 * DFF * DM, SZ_DD8 = (size_t)DM * DFF;
#define MOE_F8(l) ((FP8_MOE_MASK == 0xA) ? true : (FP8_MOE_MASK == 0) ? false : ((((FP8_MOE_MASK) >> (l)) & 1) != 0))

constexpr int RING_BYTES = 131072;
constexpr int LDS_MISC = RING_BYTES;
constexpr int LDS_BYTES = 147456;

enum { IN_X = 0, IN_META, IN_ATTN_NORM, IN_W_IN, IN_Q_NORM, IN_W_Q_UP, IN_KV_NORM, IN_W_KV_UP, IN_POOL_W, IN_POOL_SCALE, IN_CONV_W, IN_CONV_B, IN_GATE_BIAS, IN_MLSTM_NORM,
       IN_W_OUT, IN_FFN_NORM, IN_DGATE, IN_DUP, IN_DDOWN, IN_ROUTER, IN_MGATE, IN_MUP, IN_MDOWN, IN_FINAL_NORM, N_IN };
struct Args { const float* in[N_IN]; float* out; unsigned char* ws; int ph_lo, ph_hi; };
__device__ __forceinline__ const float* inp(int i) { return ((const float* const __attribute__((address_space(4)))*)__builtin_amdgcn_kernarg_segment_ptr())[i]; }
__device__ __forceinline__ float* outp() { return ((float* const __attribute__((address_space(4)))*)__builtin_amdgcn_kernarg_segment_ptr())[N_IN]; }
__device__ __forceinline__ unsigned char* wsp() { return ((unsigned char* const __attribute__((address_space(4)))*)__builtin_amdgcn_kernarg_segment_ptr())[N_IN + 1]; }
__device__ __forceinline__ int argi(int i) { return ((const int __attribute__((address_space(4)))*)__builtin_amdgcn_kernarg_segment_ptr())[2 * (N_IN + 2) + i]; }

struct Ctx {
    LAS unsigned char* lds; unsigned char* ws; int tid, lane, wave, G, bid;
    __device__ __forceinline__ u64* ss(int idx) const { return (u64*)(ws + CTL_SS_B) + (size_t)idx * MPAD; }
    __device__ __forceinline__ bf16_t* sb(size_t off) const { return (bf16_t*)(ws + WS_S + off); }
};
__device__ __forceinline__ Ctx fresh(const Ctx& X) { Ctx Y = X; asm volatile("" : "+s"(Y.ws)); Y.tid = Y.wave * 64 + lane_id(); asm volatile("" : "+v"(Y.tid)); Y.lane = Y.tid & 63; return Y; }

enum { KIND_ID = 0, KIND_WIN, KIND_QUP, KIND_KVUP, KIND_GU, KIND_WO };
struct Cvt { const float* W; const float* W2; const float* gain; bf16_t* dst; int ldw, K, NP, kind; };
__device__ __forceinline__ int rope_dim(int p) { return ((p >> 2) & 1) * 16 + (p >> 3) * 4 + (p & 3); }
__device__ __forceinline__ int cvt_srccol(int kind, int n, int ldw, bool& second) {
    second = false;
    switch (kind) {
    case KIND_WIN:
        if (n < 1024) return n; if (n < 1280) return 1056 + (n - 1024); if (n < 1792) return 1312 + (n - 1280); if (n < 2048) return 1824 + (n - 1792);
        if (n < 2304) return 2080 + (n - 2048); if (n < 2336) return 1024 + rope_dim(n - 2304); if (n < 2344) return n; return -1;
    case KIND_QUP: return n < 512 ? (n >> 6) * 96 + (n & 63) : ((n - 512) >> 5) * 96 + 64 + rope_dim((n - 512) & 31);
    case KIND_KVUP: return n < 512 ? (n >> 6) * 128 + (n & 63) : ((n - 512) >> 6) * 128 + 64 + ((n - 512) & 63);
    case KIND_GU: { const int t = n >> 8, r = n & 255; if (r >= 128) { second = true; return 128 * t + r - 128; } return 128 * t + r; }
    default: return n < ldw ? n : -1;
    }
}
__device__ __forceinline__ void cvt_item(const Cvt& c, int item, LAS float* scr, int lane) {
    const int nblk = c.NP / 64, kb = item / nblk, nb = item % nblk, k0 = 32 * kb, n0 = 64 * nb;
    if (c.kind == KIND_WO && k0 >= 512 && k0 < 768) return;
    bool second; const int sc = cvt_srccol(c.kind, n0 + 4 * (lane & 15), c.ldw, second);
    const float* src = second ? c.W2 : c.W;
    f32x4 v[8];
#pragma unroll
    for (int i = 0; i < 8; ++i) { const int kk = (lane >> 4) + 4 * i; v[i] = (f32x4){0.f, 0.f, 0.f, 0.f}; if (sc >= 0) v[i] = *(const f32x4*)(src + (size_t)(k0 + kk) * c.ldw + sc); }
    if (c.gain) {
#pragma unroll
        for (int i = 0; i < 8; ++i) v[i] = v[i] * c.gain[k0 + (lane >> 4) + 4 * i]; }
#pragma unroll
    for (int i = 0; i < 8; ++i) *(LAS f32x4*)(scr + ((lane >> 4) + 4 * i) * 68 + 4 * (lane & 15)) = v[i];
    asm volatile("s_waitcnt lgkmcnt(0)" ::: "memory");
    u32x4 o[4];
#pragma unroll
    for (int j = 0; j < 4; ++j) { const LAS float* s = scr + (8 * j) * 68 + lane;
        o[j].x = pk2(s[0 * 68], s[1 * 68]); o[j].y = pk2(s[2 * 68], s[3 * 68]); o[j].z = pk2(s[4 * 68], s[5 * 68]); o[j].w = pk2(s[6 * 68], s[7 * 68]); }
    bf16_t* dr = c.dst + (size_t)(n0 + lane) * c.K + k0;
#pragma unroll
    for (int j = 0; j < 4; ++j) *(u32x4*)(dr + 8 * j) = o[j];
    asm volatile("s_waitcnt lgkmcnt(0)" ::: "memory");
}
__device__ __forceinline__ float clamp8(float x) { return __builtin_amdgcn_fmed3f(x, -448.0f, 448.0f); }
__device__ __forceinline__ unsigned pk4_fp8(float a, float b, float c, float d) { a = clamp8(a); b = clamp8(b); c = clamp8(c); d = clamp8(d); int w = 0; w = __builtin_amdgcn_cvt_pk_fp8_f32(a, b, w, false); w = __builtin_amdgcn_cvt_pk_fp8_f32(c, d, w, true); return (unsigned)w; }
__device__ __forceinline__ void cvt_item8(const Cvt& c, unsigned char* dst8, int item, LAS float* scr, int lane) {
    const int nblk = c.NP / 64, kb = item / nblk, nb = item % nblk, k0 = 32 * kb, n0 = 64 * nb;
    if (c.kind == KIND_WO && k0 >= 512 && k0 < 768) return;
    bool second; const int sc = cvt_srccol(c.kind, n0 + 4 * (lane & 15), c.ldw, second);
    const float* src = second ? c.W2 : c.W;
    f32x4 v[8];
#pragma unroll
    for (int i = 0; i < 8; ++i) { const int kk = (lane >> 4) + 4 * i; v[i] = (f32x4){0.f, 0.f, 0.f, 0.f}; if (sc >= 0) v[i] = *(const f32x4*)(src + (size_t)(k0 + kk) * c.ldw + sc); }
#pragma unroll
    for (int i = 0; i < 8; ++i) v[i] = v[i] * ((c.gain ? c.gain[k0 + (lane >> 4) + 4 * i] : 1.0f) * W8_SCALE);
#pragma unroll
    for (int i = 0; i < 8; ++i) *(LAS f32x4*)(scr + ((lane >> 4) + 4 * i) * 68 + 4 * (lane & 15)) = v[i];
    asm volatile("s_waitcnt lgkmcnt(0)" ::: "memory");
    u32x4 o[2];
#pragma unroll
    for (int j = 0; j < 2; ++j) { const LAS float* s = scr + (16 * j) * 68 + lane;
        o[j].x = pk4_fp8(s[0 * 68], s[1 * 68], s[2 * 68], s[3 * 68]); o[j].y = pk4_fp8(s[4 * 68], s[5 * 68], s[6 * 68], s[7 * 68]);
        o[j].z = pk4_fp8(s[8 * 68], s[9 * 68], s[10 * 68], s[11 * 68]); o[j].w = pk4_fp8(s[12 * 68], s[13 * 68], s[14 * 68], s[15 * 68]); }
    unsigned char* dr = dst8 + (size_t)(n0 + lane) * c.K + k0;
#pragma unroll
    for (int j = 0; j < 2; ++j) *(u32x4*)(dr + 16 * j) = o[j];
    asm volatile("s_waitcnt lgkmcnt(0)" ::: "memory");
}
__device__ __forceinline__ int cvt_nitems(const Cvt& c) { return (c.K / 32) * (c.NP / 64); }
struct CvtJob { Cvt c; unsigned char* d8; int item; bool f8, live; };
struct CvtRegs { f32x4 v[8]; float g[8]; };
__device__ __forceinline__ void cvt_job_load(const CvtJob& j, int lane, CvtRegs& R) {
    const Cvt& c = j.c;
    const int nblk = c.NP / 64, kb = j.item / nblk, nb = j.item % nblk, k0 = 32 * kb, n0 = 64 * nb;
    bool second; const int sc = cvt_srccol(c.kind, n0 + 4 * (lane & 15), c.ldw, second);
    const float* src = second ? c.W2 : c.W;
    const bool on = j.live && !(c.kind == KIND_WO && k0 >= 512 && k0 < 768);
#pragma unroll
    for (int i = 0; i < 8; ++i) { const int kk = (lane >> 4) + 4 * i; R.v[i] = (f32x4){0.f, 0.f, 0.f, 0.f}; R.g[i] = 1.0f;
        if (on && sc >= 0) R.v[i] = __builtin_nontemporal_load((const f32x4*)(src + (size_t)(k0 + kk) * c.ldw + sc));
        if (on && c.gain) R.g[i] = c.gain[k0 + kk]; }
}
__device__ __forceinline__ void cvt_job_store(const CvtJob& j, const CvtRegs& R, LAS float* scr, int lane) {
    const Cvt& c = j.c;
    const int nblk = c.NP / 64, kb = j.item / nblk, nb = j.item % nblk, k0 = 32 * kb, n0 = 64 * nb;
    if (!j.live || (c.kind == KIND_WO && k0 >= 512 && k0 < 768)) return;
    const float ws_ = j.f8 ? W8_SCALE : 1.0f;
#pragma unroll
    for (int i = 0; i < 8; ++i) *(LAS f32x4*)(scr + ((lane >> 4) + 4 * i) * 68 + 4 * (lane & 15)) = R.v[i] * (R.g[i] * ws_);
    asm volatile("s_waitcnt lgkmcnt(0)" ::: "memory");
    if (j.f8) {
        u32x4 o[2];
#pragma unroll
        for (int q = 0; q < 2; ++q) { const LAS float* s = scr + (16 * q) * 68 + lane;
            o[q].x = pk4_fp8(s[0 * 68], s[1 * 68], s[2 * 68], s[3 * 68]); o[q].y = pk4_fp8(s[4 * 68], s[5 * 68], s[6 * 68], s[7 * 68]);
            o[q].z = pk4_fp8(s[8 * 68], s[9 * 68], s[10 * 68], s[11 * 68]); o[q].w = pk4_fp8(s[12 * 68], s[13 * 68], s[14 * 68], s[15 * 68]); }
        unsigned char* dr = j.d8 + (size_t)(n0 + lane) * c.K + k0;
#pragma unroll
        for (int q = 0; q < 2; ++q) *(u32x4*)(dr + 16 * q) = o[q];
    } else {
        u32x4 o[4];
#pragma unroll
        for (int q = 0; q < 4; ++q) { const LAS float* s = scr + (8 * q) * 68 + lane;
            o[q].x = pk2(s[0 * 68], s[1 * 68]); o[q].y = pk2(s[2 * 68], s[3 * 68]); o[q].z = pk2(s[4 * 68], s[5 * 68]); o[q].w = pk2(s[6 * 68], s[7 * 68]); }
        bf16_t* dr = c.dst + (size_t)(n0 + lane) * c.K + k0;
#pragma unroll
        for (int q = 0; q < 4; ++q) *(u32x4*)(dr + 8 * q) = o[q];
    }
    asm volatile("s_waitcnt lgkmcnt(0)" ::: "memory");
}
__device__ __forceinline__ void pool_prep_item(const Ctx& X, int l, int item) {
    const int g = item >> 4, nb = item & 15, n = nb * 64 + X.lane;
    const float* pw = inp(IN_POOL_W) + ((size_t)l * 4 + g) * 4096; const float* ps = inp(IN_POOL_SCALE) + l * 256 + g * 64;
    const float* wo = inp(IN_W_OUT) + (size_t)l * DM * DM + (size_t)(512 + 64 * g) * DM + n;
    bf16_t* dst = (bf16_t*)(X.ws + WS_WMIX + (size_t)l * SZ_WMIX + SZ_WIN + SZ_WQ + SZ_WKV) + (size_t)n * DM + 512 + 64 * g;
    float wv[64];
#pragma unroll
    for (int d = 0; d < 64; ++d) wv[d] = ps[d] * wo[(size_t)d * DM];
#pragma unroll 1
    for (int c8 = 0; c8 < 8; ++c8) {
        float o[8];
#pragma unroll
        for (int cc = 0; cc < 8; ++cc) { const float* pr = pw + (c8 * 8 + cc) * 64; float s = 0.f;
#pragma unroll
            for (int d = 0; d < 64; ++d) s += pr[d] * wv[d];
            o[cc] = s; }
        if (WOUT_F8(l)) { u32x2 w; w.x = pk4_fp8(o[0] * W8_SCALE, o[1] * W8_SCALE, o[2] * W8_SCALE, o[3] * W8_SCALE); w.y = pk4_fp8(o[4] * W8_SCALE, o[5] * W8_SCALE, o[6] * W8_SCALE, o[7] * W8_SCALE);
            *(u32x2*)((unsigned char*)(X.ws + WS_WMIX + (size_t)l * SZ_WMIX + SZ_WIN + SZ_WQ + SZ_WKV) + (size_t)n * DM + 512 + 64 * g + c8 * 8) = w; }
        else { u32x4 w; w.x = pk2(o[0], o[1]); w.y = pk2(o[2], o[3]); w.z = pk2(o[4], o[5]); w.w = pk2(o[6], o[7]);
        *(u32x4*)(dst + c8 * 8) = w; }
    }
}
__device__ __forceinline__ float wave_sum(float v) {
#pragma unroll
    for (int o = 1; o < 64; o <<= 1) v += __shfl_xor(v, o);
    return v;
}
template <class MK> __device__ __forceinline__ void cvt_run(const Ctx& X, int total, MK mk) {
    LAS float* scr = (LAS float*)(X.lds + X.wave * 8704);
    const int gw = X.bid * 8 + X.wave, NGW = X.G * 8;
    CvtJob jc = mk(gw < total ? gw : 0); jc.live = gw < total; CvtRegs rc; cvt_job_load(jc, X.lane, rc);
    for (int it = gw; it < total; it += NGW) {
        const bool hn = it + NGW < total;
        CvtJob jn = mk(hn ? it + NGW : it); jn.live = hn; CvtRegs rn; cvt_job_load(jn, X.lane, rn);
        cvt_job_store(jc, rc, scr, X.lane);
        jc = jn; rc = rn;
    }
}
__device__ __forceinline__ void moe_convert(const Ctx& X, int lm) {
    constexpr int NI_GU = (DM / 32) * (2 * DFFE / 64), NI_D = (DFFE / 32) * (DM / 64), NI_E = NI_GU + NI_D;
    cvt_run(X, NEXP * NI_E, [&](int it) {
        const bool f8 = MOE_F8(2 * lm + 1);
        const int e = it / NI_E, r = it % NI_E; CvtJob j; Cvt& c = j.c; j.f8 = f8; j.live = true;
        if (r < NI_GU) { c.W = inp(IN_MGATE) + ((size_t)lm * NEXP + e) * DM * DFFE; c.W2 = inp(IN_MUP) + ((size_t)lm * NEXP + e) * DM * DFFE; c.gain = inp(IN_FFN_NORM) + (2 * lm + 1) * DM;
            c.dst = (bf16_t*)(X.ws + WS_WMOE + (size_t)e * SZ_EXP); c.ldw = DFFE; c.K = DM; c.NP = 2 * DFFE; c.kind = KIND_GU; j.d8 = X.ws + WS_WMOE + (size_t)e * SZ_EXP8; j.item = r; }
        else { c.W = inp(IN_MDOWN) + ((size_t)lm * NEXP + e) * DFFE * DM; c.W2 = nullptr; c.gain = nullptr;
            c.dst = (bf16_t*)(X.ws + WS_WMOE + (size_t)e * SZ_EXP + SZ_EGU); c.ldw = DM; c.K = DFFE; c.NP = DM; c.kind = KIND_ID; j.d8 = X.ws + WS_WMOE + (size_t)e * SZ_EXP8 + SZ_EGU8; j.item = r - NI_GU; }
        return j; });
}
__device__ __forceinline__ void prologue(const Ctx& X) {
    const int gw = X.bid * 8 + X.wave, NGW = X.G * 8;
    constexpr int NI_WIN = (DM / 32) * (DINP / 64), NI_WQ = (QLORA / 32) * (768 / 64), NI_WKV = (KVLORA / 32) * (1024 / 64), NI_WO = (DM / 32) * (DM / 64);
    constexpr int NI_MIX = NI_WIN + NI_WQ + NI_WKV + NI_WO;
    constexpr int NI_DGU = (DM / 32) * (2 * DFF / 64), NI_DD = (DFF / 32) * (DM / 64), NI_DENSE = NI_DGU + NI_DD;
    cvt_run(X, DEPTH * NI_MIX + 2 * NI_DENSE, [&](int it) {
        CvtJob j; Cvt& c = j.c; c.W2 = nullptr; c.gain = nullptr; j.live = true; j.f8 = false; j.d8 = nullptr;
        if (it < DEPTH * NI_MIX) {
            const int l = it / NI_MIX; int r = it % NI_MIX; unsigned char* wb = X.ws + WS_WMIX + (size_t)l * SZ_WMIX;
            if (r < NI_WIN) { c.W = inp(IN_W_IN) + (size_t)l * DM * DIN; c.gain = inp(IN_ATTN_NORM) + l * DM; c.dst = (bf16_t*)wb; c.ldw = DIN; c.K = DM; c.NP = DINP; c.kind = KIND_WIN; j.f8 = WIN_F8(l) || (WINP_F8(l) && (r % (DINP / 64)) < 16); j.d8 = wb; }
            else if ((r -= NI_WIN) < NI_WQ) { c.W = inp(IN_W_Q_UP) + (size_t)l * QLORA * 768; c.gain = inp(IN_Q_NORM) + l * QLORA; c.dst = (bf16_t*)(wb + SZ_WIN); c.ldw = 768; c.K = QLORA; c.NP = 768; c.kind = KIND_QUP; j.f8 = QKV_F8(l); j.d8 = wb + SZ_WIN; }
            else if ((r -= NI_WQ) < NI_WKV) { c.W = inp(IN_W_KV_UP) + (size_t)l * KVLORA * 1024; c.gain = inp(IN_KV_NORM) + l * KVLORA; c.dst = (bf16_t*)(wb + SZ_WIN + SZ_WQ); c.ldw = 1024; c.K = KVLORA; c.NP = 1024; c.kind = KIND_KVUP; j.f8 = QKV_F8(l); j.d8 = wb + SZ_WIN + SZ_WQ; }
            else { r -= NI_WKV; c.W = inp(IN_W_OUT) + (size_t)l * DM * DM; c.dst = (bf16_t*)(wb + SZ_WIN + SZ_WQ + SZ_WKV); c.ldw = DM; c.K = DM; c.NP = DM; c.kind = KIND_WO; j.f8 = WOUT_F8(l); j.d8 = wb + SZ_WIN + SZ_WQ + SZ_WKV; }
            j.item = r;
        } else {
            const int q = it - DEPTH * NI_MIX, jj = q / NI_DENSE; int r = q % NI_DENSE; unsigned char* wb = X.ws + WS_WDENSE + (size_t)jj * SZ_DENSE;
            if (r < NI_DGU) { c.W = inp(IN_DGATE) + (size_t)jj * DM * DFF; c.W2 = inp(IN_DUP) + (size_t)jj * DM * DFF; c.gain = inp(IN_FFN_NORM) + (2 * jj) * DM; c.dst = (bf16_t*)wb; c.ldw = DFF; c.K = DM; c.NP = 2 * DFF; c.kind = KIND_GU; j.d8 = wb; }
            else { r -= NI_DGU; c.W = inp(IN_DDOWN) + (size_t)jj * DFF * DM; c.dst = (bf16_t*)(wb + SZ_DGU); c.ldw = DM; c.K = DFF; c.NP = DM; c.kind = KIND_ID; j.d8 = wb + SZ_DGU8; }
            j.f8 = DENSE_F8(2 * jj); j.item = r;
        }
        return j; });
    for (int it = gw; it < DEPTH * 64; it += NGW) pool_prep_item(X, it >> 6, it & 63);
    { float* rope = (float*)(X.ws + WS_ROPE); const int gt = X.bid * 512 + X.tid, NT = X.G * 512;
      for (int i = gt; i < LTOT * 16; i += NT) { const int pos = i >> 4, j = i & 15; const float inv = __builtin_amdgcn_exp2f(-(float)j * (13.287712379549449f / 16.0f)); const float ang = (float)pos * inv;
          float rev = ang * 0.15915494309189535f; rev -= floorf(rev);
          rope[pos * 32 + j] = __builtin_amdgcn_cosf(rev); rope[pos * 32 + 16 + j] = __builtin_amdgcn_sinf(rev); }
      float* gr = (float*)(X.ws + WS_ROUTER);
      for (int i = gt; i < 2 * DM * NEXP; i += NT) { const int lm = i / (DM * NEXP), k = (i / NEXP) % DM; gr[i] = inp(IN_ROUTER)[i] * inp(IN_FFN_NORM)[(2 * lm + 1) * DM + k]; } }
    { bf16_t* h = (bf16_t*)(X.ws + WS_H); u64* ss0 = X.ss(0);
      for (int row0 = gw; row0 < MREAL; row0 += 4 * NGW) {
          f32x4 v[4][4];
#pragma unroll
          for (int q = 0; q < 4; ++q) { const int row = row0 + q * NGW;
#pragma unroll
              for (int j = 0; j < 4; ++j) { v[q][j] = (f32x4){0.f, 0.f, 0.f, 0.f};
                  if (row < MREAL) { const float* src = row < MMAIN ? inp(IN_X) + (size_t)row * DM : inp(IN_META) + (size_t)(row - MMAIN) * DM; v[q][j] = __builtin_nontemporal_load((const f32x4*)(src + j * 256 + X.lane * 4)); } } }
#pragma unroll
          for (int q = 0; q < 4; ++q) { const int row = row0 + q * NGW;
              if (row < MREAL) {
                  float s = 0.f;
#pragma unroll
                  for (int j = 0; j < 4; ++j) { u32x2 w; w.x = pk2(v[q][j][0], v[q][j][1]); w.y = pk2(v[q][j][2], v[q][j][3]);
                      *(u32x2*)(h + (size_t)row * DM + j * 256 + X.lane * 4) = w;
                      if (H8_IN(0)) *(unsigned*)(X.ws + WS_H8 + (size_t)row * DM + j * 256 + X.lane * 4) = pk4_fp8(bflo(w.x), bfhi(w.x), bflo(w.y), bfhi(w.y));
                      s += (bflo(w.x) * bflo(w.x) + bfhi(w.x) * bfhi(w.x)) + (bflo(w.y) * bflo(w.y) + bfhi(w.y) * bfhi(w.y)); }
                  s = wave_sum(s); if (X.lane == 0) ss0[row] = ss_fix(s);
              } }
      } }
    moe_convert(X, 0);
}
typedef f32x4 AccT[2][2][4][2];
#define EPI_ROWS_BEGIN  _Pragma("unroll") for (int ai = 0; ai < 2; ++ai) _Pragma("unroll") for (int m = 0; m < 4; ++m) { const int row = row0 + ai * 128 + m * 16;
#define EPI_ROWS_END    }
#define EPI_ROWS_BEGIN_T  _Pragma("unroll") for (int ai = 0; ai < 2; ++ai) _Pragma("unroll") for (int m = 0; m < 4; ++m) { if (u.pm == NPANEL - 1 && ai + m > 0) continue; const int row = row0 + ai * 128 + m * 16;
template <class T> __device__ __forceinline__ T ldo(const void* base, unsigned off) { return *(const T*)((const char*)base + off); }
template <class T> __device__ __forceinline__ void sto(void* base, unsigned off, T v) { *(T*)((char*)base + off) = v; }
__device__ __forceinline__ u32x2 bf4(f32x4 v) { u32x2 w; w.x = pk2(v[0], v[1]); w.y = pk2(v[2], v[3]); return w; }
__device__ __forceinline__ u32x4 bf8(f32x4 a, f32x4 b) { u32x4 w; w.x = pk2(a[0], a[1]); w.y = pk2(a[2], a[3]); w.z = pk2(b[0], b[1]); w.w = pk2(b[2], b[3]); return w; }
__device__ __forceinline__ float sq4(f32x4 v) { return (v[0] * v[0] + v[1] * v[1]) + (v[2] * v[2] + v[3] * v[3]); }
__device__ __forceinline__ float red_fq(float s) { s += __shfl_xor(s, 16); s += __shfl_xor(s, 32); return s; }
__device__ __forceinline__ float sqw(unsigned w) { return bflo(w) * bflo(w) + bfhi(w) * bfhi(w); }
#define EPI_LAUNDER int fr = fr_, fq = fq_; asm volatile("" : "+v"(fr), "+v"(fq));
#define EPI_NODUP if (u.dup) return;
constexpr size_t SSOFF(int idx) { return CTL_SS_B + (size_t)idx * SS_BYTES; }

struct EpiWin {
    static constexpr bool PERM = true;
    static constexpr int NST = 16;
    __device__ __forceinline__ bool nst_ok(const pg8::Unit& u) const { return u.pn + pn0 <= 8; }
    static constexpr bool RT = true;
    __device__ __forceinline__ const unsigned char* rt_src(const pg8::Unit& u, int i) const { return ws + CTL_SS_B + (size_t)(4 * l) * SS_BYTES + ((size_t)u.pm * 256 + i * 128) * 8; }
    unsigned char* ws; int l; float sc; bool q8; int pn0;
    __device__ __forceinline__ void operator()(const AccT& acc, const pg8::Unit& u, int wr, int wc, int fr_, int fq_, const LAS unsigned char* rt) const {
        EPI_NODUP
        EPI_LAUNDER
        const int row0 = u.pm * 256 + wr * 64 + fr, pn = u.pn + pn0;
        const unsigned char* ssin = ws + CTL_SS_B + (size_t)(4 * l) * SS_BYTES;
        if (pn <= 8) {
            unsigned char* dst; int pitch, coff; unsigned char* ssacc = nullptr;
            if (pn < 3) { dst = ws + WS_S + S_CQ; pitch = QLORA; coff = pn * 256; ssacc = ws + CTL_SS_B + (size_t)(4 * l + 1) * SS_BYTES; }
            else if (pn == 3) { dst = ws + WS_S + S_CKV; pitch = 256; coff = 0; ssacc = ws + CTL_SS_B + (size_t)(4 * l + 2) * SS_BYTES; }
            else if (pn == 4) { dst = ws + WS_S + S_XP; pitch = 256; coff = 0; }
            else if (pn <= 6) { dst = ws + WS_S + S_MQK; pitch = 512; coff = (pn - 5) * 256; }
            else if (pn == 7) { dst = ws + WS_S + S_MV; pitch = 256; coff = 0; }
            else { dst = ws + WS_S + S_MO; pitch = 256; coff = 0; }
            EPI_ROWS_BEGIN_T
                const float r = rstd_of((rt ? *(const LAS u64*)(rt + (unsigned)(row - u.pm * 256) * 8u) : ldo<u64>(ssin, (unsigned)row * 8u)), 1.0f / DM) * sc; float s = 0.f;
                const unsigned ro = ((unsigned)row * (unsigned)pitch + (unsigned)(coff + wc * 32 + fq * 8)) * 2u;
#pragma unroll
                for (int bj = 0; bj < 2; ++bj) { const f32x4 v0 = acc[ai][bj][m][0] * r, v1 = acc[ai][bj][m][1] * r; s += sq4(v0) + sq4(v1);
                    if (q8 && pn <= 3) { u32x2 w; w.x = pk4_fp8(v0[0], v0[1], v0[2], v0[3]); w.y = pk4_fp8(v1[0], v1[1], v1[2], v1[3]); sto<u32x2>(dst, (ro >> 1) + bj * 128, w); }
                    else sto<u32x4>(dst, ro + bj * 256, bf8(v0, v1)); }
                if (ssacc) { s = red_fq(s); if (fq == 0) atomicAdd((u64*)(ssacc + (unsigned)row * 8u), ss_fix(s)); }
            EPI_ROWS_END
        } else {
            if (wc == 0) {
                const unsigned char* rope = ws + WS_ROPE; unsigned char* zkr = ws + WS_S + S_KR;
                EPI_ROWS_BEGIN_T
                    const float r = rstd_of((rt ? *(const LAS u64*)(rt + (unsigned)(row - u.pm * 256) * 8u) : ldo<u64>(ssin, (unsigned)row * 8u)), 1.0f / DM) * sc;
                    const f32x4 x1 = acc[ai][0][m][0] * r, x2 = acc[ai][0][m][1] * r;
                    const unsigned co = ((unsigned)rowpos(row) * 32u + fq * 4) * 4u;
                    const f32x4 c = ldo<f32x4>(rope, co), sn = ldo<f32x4>(rope, co + 64);
                    sto<u32x2>(zkr, ((unsigned)row * 32u + fq * 4) * 2u, bf4(x1 * c - x2 * sn));
                    sto<u32x2>(zkr, ((unsigned)row * 32u + 16 + fq * 4) * 2u, bf4(x2 * c + x1 * sn));
                EPI_ROWS_END
            } else if (wc == 1) {
                if (fq == 0) {
                    const f32x4 gb0 = *(const f32x4*)(inp(IN_GATE_BIAS) + l * 8), gb1 = *(const f32x4*)(inp(IN_GATE_BIAS) + l * 8 + 4); unsigned char* gates = ws + WS_S + S_GATES;
                    EPI_ROWS_BEGIN_T
                        const float r = rstd_of((rt ? *(const LAS u64*)(rt + (unsigned)(row - u.pm * 256) * 8u) : ldo<u64>(ssin, (unsigned)row * 8u)), 1.0f / DM) * sc;
                        sto<f32x4>(gates, ((unsigned)row * 8u) * 4u, acc[ai][0][m][0] * r + gb0); sto<f32x4>(gates, ((unsigned)row * 8u + 4) * 4u, acc[ai][0][m][1] * r + gb1);
                    EPI_ROWS_END
                }
            }
        }
    }
};
struct EpiQ {
    static constexpr bool PERM = true;
    static constexpr int NST = 16;
    __device__ static __forceinline__ bool nst_ok(const pg8::Unit& u) { return true; }
    static constexpr bool RT = true;
    __device__ __forceinline__ const unsigned char* rt_src(const pg8::Unit& u, int i) const { return ws + CTL_SS_B + (size_t)(4 * l + 1) * SS_BYTES + ((size_t)u.pm * 256 + i * 128) * 8; }
    unsigned char* ws; int l; float sc;
    __device__ __forceinline__ void operator()(const AccT& acc, const pg8::Unit& u, int wr, int wc, int fr_, int fq_, const LAS unsigned char* rt) const {
        EPI_LAUNDER
        const int row0 = u.pm * 256 + wr * 64 + fr, pn = u.pn;
        const unsigned char* ssin = ws + CTL_SS_B + (size_t)(4 * l + 1) * SS_BYTES; unsigned char* q = ws + WS_S + S_Q; const unsigned char* rope = ws + WS_ROPE;
        EPI_ROWS_BEGIN_T
            const float r = rstd_of((rt ? *(const LAS u64*)(rt + (unsigned)(row - u.pm * 256) * 8u) : ldo<u64>(ssin, (unsigned)row * 8u)), 1.0f / QLORA) * (QSCALE * sc);
            const unsigned ro = ((unsigned)row * 768u + (unsigned)(pn * 256 + wc * 32 + fq * 4)) * 2u;
            if (pn < 2) {
                const unsigned rw = ((unsigned)row * 768u + (unsigned)(pn * 256 + wc * 32 + fq * 8)) * 2u;
#pragma unroll
                for (int bj = 0; bj < 2; ++bj) sto<u32x4>(q, rw + bj * 256, bf8(acc[ai][bj][m][0] * r, acc[ai][bj][m][1] * r));
            } else {
                const unsigned co = ((unsigned)rowpos(row) * 32u + fq * 4) * 4u;
                const f32x4 c = ldo<f32x4>(rope, co), sn = ldo<f32x4>(rope, co + 64);
#pragma unroll
                for (int bj = 0; bj < 2; ++bj) { const f32x4 x1 = acc[ai][bj][m][0] * r, x2 = acc[ai][bj][m][1] * r;
                    sto<u32x2>(q, ro + bj * 256, bf4(x1 * c - x2 * sn)); sto<u32x2>(q, ro + bj * 256 + 32, bf4(x2 * c + x1 * sn)); }
            }
        EPI_ROWS_END
    }
};
struct EpiKV {
    static constexpr bool PERM = true;
    static constexpr int NST = 16;
    __device__ static __forceinline__ bool nst_ok(const pg8::Unit& u) { return true; }
    static constexpr bool RT = true;
    __device__ __forceinline__ const unsigned char* rt_src(const pg8::Unit& u, int i) const { return ws + CTL_SS_B + (size_t)(4 * l + 2) * SS_BYTES + ((size_t)u.pm * 256 + i * 128) * 8; }
    unsigned char* ws; int l; float sc;
    __device__ __forceinline__ void operator()(const AccT& acc, const pg8::Unit& u, int wr, int wc, int fr_, int fq_, const LAS unsigned char* rt) const {
        EPI_LAUNDER
        const int row0 = u.pm * 256 + wr * 64 + fr, pn = u.pn;
        const unsigned char* ssin = ws + CTL_SS_B + (size_t)(4 * l + 2) * SS_BYTES;
        unsigned char* dst = ws + WS_S + ((pn < 2) ? S_KN : S_V); const int coff = (pn & 1) * 256 + wc * 32 + fq * 8;
        EPI_ROWS_BEGIN_T
            const float r = rstd_of((rt ? *(const LAS u64*)(rt + (unsigned)(row - u.pm * 256) * 8u) : ldo<u64>(ssin, (unsigned)row * 8u)), 1.0f / KVLORA) * sc;
            const unsigned ro = ((unsigned)row * 512u + (unsigned)coff) * 2u;
#pragma unroll
            for (int bj = 0; bj < 2; ++bj) sto<u32x4>(dst, ro + bj * 256, bf8(acc[ai][bj][m][0] * r, acc[ai][bj][m][1] * r));
        EPI_ROWS_END
    }
};
struct EpiRes {
    static constexpr bool PERM = true;
    static constexpr int NST = 40;
    __device__ static __forceinline__ bool nst_ok(const pg8::Unit& u) { return true; }
    static constexpr bool RT = false;
    unsigned char* ws; int ssidx; float sc; bool emit8;
    __device__ __forceinline__ void operator()(const AccT& acc, const pg8::Unit& u, int wr, int wc, int fr_, int fq_, const LAS unsigned char* rt) const {
        EPI_NODUP
        EPI_LAUNDER
        const int row0 = u.pm * 256 + wr * 64 + fr, pn = u.pn;
        unsigned char* h = ws + WS_H; unsigned char* ssout = ws + CTL_SS_B + (size_t)ssidx * SS_BYTES;
        EPI_ROWS_BEGIN_T
            const unsigned ro = ((unsigned)row * (unsigned)DM + (unsigned)(pn * 256 + wc * 32 + fq * 8)) * 2u; float s = 0.f;
#pragma unroll
            for (int bj = 0; bj < 2; ++bj) {
                const u32x4 o = ldo<u32x4>(h, ro + bj * 256);
                const f32x4 a = acc[ai][bj][m][0], b = acc[ai][bj][m][1];
                const float v0 = __builtin_fmaf(a[0], sc, bflo(o.x)), v1 = __builtin_fmaf(a[1], sc, bfhi(o.x)), v2 = __builtin_fmaf(a[2], sc, bflo(o.y)), v3 = __builtin_fmaf(a[3], sc, bfhi(o.y));
                const float v4 = __builtin_fmaf(b[0], sc, bflo(o.z)), v5 = __builtin_fmaf(b[1], sc, bfhi(o.z)), v6 = __builtin_fmaf(b[2], sc, bflo(o.w)), v7 = __builtin_fmaf(b[3], sc, bfhi(o.w));
                u32x4 w; w.x = pk2(v0, v1); w.y = pk2(v2, v3); w.z = pk2(v4, v5); w.w = pk2(v6, v7);
                sto<u32x4>(h, ro + bj * 256, w);
                if (emit8) { u32x2 q; q.x = pk4_fp8(v0, v1, v2, v3); q.y = pk4_fp8(v4, v5, v6, v7); sto<u32x2>(ws + WS_H8, (ro >> 1) + bj * 128, q); }
                s = __builtin_fmaf(v0, v0, s); s = __builtin_fmaf(v1, v1, s); s = __builtin_fmaf(v2, v2, s); s = __builtin_fmaf(v3, v3, s);
                s = __builtin_fmaf(v4, v4, s); s = __builtin_fmaf(v5, v5, s); s = __builtin_fmaf(v6, v6, s); s = __builtin_fmaf(v7, v7, s);
            }
            s = red_fq(s); if (fq == 0) atomicAdd((u64*)(ssout + (unsigned)row * 8u), ss_fix(s));
        EPI_ROWS_END
    }
};
__device__ __forceinline__ f32x4 swiglu4(const f32x4 g, const f32x4 u, const float c1, const float lk, const float ik) {
    f32x4 t;
#pragma unroll
    for (int e = 0; e < 4; ++e) t[e] = fexp2(__builtin_fmaf(g[e], c1, lk));
#pragma unroll
    for (int e = 0; e < 4; ++e) t[e] = frcp(ik + t[e]);
    const f32x4 p = g * u;
    return p * t;
}
struct EpiGU {
    static constexpr bool PERM = true;
    static constexpr int NST = 8;
    __device__ static __forceinline__ bool nst_ok(const pg8::Unit& u) { return true; }
    static constexpr bool RT = true;
    __device__ __forceinline__ const unsigned char* rt_src(const pg8::Unit& u, int i) const { return ws + CTL_SS_B + (size_t)(ssidx) * SS_BYTES + ((size_t)u.pm * 256 + i * 128) * 8; }
    unsigned char* ws; int ssidx;
    __device__ __forceinline__ void operator()(const AccT& acc, const pg8::Unit& u, int wr, int wc, int fr_, int fq_, const LAS unsigned char* rt) const {
#ifdef PROBE_NOEPI
        EPI_NODUP
#endif
        EPI_LAUNDER
        const int row0 = u.pm * 256 + wr * 64 + fr, pn = u.pn;
        const unsigned char* ssin = ws + CTL_SS_B + (size_t)ssidx * SS_BYTES; unsigned char* act = ws + WS_S + S_ACT;
        EPI_ROWS_BEGIN_T
            const float r = rstd_of((rt ? *(const LAS u64*)(rt + (unsigned)(row - u.pm * 256) * 8u) : ldo<u64>(ssin, (unsigned)row * 8u)), 1.0f / DM), c1 = r * -1.4426950408889634f, lk = -2.0f * __builtin_amdgcn_logf(r), ik = frcp(r * r);
            f32x4 o[2];
#pragma unroll
            for (int n = 0; n < 2; ++n) o[n] = swiglu4(acc[ai][0][m][n], acc[ai][1][m][n], c1, lk, ik);
            sto<u32x4>(act, ((unsigned)row * (unsigned)DFF + (unsigned)(pn * 128 + wc * 32 + fq * 8)) * 2u, bf8(o[0], o[1]));
        EPI_ROWS_END
    }
};
struct EpiMoeGU {
    static constexpr bool PERM = true;
    static constexpr int NST = 0;
    __device__ static __forceinline__ bool nst_ok(const pg8::Unit& u) { return true; }
    static constexpr bool RT = false;
    unsigned char* ws; int blk0;
    __device__ __forceinline__ void operator()(const AccT& acc, const pg8::Unit& u, int wr, int wc, int fr_, int fq_, const LAS unsigned char* rt) const {
        EPI_LAUNDER
        const int row0 = wr * 64 + fr, pn = u.pn;
        const unsigned char* srstd = ws + WS_S + S_SRSTD; unsigned char* act = ws + WS_S + S_ACTE;
        EPI_ROWS_BEGIN
            const float r = ldo<float>(srstd, ((unsigned)u.pm * 256u + row) * 4u);
            f32x4 o[2];
#pragma unroll
            for (int n = 0; n < 2; ++n) { const f32x4 g = acc[ai][0][m][n] * r, uu = acc[ai][1][m][n] * r;
#pragma unroll
                for (int e = 0; e < 4; ++e) o[n][e] = siluf_(g[e]) * uu[e]; }
            sto<u32x4>(act, (((unsigned)(u.pm - blk0) * 256u + row) * (unsigned)DFFE + (unsigned)(pn * 128 + wc * 32 + fq * 8)) * 2u, bf8(o[0], o[1]));
        EPI_ROWS_END
    }
};
struct EpiMoeDown {
    static constexpr bool PERM = true;
    static constexpr int NST = 0;
    __device__ static __forceinline__ bool nst_ok(const pg8::Unit& u) { return true; }
    static constexpr bool RT = false;
    unsigned char* ws;
    __device__ __forceinline__ void operator()(const AccT& acc, const pg8::Unit& u, int wr, int wc, int fr_, int fq_, const LAS unsigned char* rt) const {
        EPI_LAUNDER
        const int row0 = wr * 64 + fr, pn = u.pn;
        const unsigned char* sslot = ws + WS_S + S_SSLOT; const unsigned char* sgate = ws + WS_S + S_SGATE; unsigned char* y = ws + WS_S + S_Y;
        EPI_ROWS_BEGIN
            const unsigned so = ((unsigned)u.pm * 256u + row) * 4u;
            const int slot = ldo<int>(sslot, so); const float g = ldo<float>(sgate, so);
            if (slot >= 0) {
                const unsigned ro = ((unsigned)slot * (unsigned)DM + (unsigned)(pn * 256 + wc * 32 + fq * 8)) * 2u;
#pragma unroll
                for (int bj = 0; bj < 2; ++bj) sto<u32x4>(y, ro + bj * 256, bf8(acc[ai][bj][m][0] * g, acc[ai][bj][m][1] * g));
            }
        EPI_ROWS_END
    }
};
struct EpiMoeGU8 {
    static constexpr bool PERM = true;
    static constexpr int NST = 8;
    __device__ static __forceinline__ bool nst_ok(const pg8::Unit& u) { return true; }
    static constexpr bool RT = false;
    unsigned char* ws; int blk0;
    __device__ __forceinline__ void operator()(const AccT& acc, const pg8::Unit& u, int wr, int wc, int fr_, int fq_, const LAS unsigned char* rt) const {
        EPI_LAUNDER
        const int row0 = wr * 64 + fr, pn = u.pn;
        unsigned char* act = ws + WS_S + S_ACTE;
        static_assert(W8_SCALE == 64.0f && ACT8_SCALE == 8.0f, "k = ACT8_SCALE / W8_SCALE^2 = 2^-9 below");
        const float c1 = -1.4426950408889634f / W8_SCALE, lk = 9.0f, ik = 512.0f;
        EPI_ROWS_BEGIN
            f32x4 o[2];
#pragma unroll
            for (int n = 0; n < 2; ++n) o[n] = swiglu4(acc[ai][0][m][n], acc[ai][1][m][n], c1, lk, ik);
            u32x2 w; w.x = pk4_fp8(o[0][0], o[0][1], o[0][2], o[0][3]); w.y = pk4_fp8(o[1][0], o[1][1], o[1][2], o[1][3]);
            sto<u32x2>(act, ((unsigned)(u.pm - blk0) * 256u + row) * (unsigned)DFFE + (unsigned)(pn * 128 + wc * 32 + fq * 8), w);
        EPI_ROWS_END
    }
};
struct EpiMoeDown8 {
    static constexpr bool PERM = true;
    static constexpr int NST = 0;
    __device__ static __forceinline__ bool nst_ok(const pg8::Unit& u) { return true; }
    static constexpr bool RT = true;
    __device__ __forceinline__ const unsigned char* rt_src(const pg8::Unit& u, int i) const { return ws + WS_S + (i == 0 ? S_SSLOT : S_SGATE) + (size_t)u.pm * 1024; }
    unsigned char* ws;
    __device__ __forceinline__ void operator()(const AccT& acc, const pg8::Unit& u, int wr, int wc, int fr_, int fq_, const LAS unsigned char* rt) const {
        EPI_LAUNDER
        const int row0 = wr * 64 + fr, pn = u.pn;
        const unsigned char* sslot = ws + WS_S + S_SSLOT; const unsigned char* sgate = ws + WS_S + S_SGATE; unsigned char* y = ws + WS_S + S_Y;
        EPI_ROWS_BEGIN
            const unsigned so = ((unsigned)u.pm * 256u + row) * 4u;
            const int slot = rt ? *(const LAS int*)(rt + (unsigned)row * 4u) : ldo<int>(sslot, so); const float g = (rt ? *(const LAS float*)(rt + 1024 + (unsigned)row * 4u) : ldo<float>(sgate, so)) * (1.0f / (W8_SCALE * ACT8_SCALE));
            if (slot >= 0) {
                const unsigned ro = ((unsigned)slot * (unsigned)DM + (unsigned)(pn * 256 + wc * 32 + fq * 8)) * 2u;
#pragma unroll
                for (int bj = 0; bj < 2; ++bj) sto<u32x4>(y, ro + bj * 256, bf8(acc[ai][bj][m][0] * g, acc[ai][bj][m][1] * g));
            }
        EPI_ROWS_END
    }
};
struct EpiGU8 {
    static constexpr bool PERM = true;
    static constexpr int NST = 8;
    __device__ static __forceinline__ bool nst_ok(const pg8::Unit& u) { return true; }
    static constexpr bool RT = true;
    __device__ __forceinline__ const unsigned char* rt_src(const pg8::Unit& u, int i) const { return ws + CTL_SS_B + (size_t)(ssidx) * SS_BYTES + ((size_t)u.pm * 256 + i * 128) * 8; }
    unsigned char* ws; int ssidx;
    __device__ __forceinline__ void operator()(const AccT& acc, const pg8::Unit& u, int wr, int wc, int fr_, int fq_, const LAS unsigned char* rt) const {
        EPI_LAUNDER
        const int row0 = u.pm * 256 + wr * 64 + fr, pn = u.pn;
        const unsigned char* ssin = ws + CTL_SS_B + (size_t)ssidx * SS_BYTES; unsigned char* act = ws + WS_S + S_ACT;
        EPI_ROWS_BEGIN_T
            const float r = rstd_of((rt ? *(const LAS u64*)(rt + (unsigned)(row - u.pm * 256) * 8u) : ldo<u64>(ssin, (unsigned)row * 8u)), 1.0f / DM) * (1.0f / W8_SCALE), c1 = r * -1.4426950408889634f;
            const float lk = -2.0f * __builtin_amdgcn_logf(r) - 3.0f, ik = frcp(r * r * ACT8_SCALE);
            f32x4 o[2];
#pragma unroll
            for (int n = 0; n < 2; ++n) o[n] = swiglu4(acc[ai][0][m][n], acc[ai][1][m][n], c1, lk, ik);
            u32x2 w; w.x = pk4_fp8(o[0][0], o[0][1], o[0][2], o[0][3]); w.y = pk4_fp8(o[1][0], o[1][1], o[1][2], o[1][3]);
            sto<u32x2>(act, (unsigned)row * (unsigned)DFF + (unsigned)(pn * 128 + wc * 32 + fq * 8), w);
        EPI_ROWS_END
    }
};
struct MixP { const bf16_t *q, *kn, *v, *kr, *xp, *mqk, *mv, *mo; const float* gates; bf16_t* cat; const float *conv_w, *conv_b, *mnorm; bool f8; };
__device__ __forceinline__ void cat_store(const MixP& P, size_t elem, const u32x4 v) {
    if (P.f8) { u32x2 w; w.x = pk4_fp8(bflo(v.x), bfhi(v.x), bflo(v.y), bfhi(v.y)); w.y = pk4_fp8(bflo(v.z), bfhi(v.z), bflo(v.w), bfhi(v.w)); *(u32x2*)((unsigned char*)P.cat + elem) = w; }
    else *(u32x4*)(P.cat + elem) = v;
}
#define MFMA32(a, b, c) __builtin_amdgcn_mfma_f32_32x32x16_bf16((a), (b), (c), 0, 0, 0)
__device__ __forceinline__ int crow(int r, int hi) { return (r & 3) + 8 * (r >> 2) + 4 * hi; }
__device__ __forceinline__ float swap_max(float m) { auto rr = __builtin_amdgcn_permlane32_swap(__float_as_uint(m), __float_as_uint(m), false, false); return fmaxf(__uint_as_float(rr[0]), __uint_as_float(rr[1])); }
__device__ __forceinline__ float swap_sum(float m) { auto rr = __builtin_amdgcn_permlane32_swap(__float_as_uint(m), __float_as_uint(m), false, false); return __uint_as_float(rr[0]) + __uint_as_float(rr[1]); }
__device__ __forceinline__ s16x4 vtr(const LAS char* p) { typedef short v4i16_t __attribute__((ext_vector_type(4))); return __builtin_bit_cast(s16x4, __builtin_amdgcn_ds_read_tr16_b64_v4i16((LAS v4i16_t*)p)); }

__device__ __forceinline__ bf16x8 pack8(const f32x16& p, int s) { u32x4 w; w.x = pk2(p[8 * s], p[8 * s + 1]); w.y = pk2(p[8 * s + 2], p[8 * s + 3]); w.z = pk2(p[8 * s + 4], p[8 * s + 5]); w.w = pk2(p[8 * s + 6], p[8 * s + 7]); return __builtin_bit_cast(bf16x8, w); }
__device__ __forceinline__ bf16x8 cat8(s16x4 lo, s16x4 hi) { return (bf16x8){lo[0], lo[1], lo[2], lo[3], hi[0], hi[1], hi[2], hi[3]}; }
template <int BASE> __device__ __forceinline__ void vtr_half(unsigned va, bf16x8& v00, bf16x8& v01, bf16x8& v10, bf16x8& v11) {
    s16x4 a0, a1, a2, a3, b0, b1, b2, b3;
    asm volatile("ds_read_b64_tr_b16 %0, %1 offset:%c2" : "=&v"(a0) : "v"(va), "i"(BASE) : "memory");
    asm volatile("ds_read_b64_tr_b16 %0, %1 offset:%c2" : "=&v"(a1) : "v"(va), "i"(BASE + 512) : "memory");
    asm volatile("ds_read_b64_tr_b16 %0, %1 offset:%c2" : "=&v"(a2) : "v"(va), "i"(BASE + 4096) : "memory");
    asm volatile("ds_read_b64_tr_b16 %0, %1 offset:%c2" : "=&v"(a3) : "v"(va), "i"(BASE + 4096 + 512) : "memory");
    asm volatile("ds_read_b64_tr_b16 %0, %1 offset:%c2" : "=&v"(b0) : "v"(va), "i"(BASE + 1024) : "memory");
    asm volatile("ds_read_b64_tr_b16 %0, %1 offset:%c2" : "=&v"(b1) : "v"(va), "i"(BASE + 1024 + 512) : "memory");
    asm volatile("ds_read_b64_tr_b16 %0, %1 offset:%c2" : "=&v"(b2) : "v"(va), "i"(BASE + 4096 + 1024) : "memory");
    asm volatile("ds_read_b64_tr_b16 %0, %1 offset:%c2" : "=&v"(b3) : "v"(va), "i"(BASE + 4096 + 1024 + 512) : "memory");
    asm volatile("s_waitcnt lgkmcnt(0)" ::: "memory");
    __builtin_amdgcn_sched_barrier(0);
    v00 = cat8(a0, a1); v01 = cat8(a2, a3); v10 = cat8(b0, b1); v11 = cat8(b2, b3);
}
__device__ __forceinline__ void kread6_issue(unsigned ae, unsigned ao, bf16x8& f0, bf16x8& f1, bf16x8& f2, bf16x8& f3, bf16x8& f4, bf16x8& f5) {
    asm volatile("ds_read_b128 %0, %1" : "=&v"(f0) : "v"(ae) : "memory");
    asm volatile("ds_read_b128 %0, %1" : "=&v"(f1) : "v"(ao) : "memory");
    asm volatile("ds_read_b128 %0, %1 offset:64" : "=&v"(f2) : "v"(ae) : "memory");
    asm volatile("ds_read_b128 %0, %1 offset:64" : "=&v"(f3) : "v"(ao) : "memory");
    asm volatile("ds_read_b128 %0, %1 offset:128" : "=&v"(f4) : "v"(ae) : "memory");
    asm volatile("ds_read_b128 %0, %1 offset:128" : "=&v"(f5) : "v"(ao) : "memory");
}
constexpr int ATT_NBUF = 4, AK_BYTES = 64 * 192, A_K0 = 0, A_V0 = ATT_NBUF * AK_BYTES, A_WS = A_V0 + ATT_NBUF * 8192, A_OST = A_WS + 8 * 256, A_END = A_OST + 8 * 4096;
static_assert(A_END <= RING_BYTES, "attention LDS");
#ifndef ATT_THR
#define ATT_THR 4.0f
#endif
constexpr size_t WS_ZERO16 = 61440;
__device__ __forceinline__ int akoff(int key, int c) { return (key * 12 + (c ^ ((key >> 2) & 3))) * 16; }

template <int VAR = 0>
__device__ __forceinline__ void attn_unit(LAS unsigned char* lds, const MixP& P, const unsigned char* ws, int tid_, int b, int hd, int qt) {
#define AEXP(x) ((VAR == 1) ? (x) * 0.001f + 0.01f : fexp2(x))
    int tid = tid_; asm volatile("" : "+v"(tid));
    const int lane = tid & 63, wid = __builtin_amdgcn_readfirstlane(tid >> 6), r32 = lane & 31, hh = lane >> 5;
    const bool meta = qt < 0;
    const int qbase = meta ? MMAIN + wid * 32 : b * SEQ + qt * 256 + wid * 32;
    const int cw = (meta || VAR == 5) ? 0 : qt * 4 + (wid >> 1) + 1, NT = (meta || VAR == 5) ? 1 : qt * 4 + 5;
    const bool active = !meta || wid == 0;
    bf16x8 qf[6];
    { const bf16_t* qr = P.q + (size_t)(qbase + r32) * 768;
#pragma unroll
      for (int d0 = 0; d0 < 4; ++d0) qf[d0] = *(const bf16x8*)(qr + hd * 64 + d0 * 16 + hh * 8);
#pragma unroll
      for (int d0 = 0; d0 < 2; ++d0) qf[4 + d0] = *(const bf16x8*)(qr + 512 + hd * 32 + d0 * 16 + hh * 8); }
    const char* src1[3]; const char* src0[3]; unsigned strd[3]; unsigned ldst[3];
#pragma unroll
    for (int i = 0; i < 3; ++i) { const int q = wid + 8 * i;
        if (q < 12) { const int s = q * 64 + lane, key = s / 12, pos = s - key * 12, c = pos ^ ((key >> 2) & 3);
            const bool nope = c < 8;
            const bf16_t* base = nope ? P.kn + hd * 64 + c * 8 : P.kr + (c - 8) * 8; const int pitch = nope ? 512 : 32;
            src1[i] = (const char*)(base + (size_t)(b * SEQ + key) * pitch); strd[i] = (unsigned)(64 * pitch * 2);
            src0[i] = key < NMETA ? (const char*)(base + (size_t)(MMAIN + key) * pitch) : (const char*)(ws + WS_ZERO16);
            ldst[i] = (unsigned)(q * 1024);
        } else { const int t = (q - 12) * 64 + lane, key = ((t >> 6) & 3) * 16 + ((t >> 2) & 15), ch = (t >> 8) * 4 + (t & 3);
            const bf16_t* base = P.v + hd * 64 + ch * 8;
            src1[i] = (const char*)(base + (size_t)(b * SEQ + key) * 512); strd[i] = 65536u;
            src0[i] = key < NMETA ? (const char*)(base + (size_t)(MMAIN + key) * 512) : (const char*)(ws + WS_ZERO16);
            ldst[i] = (unsigned)(A_V0 - 12 * 1024 + q * 1024);
        } }
    const int nmine = (wid < 4) ? 3 : 2;
    const int ksw0 = (r32 >> 2) & 3, ksw1 = ((32 + r32) >> 2) & 3;
    const unsigned ke0 = (unsigned)((r32 * 12 + (hh ^ ksw0)) * 16), ko0 = (unsigned)((r32 * 12 + ((2 + hh) ^ ksw0)) * 16);
    const unsigned ke1 = (unsigned)(((32 + r32) * 12 + (hh ^ ksw1)) * 16), ko1 = (unsigned)(((32 + r32) * 12 + ((2 + hh) ^ ksw1)) * 16);
    const unsigned ldsb = (unsigned)(uintptr_t)lds;
#define ATT_DMA(J, BSEL) do { _Pragma("unroll") for (int i_ = 0; i_ < 3; ++i_) { if (i_ < nmine) { const int q_ = wid + 8 * i_; \
        const char* g_ = ((J) == 0) ? src0[i_] : src1[i_] + (size_t)((J) - 1) * strd[i_]; \
        const unsigned l_ = ldst[i_] + (unsigned)(BSEL) * (q_ < 12 ? (unsigned)AK_BYTES : 8192u); \
        __builtin_amdgcn_global_load_lds((const unsigned*)g_, (LAS unsigned*)(lds + l_), 16, 0, 0); } } } while (0)
    f32x16 o0, o1;
#pragma unroll
    for (int i = 0; i < 16; ++i) { o0[i] = 0.f; o1[i] = 0.f; }
    float m_run = 0.f, l_run = 0.f; f32x16 negm;
#pragma unroll
    for (int i = 0; i < 16; ++i) negm[i] = 0.f;
#define ATT_NEGM() do { _Pragma("unroll") for (int i_ = 0; i_ < 16; ++i_) negm[i_] = -m_run; asm volatile("" : "+v"(negm)); } while (0)
    LAS float* wsf = (LAS float*)(lds + A_WS + wid * 256);
#define ATT_WAIT(AH) do { if ((AH) >= 2) { if (wid < 4) asm volatile("s_waitcnt vmcnt(6)" ::: "memory"); else asm volatile("s_waitcnt vmcnt(4)" ::: "memory"); } \
        else if ((AH) == 1) { if (wid < 4) asm volatile("s_waitcnt vmcnt(3)" ::: "memory"); else asm volatile("s_waitcnt vmcnt(2)" ::: "memory"); } \
        else asm volatile("s_waitcnt vmcnt(0)" ::: "memory"); } while (0)
    const bool grpB = wid >= 4;
    ATT_DMA(0, 0);
    if (NT > 1) ATT_DMA(1, 1);
    if (grpB && NT > 2) ATT_DMA(2, 2);
    { const int ah0 = grpB ? (NT > 2 ? 2 : NT - 1) : (NT > 1 ? 1 : 0); ATT_WAIT(ah0); }
    __builtin_amdgcn_s_barrier(); asm volatile("" ::: "memory");
    if (grpB) { __builtin_amdgcn_s_barrier(); asm volatile("" ::: "memory"); }
    int bcur = 0;
    bf16x8 pa0, pa1, pa2, pa3;
    const int q4 = (lane & 15) >> 2, p4 = lane & 3, blk = (lane >> 4) & 1;
    const unsigned vlane = (unsigned)((4 * hh + q4) * 64 + blk * 32 + p4 * 8);
#define ATT_PV(J1) do { const unsigned vp_ = ldsb + A_V0 + (unsigned)((bcur + 3) & 3) * 8192u + vlane; \
        if ((J1) == 0) { bf16x8 v00, v01, v10, v11; vtr_half<0>(vp_, v00, v01, v10, v11); o0 = MFMA32(pa0, v00, o0); o1 = MFMA32(pa0, v01, o1); } \
        else { { bf16x8 v00, v01, v10, v11; vtr_half<0>(vp_, v00, v01, v10, v11); o0 = MFMA32(pa0, v00, o0); o1 = MFMA32(pa0, v01, o1); o0 = MFMA32(pa1, v10, o0); o1 = MFMA32(pa1, v11, o1); } \
               { bf16x8 v00, v01, v10, v11; vtr_half<2048>(vp_, v00, v01, v10, v11); o0 = MFMA32(pa2, v00, o0); o1 = MFMA32(pa2, v01, o1); o0 = MFMA32(pa3, v10, o0); o1 = MFMA32(pa3, v11, o1); } } } while (0)
    for (int j = 0; j < NT; ++j) {
        if (!grpB && VAR != 4 && j + 2 < NT) ATT_DMA(j + 2, (bcur + 2) & 3);
        f32x16 p0, p1;
        __builtin_amdgcn_s_setprio(1);
        if (active) {
            const unsigned kb_ = ldsb + A_K0 + bcur * AK_BYTES;
            if (j <= cw) {
                if (j == 0) {
#pragma unroll
                    for (int i = 0; i < 16; ++i) p0[i] = 0.f;
                    bf16x8 a0, a1, a2, a3, a4, a5;
                    kread6_issue(kb_ + ke0, kb_ + ko0, a0, a1, a2, a3, a4, a5);
                    asm volatile("s_waitcnt lgkmcnt(0)" ::: "memory"); __builtin_amdgcn_sched_barrier(0);
                    p0 = MFMA32(a0, qf[0], p0); p0 = MFMA32(a1, qf[1], p0); p0 = MFMA32(a2, qf[2], p0); p0 = MFMA32(a3, qf[3], p0); p0 = MFMA32(a4, qf[4], p0); p0 = MFMA32(a5, qf[5], p0);
                } else {
                    bf16x8 a0, a1, a2, a3, a4, a5, b0, b1, b2, b3, b4, b5;
                    kread6_issue(kb_ + ke0, kb_ + ko0, a0, a1, a2, a3, a4, a5); kread6_issue(kb_ + ke1, kb_ + ko1, b0, b1, b2, b3, b4, b5);
                    asm volatile("s_waitcnt lgkmcnt(0)" ::: "memory"); __builtin_amdgcn_sched_barrier(0);
                    p0 = MFMA32(a0, qf[0], negm); p1 = MFMA32(b0, qf[0], negm); p0 = MFMA32(a1, qf[1], p0); p1 = MFMA32(b1, qf[1], p1); p0 = MFMA32(a2, qf[2], p0); p1 = MFMA32(b2, qf[2], p1);
                    p0 = MFMA32(a3, qf[3], p0); p1 = MFMA32(b3, qf[3], p1); p0 = MFMA32(a4, qf[4], p0); p1 = MFMA32(b4, qf[4], p1); p0 = MFMA32(a5, qf[5], p0); p1 = MFMA32(b5, qf[5], p1);
                }
            }
            if (j >= 1 && j - 1 <= cw) ATT_PV(j - 1);
        }
        __builtin_amdgcn_s_setprio(0);
        if (grpB) { const int ah = (VAR == 4) ? 0 : (j + 2 < NT) ? 1 : 0; ATT_WAIT(ah); }
        asm volatile("s_waitcnt lgkmcnt(0)" ::: "memory");
        __builtin_amdgcn_s_barrier(); asm volatile("" ::: "memory");
        if (grpB && VAR != 4 && j + 3 < NT) ATT_DMA(j + 3, (bcur + 3) & 3);
        if (active && j <= cw) {
            if (j == 0) {
                float mx = fmaxf(fmaxf(p0[0], p0[1]), fmaxf(p0[2], p0[3]));
                mx = fmaxf(mx, fmaxf(fmaxf(p0[4], p0[5]), fmaxf(p0[6], p0[7])));
                m_run = swap_max(mx); ATT_NEGM();
                float ls = 0.f;
#pragma unroll
                for (int i = 0; i < 8; ++i) { p0[i] = fexp2(p0[i] - m_run); ls += p0[i]; }
                l_run = ls;
                pa0 = pack8(p0, 0);
            } else {
                float dl0 = 0.f;
                {
                    float mx = fmaxf(p0[0], p0[1]);
#pragma unroll
                    for (int i = 2; i < 16; ++i) mx = fmaxf(mx, p0[i]);
                    mx = swap_max(mx);
                    if (__any(mx > ATT_THR)) {
                        const float dl = fmaxf(mx, 0.f), sc = fexp2(-dl);
                        m_run += dl; l_run *= sc; dl0 = dl; ATT_NEGM();
#pragma unroll
                        for (int i = 0; i < 16; ++i) p0[i] -= dl;
                        if (hh == 0) wsf[r32] = sc;
#pragma unroll
                        for (int i = 0; i < 16; ++i) { const float f = wsf[crow(i, hh)]; o0[i] *= f; o1[i] *= f; }
                    }
                    float ls = 0.f;
#pragma unroll
                    for (int i = 0; i < 16; ++i) { p0[i] = AEXP(p0[i]); ls += p0[i]; }
                    l_run += ls;
                    pa0 = pack8(p0, 0); pa1 = pack8(p0, 1);
                }
                {
                    float mx = fmaxf(p1[0], p1[1]);
#pragma unroll
                    for (int i = 2; i < 16; ++i) mx = fmaxf(mx, p1[i]);
                    mx = swap_max(mx) - dl0;
                    if (__any(dl0 > 0.f)) {
#pragma unroll
                        for (int i = 0; i < 16; ++i) p1[i] -= dl0; }
                    if (__any(mx > ATT_THR)) {
                        const float dl = fmaxf(mx, 0.f), sc = fexp2(-dl);
                        m_run += dl; l_run *= sc; ATT_NEGM();
#pragma unroll
                        for (int i = 0; i < 16; ++i) p1[i] -= dl;
                        if (hh == 0) wsf[r32] = sc;
#pragma unroll
                        for (int i = 0; i < 16; ++i) { const float f = wsf[crow(i, hh)]; o0[i] *= f; o1[i] *= f; }
#pragma unroll
                        for (int i = 0; i < 16; ++i) p0[i] *= sc;
                        pa0 = pack8(p0, 0); pa1 = pack8(p0, 1);
                    }
                    float ls = 0.f;
#pragma unroll
                    for (int i = 0; i < 16; ++i) { p1[i] = AEXP(p1[i]); ls += p1[i]; }
                    l_run += ls;
                    pa2 = pack8(p1, 0); pa3 = pack8(p1, 1);
                }
            }
        }
        if (!grpB) { const int ah = (VAR == 4) ? 0 : (j + 2 < NT) ? 1 : 0; ATT_WAIT(ah); }
        asm volatile("s_waitcnt lgkmcnt(0)" ::: "memory");
        __builtin_amdgcn_s_barrier(); asm volatile("" ::: "memory");
        bcur = (bcur + 1) & 3;
    }
    if (active && NT - 1 <= cw) ATT_PV(NT - 1);
    if (!grpB) { __builtin_amdgcn_s_barrier(); asm volatile("" ::: "memory"); }
#undef ATT_PV
#undef ATT_DMA
#undef ATT_WAIT
#undef ATT_NEGM
    if (active) {
        const float lt = swap_sum(l_run);
        if (hh == 0) wsf[32 + r32] = lt;
        LAS bf16_t* stg = (LAS bf16_t*)(lds + A_OST + wid * 4096);
#pragma unroll
        for (int i = 0; i < 16; ++i) { const int orow = crow(i, hh); const float rl = frcp(wsf[32 + orow]);
            stg[orow * 64 + r32] = (bf16_t)f2bf(o0[i] * rl); stg[orow * 64 + 32 + r32] = (bf16_t)f2bf(o1[i] * rl); }
        const int nvalid = meta ? 16 : 32;
#pragma unroll
        for (int it = 0; it < 4; ++it) { const int row = it * 8 + (lane >> 3), ch = lane & 7; const u32x4 val = *(const LAS u32x4*)(stg + row * 64 + ch * 8);
            if (row < nvalid) cat_store(P, (size_t)(qbase + row) * DM + hd * 64 + ch * 8, val); }
    }
    asm volatile("s_waitcnt vmcnt(0) lgkmcnt(0)" ::: "memory");
    __builtin_amdgcn_s_barrier(); asm volatile("" ::: "memory");
#undef AEXP
}

template <int W> __device__ __forceinline__ void pool_piece(const MixP& P, int b, int pos, int ch) {
    const int cnt = (pos + 1 < W) ? pos + 1 : W; const float inv = 1.0f / (float)cnt;
    u32x4 x[W];
#pragma unroll
    for (int jj = 0; jj < W; ++jj) { const u32x4 z = {0u, 0u, 0u, 0u}; x[jj] = z; if (jj < cnt) x[jj] = *(const u32x4*)(P.xp + (size_t)seqrow(b, pos - jj) * 256 + ch); }
    float a[8];
#pragma unroll
    for (int e = 0; e < 8; ++e) a[e] = 0.f;
#pragma unroll
    for (int jj = 0; jj < W; ++jj) { a[0] += bflo(x[jj].x); a[1] += bfhi(x[jj].x); a[2] += bflo(x[jj].y); a[3] += bfhi(x[jj].y); a[4] += bflo(x[jj].z); a[5] += bfhi(x[jj].z); a[6] += bflo(x[jj].w); a[7] += bfhi(x[jj].w); }
    const u32x4 self = x[0]; u32x4 o;
    o.x = pk2(a[0] * inv - bflo(self.x), a[1] * inv - bfhi(self.x)); o.y = pk2(a[2] * inv - bflo(self.y), a[3] * inv - bfhi(self.y));
    o.z = pk2(a[4] * inv - bflo(self.z), a[5] * inv - bfhi(self.z)); o.w = pk2(a[6] * inv - bflo(self.w), a[7] * inv - bfhi(self.w));
    cat_store(P, (size_t)seqrow(b, pos) * DM + 512 + ch, o);
}
__device__ __forceinline__ void pool_unit(const MixP& P, int tid_, int b, int grp) {
    int tid = tid_; asm volatile("" : "+v"(tid));
    const int t = tid & 63, pq = tid >> 6;
    const int pos = (grp == 0) ? t : NMETA + 64 * (grp - 1) + t;
    if (grp == 0 && t >= NMETA) return;
#pragma unroll
    for (int k = 0; k < 4; ++k) { const int piece = pq * 4 + k, ch = piece * 8, g = pq >> 1;
        if (g == 0) pool_piece<2>(P, b, pos, ch); else if (g == 1) pool_piece<4>(P, b, pos, ch); else if (g == 2) pool_piece<8>(P, b, pos, ch); else pool_piece<16>(P, b, pos, ch); }
}

constexpr int MLP = 144, ML_IMGB = 3 * 64 * MLP + 8192;
constexpr int ML_CB = 2 * ML_IMGB, ML_N = ML_CB + 2 * 64 * MLP, ML_H = ML_N + 512, ML_WSF = ML_H + 2 * 16384, ML_CW = ML_WSF + 1024, ML_END = ML_CW + 2560;
static_assert(ML_END <= RING_BYTES, "mLSTM LDS");
__device__ __forceinline__ float log_sigmoid_(float x) { return fminf(x, 0.f) - __logf(1.0f + __expf(-fabsf(x))); }
template <int CTRL, int ROWMASK> __device__ __forceinline__ float dpp_id(float v, float ident) {
    return __builtin_bit_cast(float, __builtin_amdgcn_update_dpp(__builtin_bit_cast(int, ident), __builtin_bit_cast(int, v), CTRL, ROWMASK, 0xf, false)); }
__device__ __forceinline__ float scan_add(float x, int lane) {
    (void)lane;
    x += dpp_id<0x111, 0xf>(x, 0.f); x += dpp_id<0x112, 0xf>(x, 0.f); x += dpp_id<0x114, 0xf>(x, 0.f); x += dpp_id<0x118, 0xf>(x, 0.f);
    x += dpp_id<0x142, 0xa>(x, 0.f); x += dpp_id<0x143, 0xc>(x, 0.f);
    return x; }
__device__ __forceinline__ float scan_max(float x, int lane) {
    (void)lane; const float ni = -3.0e38f;
    x = fmaxf(x, dpp_id<0x111, 0xf>(x, ni)); x = fmaxf(x, dpp_id<0x112, 0xf>(x, ni)); x = fmaxf(x, dpp_id<0x114, 0xf>(x, ni)); x = fmaxf(x, dpp_id<0x118, 0xf>(x, ni));
    x = fmaxf(x, dpp_id<0x142, 0xa>(x, ni)); x = fmaxf(x, dpp_id<0x143, 0xc>(x, ni));
    return x; }

__device__ __forceinline__ void mlstm_unit(LAS unsigned char* lds, const MixP& P, int tid_, int b, int hd) {
    int tid = tid_; asm volatile("" : "+v"(tid));
    const int lane = tid & 63, wid = __builtin_amdgcn_readfirstlane(tid >> 6), r32 = lane & 31, hh = lane >> 5;
    const int q4 = (lane & 15) >> 2, p4 = lane & 3, blk = (lane >> 4) & 1;
    const int ts = tid >> 3, tj = tid & 7;
    LAS float* nst = (LAS float*)(lds + ML_N); LAS float* hbuf = (LAS float*)(lds + ML_H); LAS float* wsf = (LAS float*)(lds + ML_WSF + (wid & 3) * 256);
    LAS float* cwl = (LAS float*)(lds + ML_CW);
    if (wid >= 4) __builtin_amdgcn_s_setprio(1);
    for (int i = tid; i < 640; i += 512) { const int tap = i >> 7, ch = i & 127; const int gc = (ch < 64) ? hd * 64 + ch : 256 + hd * 64 + (ch - 64);
        cwl[i] = (tap < 4) ? P.conv_w[tap * 512 + gc] : P.conv_b[gc]; }
    for (int i = tid; i < 64 * MLP / 4; i += 512) ((LAS unsigned*)(lds + ML_CB))[i] = 0u;
    if (tid < 64) nst[tid] = 0.f;
    f32x16 Cacc;
#pragma unroll
    for (int i = 0; i < 16; ++i) Cacc[i] = 0.f;
    float m = 0.f;
    float rf = 0.f, em = 0.f, cd = 0.f;
    const int gcol = (tj < 4) ? hd * 64 + tj * 16 : 256 + hd * 64 + (tj - 4) * 16;
    __syncthreads();
    u32x4 xt[4][2], xv, xmo = {0u, 0u, 0u, 0u}, xmo_n = {0u, 0u, 0u, 0u}; float gi = 0.f, gf = 0.f;
    const f32x4 ng0 = *(const f32x4*)(P.mnorm + hd * 64 + tj * 8), ng1 = *(const f32x4*)(P.mnorm + hd * 64 + tj * 8 + 4);
#define ML_LOAD(cn) do { const int pos0n = ((cn) == 0) ? 0 : NMETA + 64 * ((cn) - 1); const int pos = pos0n + ts; \
        _Pragma("unroll") for (int tap = 0; tap < 4; ++tap) { const int pp = pos - 3 + tap; const u32x4 z4 = {0u, 0u, 0u, 0u}; xt[tap][0] = z4; xt[tap][1] = z4; \
            if (pp >= 0) { const bf16_t* src = P.mqk + (size_t)seqrow(b, pp) * 512 + gcol; xt[tap][0] = *(const u32x4*)src; xt[tap][1] = *(const u32x4*)(src + 8); } } \
        xv = *(const u32x4*)(P.mv + (size_t)seqrow(b, pos) * 256 + hd * 64 + tj * 8); xmo_n = *(const u32x4*)(P.mo + (size_t)seqrow(b, pos) * 256 + hd * 64 + tj * 8); \
        { const int rl = seqrow(b, pos0n + lane); gi = P.gates[(size_t)rl * 8 + hd]; gf = P.gates[(size_t)rl * 8 + 4 + hd]; } } while (0)
#define ML_PHASE1(cn) do { const bool vld = ((cn) > 0) || lane < NMETA; const float lf = vld ? log_sigmoid_(gf) : 0.f, li = vld ? gi : -1e30f; \
        const float bs = scan_add(lf, lane), as = li - bs, pm = scan_max(as, lane), Mt = fmaxf(m, pm); \
        const float M63 = __shfl(Mt, 63), Bt = __shfl(bs, 63); \
        const float wgv = __expf(as - M63), decv = __expf(m - Mt); \
        rf_n = __expf(fminf(M63 - Mt, 80.f)); em_n = __expf(-(bs + Mt)); cd_n = __expf(m - M63); m_n = Bt + M63; \
        const float wg_s = __shfl(wgv, ts), dec_s = __shfl(decv, ts); \
        float yv[16]; \
        _Pragma("unroll") for (int e = 0; e < 16; ++e) yv[e] = cwl[512 + tj * 16 + e]; \
        _Pragma("unroll") for (int tap = 0; tap < 4; ++tap) { const LAS float* wr_ = cwl + tap * 128 + tj * 16; \
            _Pragma("unroll") for (int hx = 0; hx < 2; ++hx) { const u32x4 xx = xt[tap][hx]; \
                yv[8 * hx + 0] += wr_[8 * hx + 0] * bflo(xx.x); yv[8 * hx + 1] += wr_[8 * hx + 1] * bfhi(xx.x); yv[8 * hx + 2] += wr_[8 * hx + 2] * bflo(xx.y); yv[8 * hx + 3] += wr_[8 * hx + 3] * bfhi(xx.y); \
                yv[8 * hx + 4] += wr_[8 * hx + 4] * bflo(xx.z); yv[8 * hx + 5] += wr_[8 * hx + 5] * bfhi(xx.z); yv[8 * hx + 6] += wr_[8 * hx + 6] * bflo(xx.w); yv[8 * hx + 7] += wr_[8 * hx + 7] * bfhi(xx.w); } } \
        _Pragma("unroll") for (int e = 0; e < 16; ++e) yv[e] = siluf_(yv[e]); \
        LAS unsigned char* In = lds + ((cn) & 1) * ML_IMGB; \
        if (tj < 4) { \
            u32x4 w0, w1; w0.x = pk2(yv[0], yv[1]); w0.y = pk2(yv[2], yv[3]); w0.z = pk2(yv[4], yv[5]); w0.w = pk2(yv[6], yv[7]); w1.x = pk2(yv[8], yv[9]); w1.y = pk2(yv[10], yv[11]); w1.z = pk2(yv[12], yv[13]); w1.w = pk2(yv[14], yv[15]); \
            *(LAS u32x4*)(In + ts * MLP + tj * 32) = w0; *(LAS u32x4*)(In + ts * MLP + tj * 32 + 16) = w1; \
            w0.x = pk2(yv[0] * dec_s, yv[1] * dec_s); w0.y = pk2(yv[2] * dec_s, yv[3] * dec_s); w0.z = pk2(yv[4] * dec_s, yv[5] * dec_s); w0.w = pk2(yv[6] * dec_s, yv[7] * dec_s); \
            w1.x = pk2(yv[8] * dec_s, yv[9] * dec_s); w1.y = pk2(yv[10] * dec_s, yv[11] * dec_s); w1.z = pk2(yv[12] * dec_s, yv[13] * dec_s); w1.w = pk2(yv[14] * dec_s, yv[15] * dec_s); \
            *(LAS u32x4*)(In + 64 * MLP + ts * MLP + tj * 32) = w0; *(LAS u32x4*)(In + 64 * MLP + ts * MLP + tj * 32 + 16) = w1; \
        } else { const float kk = 0.125f * wg_s; \
            u32x4 w0, w1; w0.x = pk2(yv[0] * kk, yv[1] * kk); w0.y = pk2(yv[2] * kk, yv[3] * kk); w0.z = pk2(yv[4] * kk, yv[5] * kk); w0.w = pk2(yv[6] * kk, yv[7] * kk); \
            w1.x = pk2(yv[8] * kk, yv[9] * kk); w1.y = pk2(yv[10] * kk, yv[11] * kk); w1.z = pk2(yv[12] * kk, yv[13] * kk); w1.w = pk2(yv[14] * kk, yv[15] * kk); \
            *(LAS u32x4*)(In + 128 * MLP + ts * MLP + (tj - 4) * 32) = w0; *(LAS u32x4*)(In + 128 * MLP + ts * MLP + (tj - 4) * 32 + 16) = w1; } \
        *(LAS u32x4*)(In + 192 * MLP + (tj >> 2) * 4096 + (ts >> 4) * 1024 + (ts & 15) * 64 + (tj & 3) * 16) = xv; } while (0)
    float rf_n, em_n, cd_n, m_n;
    ML_LOAD(0); ML_PHASE1(0);
    u32x4 xmo_c = xmo_n;
    rf = rf_n; em = em_n; cd = cd_n; const float m0n = m_n; float m_after = m0n;
    __syncthreads();
    for (int c = 0; c <= 32; ++c) {
        const bool more = c < 32;
        if (more) ML_LOAD(c + 1);
        const LAS unsigned char* I = lds + (c & 1) * ML_IMGB; const LAS unsigned char* Qi = I; const LAS unsigned char* Qdi = I + 64 * MLP; const LAS unsigned char* Kwi = I + 128 * MLP; const LAS char* Vi = (const LAS char*)(I + 192 * MLP);
        if (wid < 4) {
            const int tb = wid & 1, vb = wid >> 1, t = 32 * tb + r32;
            const LAS unsigned char* Cb = lds + ML_CB + (c & 1) * 64 * MLP; const LAS float* nb = nst + (c & 1) * 64;
            bf16x8 qf[4];
#pragma unroll
            for (int d0 = 0; d0 < 4; ++d0) qf[d0] = *(const LAS bf16x8*)(Qi + t * MLP + (2 * d0 + hh) * 16);
            f32x16 p0, p1;
#pragma unroll
            for (int i = 0; i < 16; ++i) { p0[i] = 0.f; p1[i] = 0.f; }
#pragma unroll
            for (int d0 = 0; d0 < 4; ++d0) p0 = MFMA32(*(const LAS bf16x8*)(Kwi + r32 * MLP + (2 * d0 + hh) * 16), qf[d0], p0);
            if (tb == 1) {
#pragma unroll
                for (int d0 = 0; d0 < 4; ++d0) p1 = MFMA32(*(const LAS bf16x8*)(Kwi + (32 + r32) * MLP + (2 * d0 + hh) * 16), qf[d0], p1);
            }
            const float rf_t = __shfl(rf, t), em_t = __shfl(em, t);
            float ds = 0.f;
            if (tb == 0) {
#pragma unroll
                for (int i = 0; i < 16; ++i) { p0[i] = (crow(i, hh) <= r32) ? p0[i] * rf_t : 0.f; ds += p0[i]; }
            } else {
#pragma unroll
                for (int i = 0; i < 16; ++i) { p0[i] *= rf_t; p1[i] = (crow(i, hh) <= r32) ? p1[i] * rf_t : 0.f; ds += p0[i] + p1[i]; }
            }
            float nq = 0.f;
#pragma unroll
            for (int c4 = 0; c4 < 4; ++c4) { const u32x4 qd = *(const LAS u32x4*)(Qdi + t * MLP + (hh * 4 + c4) * 16); const f32x4 n0 = *(const LAS f32x4*)(nb + 32 * hh + 8 * c4), n1 = *(const LAS f32x4*)(nb + 32 * hh + 8 * c4 + 4);
                nq += bflo(qd.x) * n0[0] + bfhi(qd.x) * n0[1] + bflo(qd.y) * n0[2] + bfhi(qd.y) * n0[3] + bflo(qd.z) * n1[0] + bfhi(qd.z) * n1[1] + bflo(qd.w) * n1[2] + bfhi(qd.w) * n1[3]; }
            const float den = swap_sum(ds + nq);
            const float nrm = 1.0f / fmaxf(fabsf(den), em_t);
            if (hh == 0) wsf[r32] = nrm;
            f32x16 O;
#pragma unroll
            for (int i = 0; i < 16; ++i) O[i] = 0.f;
            const LAS char* vp = Vi + vb * 4096 + (4 * hh + q4) * 64 + blk * 32 + p4 * 8;
#pragma unroll
            for (int ks = 0; ks < 2; ++ks) O = MFMA32(pack8(p0, ks), cat8(vtr(vp + ks * 1024), vtr(vp + ks * 1024 + 512)), O);
            if (tb == 1) {
#pragma unroll
                for (int ks = 0; ks < 2; ++ks) O = MFMA32(pack8(p1, ks), cat8(vtr(vp + (2 + ks) * 1024), vtr(vp + (2 + ks) * 1024 + 512)), O);
            }
#pragma unroll
            for (int ks = 0; ks < 4; ++ks) O = MFMA32(*(const LAS bf16x8*)(Qdi + t * MLP + (2 * ks + hh) * 16), *(const LAS bf16x8*)(Cb + (32 * vb + r32) * MLP + (2 * ks + hh) * 16), O);
            LAS float* hb = hbuf + (c & 1) * 4096;
#pragma unroll
            for (int i = 0; i < 16; ++i) hb[(32 * tb + crow(i, hh)) * 64 + 32 * vb + r32] = O[i] * wsf[crow(i, hh)];
        } else {
            const int w2 = wid - 4, vb = w2 >> 1, kb = w2 & 1;
#pragma unroll
            for (int i = 0; i < 16; ++i) Cacc[i] *= cd;
#pragma unroll
            for (int ks = 0; ks < 4; ++ks) {
                const LAS char* va = Vi + vb * 4096 + ks * 1024 + (8 * hh + q4) * 64 + blk * 32 + p4 * 8;
                const LAS char* ka = (const LAS char*)Kwi + (16 * ks + 8 * hh + q4) * MLP + (32 * kb + 16 * blk) * 2 + p4 * 8;
                Cacc = MFMA32(cat8(vtr(va), vtr(va + 256)), cat8(vtr(ka), vtr(ka + 4 * MLP)), Cacc);
            }
            LAS unsigned char* Cn = lds + ML_CB + ((c + 1) & 1) * 64 * MLP;
#pragma unroll
            for (int i = 0; i < 16; ++i) *(LAS bf16_t*)(Cn + (32 * vb + crow(i, hh)) * MLP + (32 * kb + r32) * 2) = (bf16_t)f2bf(Cacc[i]);
            if (wid == 4) { float a = cd * nst[(c & 1) * 64 + lane];
#pragma unroll 8
                for (int s = 0; s < 64; ++s) a += bf2f(*(const LAS bf16_t*)(Kwi + s * MLP + lane * 2));
                nst[((c + 1) & 1) * 64 + lane] = a; }
        }
#define ML_NORMPASS(cc) do { const int pos = ((cc) == 0) ? ts : NMETA + 64 * ((cc) - 1) + ts; const bool ok = ((cc) > 0) || (ts < NMETA && b == 0); \
            const LAS float* hp = hbuf + ((cc) & 1) * 4096 + ts * 64 + tj * 8; const f32x4 x0 = *(const LAS f32x4*)hp, x1 = *(const LAS f32x4*)(hp + 4); \
            float ss = sq4(x0) + sq4(x1); ss += __shfl_xor(ss, 1); ss += __shfl_xor(ss, 2); ss += __shfl_xor(ss, 4); \
            const float r = rsqrtf(ss * (1.0f / 64.0f) + EPS); \
            if (ok) { const int row = seqrow(b, pos); const u32x4 mo = xmo; const f32x4 g0 = ng0, g1 = ng1; u32x4 o; \
                o.x = pk2(x0[0] * r * g0[0] * sigmoidf_(bflo(mo.x)), x0[1] * r * g0[1] * sigmoidf_(bfhi(mo.x))); o.y = pk2(x0[2] * r * g0[2] * sigmoidf_(bflo(mo.y)), x0[3] * r * g0[3] * sigmoidf_(bfhi(mo.y))); \
                o.z = pk2(x1[0] * r * g1[0] * sigmoidf_(bflo(mo.z)), x1[1] * r * g1[1] * sigmoidf_(bfhi(mo.z))); o.w = pk2(x1[2] * r * g1[2] * sigmoidf_(bflo(mo.w)), x1[3] * r * g1[3] * sigmoidf_(bfhi(mo.w))); \
                cat_store(P, (size_t)row * DM + 768 + hd * 64 + tj * 8, o); } } while (0)
        if (c > 0) ML_NORMPASS(c - 1);
        if (more) { m = m_after; ML_PHASE1(c + 1); m_after = m_n; }
        __syncthreads();
        if (more) { rf = rf_n; em = em_n; cd = cd_n; }
        xmo = xmo_c; xmo_c = xmo_n;
    }
    ML_NORMPASS(32);
    __builtin_amdgcn_s_setprio(0);
    __syncthreads();
#undef ML_LOAD
#undef ML_PHASE1
#undef ML_NORMPASS
}
constexpr int R1_GR = 0, R1_E = 32768, R1_LP = R1_E + 2048, R1_G = R1_LP + 2048, R1_CNT = R1_G + 2048, R1_BASE = R1_CNT + 64, R1_END = R1_BASE + 64;
__device__ __forceinline__ void moe_route(const Ctx& X, int l) {
    const int lm = l >> 1, tid = X.tid, lane = X.lane, wid = X.wave;
    LAS float* gr = (LAS float*)(X.lds + R1_GR); LAS int* le = (LAS int*)(X.lds + R1_E); LAS int* lp = (LAS int*)(X.lds + R1_LP); LAS float* lg = (LAS float*)(X.lds + R1_G);
    LAS unsigned* lcnt = (LAS unsigned*)(X.lds + R1_CNT); LAS unsigned* lbase = (LAS unsigned*)(X.lds + R1_BASE);
    const float* grg = (const float*)(X.ws + WS_ROUTER) + (size_t)lm * DM * NEXP;
    for (int i = tid; i < DM * NEXP; i += 512) gr[i] = grg[i];
    { int* stok = (int*)(X.ws + WS_S + S_STOK); int* sslot = (int*)(X.ws + WS_S + S_SSLOT); float* sgate = (float*)(X.ws + WS_S + S_SGATE); float* srstd = (float*)(X.ws + WS_S + S_SRSTD);
      for (int i = X.bid * 512 + tid; i < MOE_RCAP; i += X.G * 512) { stok[i] = 0; sslot[i] = -1; sgate[i] = 0.f; srstd[i] = 0.f; } }
    const bf16_t* h = (const bf16_t*)(X.ws + WS_H); const u64* ssf = X.ss(4 * l + 3);
    unsigned* gcnt = (unsigned*)(X.ws + CTL_MOECNT_B) + (size_t)lm * 8 * 64;
    int* ae = (int*)(X.ws + WS_S + S_AE); int* apos = (int*)(X.ws + WS_S + S_APOS); float* agate = (float*)(X.ws + WS_S + S_AGATE);
    for (int p = X.bid; p < NPANEL; p += X.G) {
        if (tid < 8) lcnt[tid] = 0u;
        __syncthreads();
        for (int rr = 0; rr < 32; rr += 4) {
            const int r0 = wid * 32 + rr, row0 = p * 256 + r0;
            if (row0 >= MREAL) break;
            u32x4 xa[4][2];
#pragma unroll
            for (int q = 0; q < 4; ++q) { xa[q][0] = *(const u32x4*)(h + (size_t)(row0 + q) * DM + lane * 16); xa[q][1] = *(const u32x4*)(h + (size_t)(row0 + q) * DM + lane * 16 + 8); }
            float lg8[4][8];
#pragma unroll
            for (int q = 0; q < 4; ++q)
#pragma unroll
                for (int e = 0; e < 8; ++e) lg8[q][e] = 0.f;
#pragma unroll
            for (int k = 0; k < 16; ++k) { const f32x4 w0 = *(const LAS f32x4*)(gr + (lane * 16 + k) * 8), w1 = *(const LAS f32x4*)(gr + (lane * 16 + k) * 8 + 4);
#pragma unroll
                for (int q = 0; q < 4; ++q) { const unsigned wd = (k & 8) ? ((k & 6) == 0 ? xa[q][1].x : (k & 6) == 2 ? xa[q][1].y : (k & 6) == 4 ? xa[q][1].z : xa[q][1].w) : ((k & 6) == 0 ? xa[q][0].x : (k & 6) == 2 ? xa[q][0].y : (k & 6) == 4 ? xa[q][0].z : xa[q][0].w);
                    const float xv = (k & 1) ? bfhi(wd) : bflo(wd);
                    lg8[q][0] += xv * w0[0]; lg8[q][1] += xv * w0[1]; lg8[q][2] += xv * w0[2]; lg8[q][3] += xv * w0[3]; lg8[q][4] += xv * w1[0]; lg8[q][5] += xv * w1[1]; lg8[q][6] += xv * w1[2]; lg8[q][7] += xv * w1[3]; } }
#pragma unroll
            for (int o = 1; o < 64; o <<= 1)
#pragma unroll
                for (int q = 0; q < 4; ++q)
#pragma unroll
                    for (int e = 0; e < 8; ++e) lg8[q][e] += __shfl_xor(lg8[q][e], o);
#pragma unroll
            for (int q = 0; q < 4; ++q) {
                const int r = r0 + q; const float rs = rstd_of(ssf[row0 + q], 1.0f / DM);
                int i0 = 0; float v0 = lg8[q][0] * rs;
#pragma unroll
                for (int e = 1; e < 8; ++e) if (lg8[q][e] * rs > v0) { v0 = lg8[q][e] * rs; i0 = e; }
                int i1 = -1; float v1 = -3.0e38f;
#pragma unroll
                for (int e = 0; e < 8; ++e) if (e != i0 && lg8[q][e] * rs > v1) { v1 = lg8[q][e] * rs; i1 = e; }
                if (i1 < 0) { i1 = (i0 == 0) ? 1 : 0; v1 = v0; }
                if (lane == 0) { const float ex = __expf(v1 - v0), g0 = 1.0f / (1.0f + ex);
                    le[r * 2] = i0; le[r * 2 + 1] = i1; lg[r * 2] = g0; lg[r * 2 + 1] = ex * g0;
                    lp[r * 2] = (int)__hip_atomic_fetch_add(&lcnt[i0], 1u, __ATOMIC_RELAXED, __HIP_MEMORY_SCOPE_WORKGROUP); lp[r * 2 + 1] = (int)__hip_atomic_fetch_add(&lcnt[i1], 1u, __ATOMIC_RELAXED, __HIP_MEMORY_SCOPE_WORKGROUP); }
            }
        }
        __syncthreads();
        if (tid < 8) lbase[tid] = atomicAdd(gcnt + tid * 64, lcnt[tid]);
        __syncthreads();
        if (tid < 256 && p * 256 + tid < MREAL) { const int row = p * 256 + tid;
#pragma unroll
            for (int k = 0; k < 2; ++k) { const int e = le[tid * 2 + k]; ae[row * 2 + k] = e; apos[row * 2 + k] = (int)lbase[e] + lp[tid * 2 + k]; agate[row * 2 + k] = lg[tid * 2 + k]; } }
        __syncthreads();
    }
}
__device__ __forceinline__ void moe_scatter(const Ctx& X, int l) {
    const int lm = l >> 1, tid = X.tid;
    const unsigned* gcnt = (const unsigned*)(X.ws + CTL_MOECNT_B) + (size_t)lm * 8 * 64;
    int pstart[8]; int acc = 0;
#pragma unroll
    for (int e = 0; e < 8; ++e) { const int c = (int)__hip_atomic_load(gcnt + e * 64, __ATOMIC_RELAXED, __HIP_MEMORY_SCOPE_AGENT); pstart[e] = acc; acc += ((c + 255) >> 8) << 8; }
    const int nblk = acc >> 8;
    int* minfo = (int*)(X.ws + WS_S + S_MINFO);
    if (X.bid == 0) { if (tid == 0) minfo[0] = nblk;
        for (int blk = tid; blk < nblk; blk += 512) { int e = 0;
#pragma unroll
            for (int k = 1; k < 8; ++k) if (blk * 256 >= pstart[k]) e = k;
            minfo[16 + blk] = e; } }
    int* stok = (int*)(X.ws + WS_S + S_STOK); int* sslot = (int*)(X.ws + WS_S + S_SSLOT); float* sgate = (float*)(X.ws + WS_S + S_SGATE); float* srstd = (float*)(X.ws + WS_S + S_SRSTD);
    const int* ae = (const int*)(X.ws + WS_S + S_AE); const int* apos = (const int*)(X.ws + WS_S + S_APOS); const float* agate = (const float*)(X.ws + WS_S + S_AGATE);
    const u64* ssf = X.ss(4 * l + 3);
    for (int a = X.bid * 512 + tid; a < MOE_NASG; a += X.G * 512) {
        const int e = ae[a]; int ps = 0;
#pragma unroll
        for (int k = 0; k < 8; ++k) if (k == e) ps = pstart[k];
        const int dest = ps + apos[a], row = a >> 1;
        stok[dest] = row; sslot[dest] = a; sgate[dest] = agate[a]; srstd[dest] = rstd_of(ssf[row], 1.0f / DM);
    }
    if (MOE_F8(l)) {
        const bf16_t* h = (const bf16_t*)(X.ws + WS_H); unsigned char* xs8 = X.ws + WS_XS8;
        const int gw = X.bid * 8 + X.wave, NGW = X.G * 8, lane = X.lane;
        for (int t0 = gw; t0 < MREAL; t0 += 4 * NGW) {
            u32x4 x[4][2]; int d0[4], d1[4]; float rq[4];
#pragma unroll
            for (int q = 0; q < 4; ++q) { const int row = t0 + q * NGW; d0[q] = -1; d1[q] = -1; rq[q] = 0.f; const u32x4 z = {0u, 0u, 0u, 0u}; x[q][0] = z; x[q][1] = z;
                if (row < MREAL) { const int e0 = __builtin_amdgcn_readfirstlane(ae[2 * row]), e1 = __builtin_amdgcn_readfirstlane(ae[2 * row + 1]); int p0 = 0, p1 = 0;
#pragma unroll
                    for (int k = 0; k < 8; ++k) { if (k == e0) p0 = pstart[k]; if (k == e1) p1 = pstart[k]; }
                    d0[q] = p0 + __builtin_amdgcn_readfirstlane(apos[2 * row]); d1[q] = p1 + __builtin_amdgcn_readfirstlane(apos[2 * row + 1]); rq[q] = rstd_of(ssf[row], 1.0f / DM);
                    x[q][0] = __builtin_nontemporal_load((const u32x4*)(h + (size_t)row * DM + lane * 16)); x[q][1] = __builtin_nontemporal_load((const u32x4*)(h + (size_t)row * DM + lane * 16 + 8)); } }
#pragma unroll
            for (int q = 0; q < 4; ++q) if (d0[q] >= 0) { const float r = rq[q]; u32x4 w;
                w.x = pk4_fp8(bflo(x[q][0].x) * r, bfhi(x[q][0].x) * r, bflo(x[q][0].y) * r, bfhi(x[q][0].y) * r); w.y = pk4_fp8(bflo(x[q][0].z) * r, bfhi(x[q][0].z) * r, bflo(x[q][0].w) * r, bfhi(x[q][0].w) * r);
                w.z = pk4_fp8(bflo(x[q][1].x) * r, bfhi(x[q][1].x) * r, bflo(x[q][1].y) * r, bfhi(x[q][1].y) * r); w.w = pk4_fp8(bflo(x[q][1].z) * r, bfhi(x[q][1].z) * r, bflo(x[q][1].w) * r, bfhi(x[q][1].w) * r);
                *(u32x4*)(xs8 + (size_t)d0[q] * DM + lane * 16) = w; *(u32x4*)(xs8 + (size_t)d1[q] * DM + lane * 16) = w; }
        }
    }
}
struct MoeOrder {
    int blk_lo, nb, nN, G, c; const char* A; const char* W; size_t tstepA, tstepB; const int* stok; const int* bexp; bool gather; size_t estride;
    __device__ __forceinline__ bool next(int i, pg8::Unit& u) const {
        u.dup = false;
        const bool xo = (G == 256);
        const int nbs = xo ? ((nb >> 6) << 6) : 0, gq = nbs >> 6, pgn = nN >> 2, Rs = gq * pgn, x = c & 7, j = c >> 3;
        if (i < Rs) { const int q = (i >= pgn ? 1 : 0) + (i >= 2 * pgn ? 1 : 0) + (i >= 3 * pgn ? 1 : 0), pg = i - q * pgn; u.pm = blk_lo + (x + 8 * q) * 8 + (j & 7); u.pn = pg * 4 + (j >> 3); return true; }
        const int rem = nb - nbs; int L = (i - Rs) * G + c; if (L >= rem * nN) return false;
        int pn = 0; while (L >= rem) { L -= rem; ++pn; }
        u.pn = pn; u.pm = blk_lo + nbs + L; return true;
    }
    __device__ __forceinline__ const char* a_ptr(const pg8::Unit& u) const { return gather ? A : A + (size_t)(u.pm - blk_lo) * tstepA; }
    __device__ __forceinline__ const char* b_ptr(const pg8::Unit& u) const { const int e = __builtin_amdgcn_readfirstlane(bexp[u.pm]); return W + (size_t)e * estride + (size_t)u.pn * tstepB; }
    __device__ __forceinline__ int a_row(const pg8::Unit& u, int r) const { return stok[(size_t)u.pm * 256 + r]; }
    __device__ __forceinline__ const int* a_row_ptr(const pg8::Unit& u, int r) const { return stok + (size_t)u.pm * 256 + r; }
};
__device__ __forceinline__ void moe_combine(const Ctx& X, int l) {
    const bool lastl = (l == DEPTH - 1);
    bf16_t* h = (bf16_t*)(X.ws + WS_H); const bf16_t* y = X.sb(S_Y); u64* ssn = X.ss(lastl ? 16 : 4 * (l + 1)); const float* fn = inp(IN_FINAL_NORM); float* out = outp();
    const int gw = X.bid * 8 + X.wave, NGW = X.G * 8, lane = X.lane;
    for (int rowa = gw; rowa < MREAL; rowa += 2 * NGW) {
        u32x2 ha[2][4], ya[2][4], yb[2][4];
#pragma unroll
        for (int q = 0; q < 2; ++q) { const int row = rowa + q * NGW;
#pragma unroll
            for (int j = 0; j < 4; ++j) { const u32x2 z = {0u, 0u}; ha[q][j] = z; ya[q][j] = z; yb[q][j] = z;
                if (row < MREAL) { const size_t c = (size_t)j * 256 + lane * 4; ha[q][j] = *(const u32x2*)(h + (size_t)row * DM + c); ya[q][j] = __builtin_nontemporal_load((const u32x2*)(y + (size_t)(2 * row) * DM + c)); yb[q][j] = __builtin_nontemporal_load((const u32x2*)(y + (size_t)(2 * row + 1) * DM + c)); } } }
#pragma unroll
        for (int q = 0; q < 2; ++q) { const int row = rowa + q * NGW;
            if (row < MREAL) {
                float vv[16]; float s = 0.f;
#pragma unroll
                for (int j = 0; j < 4; ++j) { const u32x2 a = ha[q][j], b0 = ya[q][j], b1 = yb[q][j];
                    vv[4 * j] = bflo(a.x) + (bflo(b0.x) + bflo(b1.x)); vv[4 * j + 1] = bfhi(a.x) + (bfhi(b0.x) + bfhi(b1.x)); vv[4 * j + 2] = bflo(a.y) + (bflo(b0.y) + bflo(b1.y)); vv[4 * j + 3] = bfhi(a.y) + (bfhi(b0.y) + bfhi(b1.y)); }
                if (!lastl) {
#pragma unroll
                    for (int j = 0; j < 4; ++j) { u32x2 w; w.x = pk2(vv[4 * j], vv[4 * j + 1]); w.y = pk2(vv[4 * j + 2], vv[4 * j + 3]); *(u32x2*)(h + (size_t)row * DM + j * 256 + lane * 4) = w;
                        if (H8_IN(l + 1)) *(unsigned*)(X.ws + WS_H8 + (size_t)row * DM + j * 256 + lane * 4) = pk4_fp8(bflo(w.x), bfhi(w.x), bflo(w.y), bfhi(w.y));
                        s += (bflo(w.x) * bflo(w.x) + bfhi(w.x) * bfhi(w.x)) + (bflo(w.y) * bflo(w.y) + bfhi(w.y) * bfhi(w.y)); }
                    s = wave_sum(s); if (lane == 0) ssn[row] = ss_fix(s);
                } else {
#pragma unroll
                    for (int k = 0; k < 16; ++k) s += vv[k] * vv[k];
                    s = wave_sum(s); float r = rsqrtf(s * (1.0f / DM) + EPS);
#ifdef PROBE_A
                    { const unsigned long long* st = (const unsigned long long*)(X.ws + 49152); const float cq = floorf((float)(st[PROBE_B] - st[PROBE_A]) * (0.01f / PROBE_Q) + 0.5f);
#pragma unroll
                      for (int k = 0; k < 16; ++k) vv[k] = cq; r = 1.0f; }
#endif
                    if (row < MMAIN) {
#pragma unroll
                        for (int j = 0; j < 4; ++j) { f32x4 g = *(const f32x4*)(fn + j * 256 + lane * 4);
#ifdef PROBE_A
                            g = (f32x4){1.f, 1.f, 1.f, 1.f};
#endif
                            f32x4 o = {vv[4 * j] * r * g[0], vv[4 * j + 1] * r * g[1], vv[4 * j + 2] * r * g[2], vv[4 * j + 3] * r * g[3]};
                            __builtin_nontemporal_store(o, (f32x4*)(out + (size_t)row * DM + j * 256 + lane * 4)); } }
                }
            } }
    }
}
#ifndef SKIP
#define SKIP 0
#endif
#define PH_ON(bit) (!((SKIP >> (bit)) & 1))
#ifndef DUP
#define DUP 0
#endif
#define NREP(bit) ((((DUP) >> (bit)) & 1) ? 2 : 1)
#ifndef GU8_ALIGN
#define GU8_ALIGN true
#endif
#ifndef GU_ALIGN
#define GU_ALIGN true
#endif
#ifndef ONE_LAUNCH
#define ONE_LAUNCH 1
#endif
constexpr int PH_PER_LAYER = 15, N_PHASES = 1 + DEPTH * PH_PER_LAYER;
constexpr int ATT_UNITS = NBATCH * NHEAD * 8 + NHEAD;

__device__ __forceinline__ bool stamp_fn(unsigned char* ws, int bid, int wave, int k) {
#ifdef PROBE_A
    if (bid == 0 && wave == 0 && lane_id() == 0) ((unsigned long long*)(ws + 49152))[k] = __builtin_amdgcn_s_memrealtime();
#endif
    return true;
}
__global__ void __launch_bounds__(512, 2) fwd(Args args) {
    extern __shared__ __attribute__((aligned(16))) unsigned char lds_raw[];
    Ctx X0; X0.lds = (LAS unsigned char*)lds_raw; X0.ws = wsp(); X0.wave = __builtin_amdgcn_readfirstlane((int)threadIdx.x >> 6); X0.lane = lane_id(); X0.tid = X0.wave * 64 + X0.lane; X0.G = gridDim.x; X0.bid = blockIdx.x;
    volatile LAS unsigned* MISC = (volatile LAS unsigned*)(X0.lds + LDS_MISC);
    for (int u = X0.tid; u < (LDS_BYTES - LDS_MISC) / 4; u += 512) MISC[u] = 0u;
    __syncthreads();
    const int lo = argi(0), hi = argi(1);
    const bool use_bar = (hi - lo) > 1;
    XcdBarrier bar; bar.bar = (unsigned*)(X0.ws + WS_CTL) + CTL_BAR_W; bar.x = 0; bar.st = MISC + 8;
    if (use_bar) bar = xcd_barrier_post((unsigned*)(X0.ws + WS_CTL) + CTL_BAR_W, MISC + 8, X0.wave == 0 && lane_id() == 0);
#define IN(k) ((lo <= (k) && (k) < hi) && stamp_fn(X0.ws, X0.bid, X0.wave, (k)))
#ifdef PROBE_BAR2
#define SEAM(k) do { if ((k) + 1 < hi) { xcd_barrier(bar, X0.wave == 0 && lane_id() == 0); xcd_barrier(bar, X0.wave == 0 && lane_id() == 0); } } while (0)
#else
#define SEAM(k) do { if ((k) + 1 < hi) xcd_barrier(bar, X0.wave == 0 && lane_id() == 0); } while (0)
#endif
    LAS unsigned char* ring = X0.lds;
#define PHASE_CTX const Ctx X = fresh(X0); bf16_t* H = (bf16_t*)(X.ws + WS_H); const float* rope = (const float*)(X.ws + WS_ROPE); (void)H; (void)rope;

    if (PH_ON(0) && IN(0)) { PHASE_CTX for (int rep = 0; rep < NREP(0); ++rep) { prologue(X); if (rep + 1 < NREP(0)) xcd_barrier(bar, X0.wave == 0 && lane_id() == 0); } SEAM(0); }

#pragma unroll 1
    for (int l = 0; l < DEPTH; ++l) {
        const int pb = 1 + l * PH_PER_LAYER;
        if (PH_ON(1) && IN(pb)) {
            PHASE_CTX unsigned char* wmix = X.ws + WS_WMIX + (size_t)l * SZ_WMIX; (void)wmix;
            if (PH_ON(0) && l == 2) { moe_convert(X, 1); __syncthreads(); }
            if (WIN_F8(l)) {
            pg8::StaticOrder S; S.init((const bf16_t*)(X.ws + WS_H8), (const bf16_t*)wmix, DM / 2, NPANEL - 1, DINP / 256, X.G, X.bid);
            EpiWin E{X.ws, l, 1.0f / W8_SCALE, QKV_F8(l), 0};
            pg8::thin_gemm8<EpiWin>(ring, X.tid, X.ws + WS_H8, wmix, DM, DINP / 256, X.bid, E);
            pg8::gemm_phase8<EpiWin, pg8::StaticOrder, false>(ring, X0.wave * 64 + lane_id(), DM, S, E);
            } else if (WINP_F8(l)) {
            { pg8::StaticOrder S; S.init((const bf16_t*)(X.ws + WS_H8), (const bf16_t*)wmix, DM / 2, NPANEL - 1, 4, X.G, X.bid);
              EpiWin E{X.ws, l, 1.0f / W8_SCALE, QKV_F8(l), 0};
              pg8::thin_gemm8<EpiWin>(ring, X.tid, X.ws + WS_H8, wmix, DM, 4, X.bid, E);
              pg8::gemm_phase8<EpiWin, pg8::StaticOrder, false>(ring, X0.wave * 64 + lane_id(), DM, S, E); }
            { const bf16_t* wb4 = (const bf16_t*)(wmix + (size_t)4 * 256 * DM * 2);
              pg8::StaticOrder S; S.init(H, wb4, DM, NPANEL - 1, DINP / 256 - 4, X.G, X.bid);
              EpiWin E{X.ws, l, 1.0f, QKV_F8(l), 4};
              pg8::thin_gemm<EpiWin>(ring, X.tid, H, wb4, DM, DINP / 256 - 4, X.bid, E);
              pg8::gemm_phase<EpiWin, pg8::StaticOrder, false>(ring, X0.wave * 64 + lane_id(), DM, S, E); }
            } else {
            pg8::StaticOrder S; S.init(H, (const bf16_t*)wmix, DM, NPANEL - 1, DINP / 256, X.G, X.bid, NREP(1));
            EpiWin E{X.ws, l, 1.0f, QKV_F8(l), 0};
            pg8::thin_gemm<EpiWin>(ring, X.tid, H, (const bf16_t*)wmix, DM, DINP / 256, X.bid, E);
            pg8::gemm_phase<EpiWin, pg8::StaticOrder, false>(ring, X.tid, DM, S, E);
            }
            SEAM(pb);
        }
        if (PH_ON(2) && IN(pb + 1)) {
            PHASE_CTX unsigned char* wmix = X.ws + WS_WMIX + (size_t)l * SZ_WMIX; (void)wmix;
            for (int rep = 0; rep < NREP(2); ++rep) {
            if (QKV_F8(l)) {
            if (PH_ON(15)) { pg8::StaticOrder S; S.init(X.sb(S_CQ), (const bf16_t*)(wmix + SZ_WIN), QLORA / 2, NPANEL - 1, 3, X.G, X.bid);
              EpiQ E{X.ws, l, 1.0f / W8_SCALE};
              pg8::thin_gemm8<EpiQ>(ring, X.tid, (const unsigned char*)X.sb(S_CQ), wmix + SZ_WIN, QLORA, 3, X.bid, E);
              pg8::gemm_phase8<EpiQ, pg8::StaticOrder, false>(ring, X0.wave * 64 + lane_id(), QLORA, S, E); }
            if (PH_ON(16)) { pg8::StaticOrder S; S.init(X.sb(S_CKV), (const bf16_t*)(wmix + SZ_WIN + SZ_WQ), KVLORA / 2, NPANEL - 1, 4, X.G, X.bid);
              EpiKV E{X.ws, l, 1.0f / W8_SCALE};
              pg8::thin_gemm8<EpiKV>(ring, X.tid, (const unsigned char*)X.sb(S_CKV), wmix + SZ_WIN + SZ_WQ, KVLORA, 4, X.bid, E);
              pg8::gemm_phase8<EpiKV, pg8::StaticOrder, false>(ring, X0.wave * 64 + lane_id(), KVLORA, S, E); }
            } else {
            if (PH_ON(15)) { pg8::StaticOrder S; S.init(X.sb(S_CQ), (const bf16_t*)(wmix + SZ_WIN), QLORA, NPANEL - 1, 3, X.G, X.bid, NREP(18));
              EpiQ E{X.ws, l, 1.0f};
              pg8::thin_gemm<EpiQ>(ring, X.tid, X.sb(S_CQ), (const bf16_t*)(wmix + SZ_WIN), QLORA, 3, X.bid, E);
              pg8::gemm_phase<EpiQ, pg8::StaticOrder, false>(ring, X.tid, QLORA, S, E); }
            if (PH_ON(16)) { pg8::StaticOrder S; S.init(X.sb(S_CKV), (const bf16_t*)(wmix + SZ_WIN + SZ_WQ), KVLORA, NPANEL - 1, 4, X.G, X.bid, NREP(18));
              EpiKV E{X.ws, l, 1.0f};
              pg8::thin_gemm<EpiKV>(ring, X.tid, X.sb(S_CKV), (const bf16_t*)(wmix + SZ_WIN + SZ_WQ), KVLORA, 4, X.bid, E);
              pg8::gemm_phase<EpiKV, pg8::StaticOrder, false>(ring, X.tid, KVLORA, S, E); }
            }
            if (rep + 1 < NREP(2)) xcd_barrier(bar, X0.wave == 0 && lane_id() == 0); }
            SEAM(pb + 1);
        }
        if (PH_ON(3) && IN(pb + 2)) {
            PHASE_CTX unsigned char* wmix = X.ws + WS_WMIX + (size_t)l * SZ_WMIX; (void)wmix;
            MixP P{X.sb(S_Q), X.sb(S_KN), X.sb(S_V), X.sb(S_KR), X.sb(S_XP), X.sb(S_MQK), X.sb(S_MV), X.sb(S_MO), (const float*)(X.ws + WS_S + S_GATES), X.sb(S_CAT),
                   inp(IN_CONV_W) + (size_t)l * 4 * 512, inp(IN_CONV_B) + l * 512, inp(IN_MLSTM_NORM) + l * 256, WOUT_F8(l)};
            for (int rep = 0; rep < NREP(3); ++rep) {
            if (PH_ON(12)) for (int it = X.bid; it < NBATCH * 32 + 1; it += X.G) { if (it < NBATCH * 32) pool_unit(P, X0.wave * 64 + lane_id(), it >> 5, (it & 31) + 1); else pool_unit(P, X0.wave * 64 + lane_id(), 0, 0); }
            if (PH_ON(13)) for (int u = X.bid; u < NBATCH * MH * NREP(13); u += X.G) mlstm_unit(ring, P, X0.wave * 64 + lane_id(), (u & 127) >> 2, u & 3);
            for (int rep3 = 0; rep3 < NREP(14); ++rep3) {
            unsigned* qhead = (unsigned*)(X.ws + CTL_QUEUE_B) + l * 64 + rep * 16 + rep3 * 32;
            if (PH_ON(14)) {
                unsigned nxt = 0u; const bool qleader = (X0.wave == 0 && lane_id() == 0);
                __syncthreads();
                if (qleader) MISC[16] = atomicAdd(qhead, 1u);
                __syncthreads();
                for (int it = 0;; ++it) {
                    const int idx = (int)MISC[16 + (it & 1)];
                    if (idx >= ATT_UNITS) break;
                    if (qleader) nxt = atomicAdd(qhead, 1u);
                    if (idx < NBATCH * NHEAD * 8) { const int qt = 7 - (idx >> 8), bh = idx & 255; attn_unit(ring, P, X.ws, X0.wave * 64 + lane_id(), bh >> 3, bh & 7, qt); }
                    else attn_unit(ring, P, X.ws, X0.wave * 64 + lane_id(), 0, idx - NBATCH * NHEAD * 8, -1);
                    if (qleader) MISC[16 + ((it + 1) & 1)] = nxt;
                    __syncthreads();
                }
            }
            }
            if (rep + 1 < NREP(3)) xcd_barrier(bar, X0.wave == 0 && lane_id() == 0); }
            SEAM(pb + 2);
        }
        if (PH_ON(4) && IN(pb + 3)) {
            PHASE_CTX unsigned char* wmix = X.ws + WS_WMIX + (size_t)l * SZ_WMIX; (void)wmix;
            if (WOUT_F8(l)) {
            pg8::StaticOrder S; S.init(X.sb(S_CAT), (const bf16_t*)(wmix + SZ_WIN + SZ_WQ + SZ_WKV), DM / 2, NPANEL - 1, 4, X.G, X.bid);
            EpiRes E{X.ws, 4 * l + 3, 1.0f / W8_SCALE, DENSE_F8(l) && (l & 1) == 0};
            pg8::thin_gemm8<EpiRes>(ring, X.tid, (const unsigned char*)X.sb(S_CAT), wmix + SZ_WIN + SZ_WQ + SZ_WKV, DM, 4, X.bid, E);
            pg8::gemm_phase8<EpiRes, pg8::StaticOrder, false>(ring, X0.wave * 64 + lane_id(), DM, S, E);
            } else {
            pg8::StaticOrder S; S.init(X.sb(S_CAT), (const bf16_t*)(wmix + SZ_WIN + SZ_WQ + SZ_WKV), DM, NPANEL - 1, 4, X.G, X.bid, NREP(4));
            EpiRes E{X.ws, 4 * l + 3, 1.0f, DENSE_F8(l) && (l & 1) == 0};
            pg8::thin_gemm<EpiRes>(ring, X.tid, X.sb(S_CAT), (const bf16_t*)(wmix + SZ_WIN + SZ_WQ + SZ_WKV), DM, 4, X.bid, E);
            pg8::gemm_phase<EpiRes, pg8::StaticOrder, false>(ring, X.tid, DM, S, E);
            }
            SEAM(pb + 3);
        }
        if ((l & 1) == 0) {
            if (PH_ON(5) && IN(pb + 4)) {
                PHASE_CTX unsigned char* wd = X.ws + WS_WDENSE + (size_t)(l >> 1) * SZ_DENSE;
if (DENSE_F8(l)) {
                pg8::StaticOrder S; S.init((const bf16_t*)(X.ws + WS_H8), (const bf16_t*)wd, DM / 2, NPANEL - 1, 2 * DFF / 256, X.G, X.bid);
                EpiGU8 E{X.ws, 4 * l + 3};
                pg8::thin_gemm8<EpiGU8>(ring, X.tid, X.ws + WS_H8, wd, DM, 2 * DFF / 256, X.bid, E);
                pg8::gemm_phase8<EpiGU8, pg8::StaticOrder, false, GU8_ALIGN>(ring, X0.wave * 64 + lane_id(), DM, S, E);
                } else {
                pg8::StaticOrder S; S.init(H, (const bf16_t*)wd, DM, NPANEL - 1, 2 * DFF / 256, X.G, X.bid, NREP(17));
                EpiGU E{X.ws, 4 * l + 3};
                pg8::thin_gemm<EpiGU>(ring, X.tid, H, (const bf16_t*)wd, DM, 2 * DFF / 256, X.bid, E);
                for (int rep = 0; rep < NREP(5); ++rep) { pg8::gemm_phase<EpiGU, pg8::StaticOrder, false, GU_ALIGN>(ring, X.tid, DM, S, E); if (rep + 1 < NREP(5)) xcd_barrier(bar, X0.wave == 0 && lane_id() == 0); }
                }
                SEAM(pb + 4);
            }
            if (PH_ON(6) && IN(pb + 5)) {
                PHASE_CTX unsigned char* wd = X.ws + WS_WDENSE + (size_t)(l >> 1) * SZ_DENSE;
if (DENSE_F8(l)) {
                pg8::StaticOrder S; S.init(X.sb(S_ACT), (const bf16_t*)(wd + SZ_DGU8), DFF / 2, NPANEL - 1, 4, X.G, X.bid);
                EpiRes E{X.ws, 4 * (l + 1), 1.0f / (W8_SCALE * ACT8_SCALE), H8_IN(l + 1)};
                pg8::thin_gemm8<EpiRes>(ring, X.tid, (const unsigned char*)X.sb(S_ACT), wd + SZ_DGU8, DFF, 4, X.bid, E);
                pg8::gemm_phase8<EpiRes, pg8::StaticOrder, false>(ring, X0.wave * 64 + lane_id(), DFF, S, E);
                } else {
                pg8::StaticOrder S; S.init(X.sb(S_ACT), (const bf16_t*)(wd + SZ_DGU), DFF, NPANEL - 1, 4, X.G, X.bid, NREP(6));
                EpiRes E{X.ws, 4 * (l + 1), 1.0f, H8_IN(l + 1)};
                pg8::thin_gemm<EpiRes>(ring, X.tid, X.sb(S_ACT), (const bf16_t*)(wd + SZ_DGU), DFF, 4, X.bid, E);
                pg8::gemm_phase<EpiRes, pg8::StaticOrder, false>(ring, X.tid, DFF, S, E);
                }
                SEAM(pb + 5);
            }
        } else {
            if (PH_ON(7) && IN(pb + 4)) { PHASE_CTX moe_route(X, l); SEAM(pb + 4); }
            if (PH_ON(8) && IN(pb + 5)) { PHASE_CTX moe_scatter(X, l); SEAM(pb + 5); }
#pragma unroll 1
            for (int ci = 0; ci < MOE_NCHUNK; ++ci) {
                if (IN(pb + 6 + 2 * ci) || IN(pb + 7 + 2 * ci)) {
                    PHASE_CTX const int* minfo = (const int*)(X.ws + WS_S + S_MINFO);
                    const int nblk = __builtin_amdgcn_readfirstlane(minfo[0]);
                    const int blk_lo = MOE_CHUNK * ci; int blk_hi = (ci == MOE_NCHUNK - 1) ? nblk : (nblk < MOE_CHUNK * (ci + 1) ? nblk : MOE_CHUNK * (ci + 1));
                    if (blk_hi > blk_lo + MOE_CHUNK_CAP) blk_hi = blk_lo + MOE_CHUNK_CAP;
                    const int nb = blk_hi > blk_lo ? blk_hi - blk_lo : 0;
                    if (PH_ON(9) && IN(pb + 6 + 2 * ci)) {
                        if (MOE_F8(l)) {
                            MoeOrder S{blk_lo, nb, 2 * DFFE / 256, X.G, X.bid, (const char*)(X.ws + WS_XS8) + (size_t)blk_lo * 256 * DM, (const char*)(X.ws + WS_WMOE), (size_t)256 * DM, (size_t)256 * DM, (const int*)(X.ws + WS_S + S_STOK), minfo + 16, false, SZ_EXP8};
                            EpiMoeGU8 E{X.ws, blk_lo};
                            pg8::gemm_phase8<EpiMoeGU8, MoeOrder, false, GU8_ALIGN>(ring, X0.wave * 64 + lane_id(), DM, S, E);
                        } else {
#if FP8_MOE_MASK != 0xA
                        MoeOrder S{blk_lo, nb, 2 * DFFE / 256, X.G, X.bid, (const char*)H, (const char*)(X.ws + WS_WMOE), 0, (size_t)256 * DM * 2, (const int*)(X.ws + WS_S + S_STOK), minfo + 16, true, SZ_EXP};
                        EpiMoeGU E{X.ws, blk_lo};
                        for (int rep = 0; rep < NREP(9); ++rep) { pg8::gemm_phase<EpiMoeGU, MoeOrder, true, GU_ALIGN>(ring, X0.wave * 64 + lane_id(), DM, S, E); if (rep + 1 < NREP(9)) xcd_barrier(bar, X0.wave == 0 && lane_id() == 0); }
#endif
                        }
                        SEAM(pb + 6 + 2 * ci);
                    }
                    if (PH_ON(10) && IN(pb + 7 + 2 * ci)) {
                        if (MOE_F8(l)) {
                            MoeOrder S{blk_lo, nb, 4, X.G, X.bid, (const char*)X.sb(S_ACTE), (const char*)(X.ws + WS_WMOE + SZ_EGU8), (size_t)256 * DFFE, (size_t)256 * DFFE, (const int*)(X.ws + WS_S + S_STOK), minfo + 16, false, SZ_EXP8};
                            EpiMoeDown8 E{X.ws};
                            pg8::gemm_phase8<EpiMoeDown8, MoeOrder, false>(ring, X0.wave * 64 + lane_id(), DFFE, S, E);
                        } else {
#if FP8_MOE_MASK != 0xA
                        MoeOrder S{blk_lo, nb, 4, X.G, X.bid, (const char*)X.sb(S_ACTE), (const char*)(X.ws + WS_WMOE + SZ_EGU), (size_t)256 * DFFE * 2, (size_t)256 * DFFE * 2, (const int*)(X.ws + WS_S + S_STOK), minfo + 16, false, SZ_EXP};
                        EpiMoeDown E{X.ws};
                        for (int rep = 0; rep < NREP(10); ++rep) { pg8::gemm_phase<EpiMoeDown, MoeOrder, false>(ring, X0.wave * 64 + lane_id(), DFFE, S, E); if (rep + 1 < NREP(10)) xcd_barrier(bar, X0.wave == 0 && lane_id() == 0); }
#endif
                        }
                        SEAM(pb + 7 + 2 * ci);
                    }
                }
            }
            if (PH_ON(11) && IN(pb + 14)) { PHASE_CTX moe_combine(X, l); SEAM(pb + 14); }
        }
    }
#undef IN
#undef SEAM
}

extern "C" void kernel_launch(void* const* d_in, const int* in_sizes, int n_in, void* d_out, int out_size, void* d_ws, size_t ws_size, hipStream_t stream) {
    static int grid = 0;
    if (grid == 0) {
        if (n_in != N_IN || in_sizes[0] != MMAIN * DM || out_size != MMAIN * DM || ws_size < WS_END8) {
            fprintf(stderr, "kernel_launch: unexpected shapes (n_in %d, in0 %d, out %d, ws %zu < %zu); nothing launched\n", n_in, n_in > 0 ? in_sizes[0] : -1, out_size, ws_size, (size_t)WS_END); grid = -1; return; }
        int dev = 0, cus = 0, per_cu = 0;
        if (hipGetDevice(&dev) != hipSuccess || hipDeviceGetAttribute(&cus, hipDeviceAttributeMultiprocessorCount, dev) != hipSuccess) { grid = -1; return; }
        if (hipFuncSetAttribute((const void*)fwd, hipFuncAttributeMaxDynamicSharedMemorySize, LDS_BYTES) != hipSuccess) { fprintf(stderr, "kernel_launch: hipFuncSetAttribute failed\n"); grid = -1; return; }
        if (hipOccupancyMaxActiveBlocksPerMultiprocessor(&per_cu, (const void*)fwd, 512, LDS_BYTES) != hipSuccess || per_cu < 1) { fprintf(stderr, "kernel_launch: occupancy query says %d\n", per_cu); }
        (void)hipGetLastError();
        grid = cus;
    }
    if (grid < 0) return;
    (void)hipMemsetAsync((char*)d_ws + WS_CTL, 0, CTL_BYTES, stream);
    Args a{};
    for (int i = 0; i < N_IN; ++i) a.in[i] = (const float*)d_in[i];
    a.out = (float*)d_out; a.ws = (unsigned char*)d_ws;
#if ONE_LAUNCH
    a.ph_lo = 0; a.ph_hi = N_PHASES;
    hipLaunchKernelGGL(fwd, dim3(grid), dim3(512), LDS_BYTES, stream, a);
#else
    for (int ph = 0; ph < N_PHASES; ++ph) {
        if (ph > 0) { const int l = (ph - 1) / PH_PER_LAYER, r = (ph - 1) % PH_PER_LAYER; if ((l & 1) == 0 && r > 5) continue; }
        a.ph_lo = ph; a.ph_hi = ph + 1;
        hipLaunchKernelGGL(fwd, dim3(grid), dim3(512), LDS_BYTES, stream, a);
    }
#endif
    const hipError_t le = hipPeekAtLastError();
    if (le != hipSuccess) fprintf(stderr, "kernel_launch: launch failed: %s\n", hipGetErrorName(le));
}
```

```cpp
#include <hip/hip_runtime.h>
#include <cstdio>
#include <cstdint>

#define LAS __attribute__((address_space(3)))
#define GAS __attribute__((address_space(1)))
typedef unsigned short bf16_t;
typedef short bf16x8 __attribute__((ext_vector_type(8)));
typedef short s16x4 __attribute__((ext_vector_type(4)));
typedef float f32x4 __attribute__((ext_vector_type(4)));
typedef float f32x2 __attribute__((ext_vector_type(2)));
typedef float f32x16 __attribute__((ext_vector_type(16)));
typedef unsigned u32x4 __attribute__((ext_vector_type(4)));
typedef unsigned u32x2 __attribute__((ext_vector_type(2)));
typedef unsigned long long u64;
typedef int v8i __attribute__((ext_vector_type(8)));

constexpr int NBATCH = 32, SEQ = 2048, DM = 1024, DEPTH = 4, NMETA = 16, LTOT = SEQ + NMETA;
constexpr int MMAIN = NBATCH * SEQ;
constexpr int MREAL = MMAIN + NMETA;
constexpr int NPANEL = 257, MPAD = NPANEL * 256;
constexpr int QLORA = 768, KVLORA = 256, NHEAD = 8, QKN = 64, QKR = 32, VH = 64;
constexpr int DIN = 2344, DINP = 2560;
constexpr int DFF = 2816, DFFE = 3584, NEXP = 8;
constexpr int MH = 4, MHD = 64;
constexpr float EPS = 1e-6f;
constexpr float QSCALE = 0.10206207261596577f * 1.4426950408889634f;
constexpr float SSFIX = 1048576.0f;

__device__ __forceinline__ unsigned f2bf(float f) { unsigned u = __builtin_bit_cast(unsigned, f); return (u + 0x7fffu + ((u >> 16) & 1u)) >> 16; }
__device__ __forceinline__ unsigned pk2(float lo, float hi) { f32x2 v = {lo, hi}; typedef __bf16 bf2 __attribute__((ext_vector_type(2))); bf2 b = __builtin_convertvector(v, bf2); return __builtin_bit_cast(unsigned, b); }
__device__ __forceinline__ float bf2f(unsigned short h) { return __builtin_bit_cast(float, (unsigned)h << 16); }
__device__ __forceinline__ float bflo(unsigned w) { return __builtin_bit_cast(float, w << 16); }
__device__ __forceinline__ float bfhi(unsigned w) { return __builtin_bit_cast(float, w & 0xffff0000u); }
__device__ __forceinline__ float fexp2(float x) { return __builtin_amdgcn_exp2f(x); }
__device__ __forceinline__ float fexp(float x) { return __builtin_amdgcn_exp2f(x * 1.4426950408889634f); }
__device__ __forceinline__ float frcp(float x) { return __builtin_amdgcn_rcpf(x); }
__device__ __forceinline__ float sigmoidf_(float x) { return frcp(1.0f + fexp(-x)); }
__device__ __forceinline__ float siluf_(float x) { return x * sigmoidf_(x); }
__device__ __forceinline__ float rstd_of(u64 ss, float inv_n) { return rsqrtf((float)ss * (1.0f / SSFIX) * inv_n + EPS); }
__device__ __forceinline__ u64 ss_fix(float s) { return (u64)(s * SSFIX + 0.5f); }
__device__ __forceinline__ int lane_id() { int l; asm volatile("v_mbcnt_lo_u32_b32 %0, -1, 0\n\tv_mbcnt_hi_u32_b32 %0, -1, %0" : "=v"(l)); return l; }
__device__ __forceinline__ int seqrow(int b, int pos) { return pos < NMETA ? MMAIN + pos : b * SEQ + (pos - NMETA); }
__device__ __forceinline__ int rowpos(int row) { return row < MMAIN ? NMETA + (row & (SEQ - 1)) : row - MMAIN; }

#define XB_TMO      128
#define XB_XCNT(j)  (256  + 64 * (j))
#define XB_XSUB(j)  (1280 + 64 * (j))
#define XB_XGEN(j)  (2304 + 64 * (j))
#define XB_TOP      3328
#define XB_TOPGEN   3392
#define XCD_BAR_WORDS 3456
#define XB_SPIN_CAP (1u << 22)

__device__ __forceinline__ unsigned xb_ld(unsigned* p)              { return __hip_atomic_load(p, __ATOMIC_RELAXED, __HIP_MEMORY_SCOPE_AGENT); }
__device__ __forceinline__ unsigned xb_add(unsigned* p, unsigned v) { return __hip_atomic_fetch_add(p, v, __ATOMIC_RELAXED, __HIP_MEMORY_SCOPE_AGENT); }
__device__ __forceinline__ unsigned xb_xcc_id() { return (unsigned)__builtin_amdgcn_s_getreg((3 << 11) | 20) & 0xFu; }
#define XB_SPIN(cond, bar) do { unsigned _sp = 0; while (cond) { __builtin_amdgcn_s_sleep(1); \
    if ((++_sp & 255u) == 0u) { if (xb_ld(&(bar)[XB_TMO])) break; if (_sp > XB_SPIN_CAP) { atomicAdd(&(bar)[XB_TMO], 1u); break; } } } } while (0)

struct XcdBarrier { unsigned* bar; unsigned x; volatile LAS unsigned* st; };

__device__ __forceinline__ XcdBarrier xcd_barrier_post(unsigned* bar, volatile LAS unsigned* st, bool leader) {
    XcdBarrier b; b.bar = bar; b.x = xb_xcc_id(); b.st = st;
    if (leader) (void)xb_add(&bar[XB_XCNT(b.x)], 1u);
    return b;
}
__device__ __forceinline__ void xcd_barrier_complete(unsigned* bar, unsigned x, unsigned& nloc, unsigned& nx) {
    const unsigned G = gridDim.x * gridDim.y * gridDim.z;
    unsigned sum, cnt, mine, sp = 0u;
    for (;;) {
        sum = 0u; cnt = 0u; mine = 0u;
#pragma unroll
        for (unsigned j = 0; j < 16; ++j) { const unsigned c = xb_ld(&bar[XB_XCNT(j)]); sum += c; cnt += (c > 0u) ? 1u : 0u; mine = (j == x) ? c : mine; }
        if (sum == G) break;
        __builtin_amdgcn_s_sleep(1);
        if ((++sp & 255u) == 0u) { if (xb_ld(&bar[XB_TMO])) break; if (sp > XB_SPIN_CAP) { atomicAdd(&bar[XB_TMO], 1u); break; } }
    }
    nloc = mine > 0u ? mine : 1u; nx = cnt > 0u ? cnt : 1u;
}
__device__ __forceinline__ void xcd_barrier(const XcdBarrier& b, bool leader) {
    asm volatile("s_waitcnt vmcnt(0)" ::: "memory");
    __syncthreads();
    if (leader) {
        unsigned* bar = b.bar;
        __builtin_amdgcn_s_waitcnt(0);
        unsigned nloc = b.st[0], nx = b.st[1];
        if (nloc == 0u) { xcd_barrier_complete(bar, b.x, nloc, nx); b.st[0] = nloc; b.st[1] = nx; }
        const unsigned old = xb_add(&bar[XB_XSUB(b.x)], 1u);
        const unsigned gen = old / nloc;
        if (old + 1u == (gen + 1u) * nloc) {
            __builtin_amdgcn_fence(__ATOMIC_RELEASE, "agent");
            asm volatile("s_waitcnt vmcnt(0)" ::: "memory");
            const unsigned og = xb_add(&bar[XB_TOP], 1u);
            const unsigned tg = og / nx;
            if (og + 1u == (tg + 1u) * nx) xb_add(&bar[XB_TOPGEN], 1u);
            else XB_SPIN(xb_ld(&bar[XB_TOPGEN]) == tg, bar);
            __builtin_amdgcn_fence(__ATOMIC_ACQUIRE, "agent");
            xb_add(&bar[XB_XGEN(b.x)], 1u);
            asm volatile("s_waitcnt vmcnt(0)" ::: "memory");
        } else {
            XB_SPIN(xb_ld(&bar[XB_XGEN(b.x)]) == gen, bar);
            __builtin_amdgcn_fence(__ATOMIC_ACQUIRE, "agent");
            asm volatile("s_waitcnt vmcnt(0)" ::: "memory");
        }
    }
    __syncthreads();
}

__device__ __forceinline__ const char* uni_ptr(const char* p) { const unsigned long long v = (unsigned long long)p; const unsigned lo = __builtin_amdgcn_readfirstlane((unsigned)v), hi = __builtin_amdgcn_readfirstlane((unsigned)(v >> 32)); return (const char*)(((unsigned long long)hi << 32) | lo); }
__device__ __forceinline__ void glds16_s(const char* sbase, unsigned voff, unsigned lds_dst) {
    unsigned keep;
    asm volatile("s_mov_b32 %0, m0\n\ts_mov_b32 m0, %1\n\ts_nop 0\n\tglobal_load_lds_dwordx4 %2, %3\n\ts_mov_b32 m0, %0" : "=&s"(keep) : "s"(lds_dst), "v"(voff), "s"(sbase) : "memory");
}
namespace pg8 {
constexpr int BM = 256, BK = 64, HALF = 128, HTB = HALF * BK * 2, STAGE_BYTES = 8 * HTB, NXCD = 8, WGM = 8;
__host__ __device__ __forceinline__ int lds_byte(int r, int c) { const int st = (r >> 4) * 2 + (c >> 5), rr = r & 15, cc = c & 31, ob = rr * 64 + cc * 2; return st * 1024 + (ob ^ (((ob >> 9) & 1) << 5)); }
__host__ __device__ __forceinline__ void stage_rc(int b, int& R, int& C) { const int st = b / 1024, sb = b % 1024, swz = sb ^ (((sb >> 9) & 1) << 5); R = (st >> 1) * 16 + swz / 64; C = (st & 1) * 32 + (swz % 64) / 2; }
__host__ __device__ __forceinline__ int perm32(int rho) { const int n = rho >> 4, i = rho & 15; return 8 * (i >> 2) + 4 * n + (i & 3); }

struct Unit { int pm, pn; bool dup; };

struct StaticOrder {
    int nM, nN, nwg, G, c, rep; const char* A; const char* B; size_t tstep;
    __device__ __forceinline__ void init(const bf16_t* A_, const bf16_t* B_, int K, int nM_, int nN_, int G_, int c_, int rep_ = 1) { A = (const char*)A_; B = (const char*)B_; tstep = (size_t)BM * K * 2; nM = nM_; nN = nN_; nwg = nM * nN; G = G_; c = c_; rep = rep_; }
    __device__ __forceinline__ bool next(int i, Unit& u) const {
        long L = (long)i * G + c; if (L >= (long)nwg * rep) return false;
        u.dup = L >= nwg; if (u.dup) L -= nwg;
        int wgid = (int)L; { const int q = nwg / NXCD, r = nwg % NXCD, xcd = wgid % NXCD, off = wgid / NXCD; wgid = (xcd < r ? xcd * (q + 1) : r * (q + 1) + (xcd - r) * q) + off; }
        const int nig = WGM * nN, gid = wgid / nig, fm = gid * WGM, gsz = (nM - fm) < WGM ? (nM - fm) : WGM;
        u.pm = fm + ((wgid % nig) % gsz); u.pn = (wgid % nig) / gsz; return true;
    }
    __device__ __forceinline__ const char* a_ptr(const Unit& u) const { return A + (size_t)u.pm * tstep; }
    __device__ __forceinline__ const char* b_ptr(const Unit& u) const { return B + (size_t)u.pn * tstep; }
    __device__ __forceinline__ int a_row(const Unit&, int) const { return 0; }
    __device__ __forceinline__ const int* a_row_ptr(const Unit&, int) const { return nullptr; }
};

template <class Epi, class Sched, bool GATHER, bool ALIGN_EPI = true>
__device__ __forceinline__ void gemm_phase(LAS unsigned char* lds, const int tid_, const int K_, const Sched& S, const Epi& E) {
    int tid = tid_, K = K_;
    asm volatile("" : "+v"(tid)); asm volatile("" : "+s"(K));
    const int wid = __builtin_amdgcn_readfirstlane(tid >> 6), lane = tid & 63, wr = wid >> 2, wc = wid & 3, fr = lane & 15, fq = lane >> 4;
    const int nt = K / BK;
    unsigned voffA[2], voffB[2]; int RA[2], CA2[2];
#pragma unroll
    for (int i = 0; i < 2; ++i) { int R, C; stage_rc(tid * 16 + i * 8192, R, C); const int Rb = Epi::PERM ? ((R & ~31) + perm32(R & 31)) : R;
        voffA[i] = (unsigned)(R * K + C) * 2u; voffB[i] = (unsigned)(Rb * K + C) * 2u; RA[i] = R; CA2[i] = C * 2; }
    const size_t kstep = (size_t)(BK * 2);
    const size_t hstep = GATHER ? (size_t)0 : (size_t)HALF * K * 2;
    const size_t hstepB = (size_t)HALF * K * 2;
    const unsigned ldsw = (unsigned)wid * 1024u;
    const int aoff = lds_byte(wr * 64 + fr, fq * 8), boff = lds_byte(wc * 32 + fr, fq * 8);
#define PG8_SA(b, h) (((b) * 2 + (h)) * HTB)
#define PG8_SB(b, h) ((4 + (b) * 2 + (h)) * HTB)
#define PG8_STAGE(bufoff, gbase, voff) do { const char* _gb = uni_ptr((const char*)(gbase)); _Pragma("unroll") for (int _i = 0; _i < 2; ++_i) \
        __builtin_amdgcn_global_load_lds((const unsigned*)(_gb + (voff)[_i]), (LAS unsigned*)(lds + (bufoff) + ldsw + _i * 8192), 16, 0, 0); } while (0)
#define PG8_LDA(dst, b, h) do { _Pragma("unroll") for (int m = 0; m < 4; ++m) _Pragma("unroll") for (int k = 0; k < 2; ++k) dst[m][k] = *(const LAS bf16x8*)(lds + PG8_SA(b, h) + aoff + m * 2048 + k * 1024); } while (0)
#define PG8_LDB(dst, b, h) do { _Pragma("unroll") for (int n = 0; n < 2; ++n) _Pragma("unroll") for (int k = 0; k < 2; ++k) dst[n][k] = *(const LAS bf16x8*)(lds + PG8_SB(b, h) + boff + n * 2048 + k * 1024); } while (0)
#define PG8_MMA(ai, bj, At, Bt) do { __builtin_amdgcn_s_setprio(1); _Pragma("unroll") for (int m = 0; m < 4; ++m) _Pragma("unroll") for (int n = 0; n < 2; ++n) _Pragma("unroll") for (int k = 0; k < 2; ++k) \
        acc[ai][bj][m][n] = __builtin_amdgcn_mfma_f32_16x16x32_bf16(Bt[n][k], At[m][k], acc[ai][bj][m][n], 0, 0, 0); __builtin_amdgcn_s_setprio(0); } while (0)
#define PG8_MMA0(ai, bj, At, Bt) do { __builtin_amdgcn_s_setprio(1); _Pragma("unroll") for (int m = 0; m < 4; ++m) _Pragma("unroll") for (int n = 0; n < 2; ++n) { \
        acc[ai][bj][m][n] = __builtin_amdgcn_mfma_f32_16x16x32_bf16(Bt[n][0], At[m][0], (f32x4){0.f, 0.f, 0.f, 0.f}, 0, 0, 0); \
        acc[ai][bj][m][n] = __builtin_amdgcn_mfma_f32_16x16x32_bf16(Bt[n][1], At[m][1], acc[ai][bj][m][n], 0, 0, 0); } __builtin_amdgcn_s_setprio(0); } while (0)
#define PG8_MMAF(ai, bj, At, Bt) do { if (t == 0) PG8_MMA0(ai, bj, At, Bt); else PG8_MMA(ai, bj, At, Bt); } while (0)
#define PG8_WAIT_V(n) asm volatile("s_waitcnt vmcnt(" #n ")" ::: "memory")
#define PG8_WAIT_V8R() do { if (Epi::NST > 0 && relax) asm volatile("s_waitcnt vmcnt(%0)" :: "n"(8 + Epi::NST) : "memory"); else asm volatile("s_waitcnt vmcnt(8)" ::: "memory"); } while (0)
#define PG8_WAIT_L(n) asm volatile("s_waitcnt lgkmcnt(" #n ")" ::: "memory")
#define PG8_BAR __builtin_amdgcn_s_barrier()
#define PG8_SCHED __builtin_amdgcn_sched_barrier(0)
    Unit cur, nxt; int ui = 0; bool prev_ok = false;
    if (!S.next(0, cur)) return;
    f32x4 acc[2][2][4][2];
    bf16x8 At[4][2], B0[2][2], B1[2][2];
    unsigned gc0[2], gc1[2];
    const char* cA = S.a_ptr(cur); const char* cB = S.b_ptr(cur);
    LAS int* gtab = (LAS int*)(lds + STAGE_BYTES + 1024);
    LAS unsigned char* rtab = lds + STAGE_BYTES + 4096;
#define PG8_RT(U, SLOT) do { if constexpr (Epi::RT) { if (wid == 4 || wid == 5) \
        __builtin_amdgcn_global_load_lds((const unsigned*)(uni_ptr((const char*)E.rt_src((U), wid - 4)) + (unsigned)lane * 16u), (LAS unsigned*)(rtab + (SLOT) * 2048 + (wid - 4) * 1024), 16, 0, 0); } } while (0)
    PG8_RT(cur, 0);
    if constexpr (GATHER) {
#pragma unroll
        for (int i = 0; i < 2; ++i) { gc0[i] = (unsigned)S.a_row(cur, RA[i]) * (unsigned)(K * 2) + CA2[i]; gc1[i] = (unsigned)S.a_row(cur, HALF + RA[i]) * (unsigned)(K * 2) + CA2[i]; }
    } else {
#pragma unroll
        for (int i = 0; i < 2; ++i) { gc0[i] = voffA[i]; gc1[i] = voffA[i]; }
    }
    PG8_STAGE(PG8_SB(0, 0), cB, voffB); PG8_STAGE(PG8_SB(0, 1), cB + hstepB, voffB); PG8_STAGE(PG8_SA(0, 0), cA, gc0); PG8_STAGE(PG8_SA(0, 1), cA + hstep, gc1);
    if (wr == 1) PG8_BAR;
    PG8_WAIT_V(2); PG8_BAR;
    PG8_STAGE(PG8_SB(1, 0), cB + kstep, voffB); PG8_STAGE(PG8_SA(1, 0), cA + kstep, gc0); PG8_STAGE(PG8_SB(1, 1), cB + hstepB + kstep, voffB);
    PG8_WAIT_V(6); PG8_BAR;
    for (;;) {
        const bool has_next = S.next(ui + 1, nxt);
        const char* nA = has_next ? S.a_ptr(nxt) : cA; const char* nB = has_next ? S.b_ptr(nxt) : cB;
        if (has_next) PG8_RT(nxt, (ui + 1) & 1);
        if constexpr (GATHER) { if (has_next && wid < 4)
            __builtin_amdgcn_global_load_lds((const unsigned*)(uni_ptr((const char*)S.a_row_ptr(nxt, 0)) + (unsigned)tid * 4u), (LAS unsigned*)(gtab + ((ui + 1) & 1) * 256 + wid * 64), 4, 0, 0); }
        for (int t = 0; t < nt; t += 2) {
            const bool last = (t == nt - 2);
            const bool relax = (t == 0) && prev_ok;
            const char* a1 = cA + (size_t)(t + 1) * kstep;
            const char* a2 = last ? nA : cA + (size_t)(t + 2) * kstep; const char* b2 = last ? nB : cB + (size_t)(t + 2) * kstep;
            const char* a3 = a2 + kstep; const char* b3 = b2 + kstep;
            unsigned s0[2], s1[2];
#pragma unroll
            for (int i = 0; i < 2; ++i) { s0[i] = gc0[i]; s1[i] = gc1[i]; }
            if constexpr (GATHER) { if (last && has_next) {
#pragma unroll
                for (int i = 0; i < 2; ++i) { const LAS int* tb = gtab + ((ui + 1) & 1) * 256; int r0 = tb[RA[i]], r1 = tb[HALF + RA[i]]; r0 = r0 < 0 ? 0 : r0; r1 = r1 < 0 ? 0 : r1;
                    s0[i] = (unsigned)r0 * (unsigned)(K * 2) + CA2[i]; s1[i] = (unsigned)r1 * (unsigned)(K * 2) + CA2[i]; } } }
            PG8_LDB(B0, 0, 0); PG8_LDB(B1, 0, 1); PG8_SCHED; PG8_LDA(At, 0, 0); PG8_STAGE(PG8_SA(1, 1), a1 + hstep, gc1);
            PG8_WAIT_V8R(); PG8_WAIT_L(0); PG8_BAR; PG8_MMAF(0, 0, At, B0); PG8_MMAF(0, 1, At, B1); PG8_BAR; PG8_SCHED;
            PG8_LDA(At, 0, 1); PG8_STAGE(PG8_SB(0, 0), b2, voffB); PG8_STAGE(PG8_SB(0, 1), b2 + hstepB, voffB); PG8_STAGE(PG8_SA(0, 0), a2, s0);
            PG8_WAIT_V8R(); PG8_WAIT_L(0); PG8_BAR; PG8_MMAF(1, 0, At, B0); PG8_MMAF(1, 1, At, B1); PG8_BAR; PG8_SCHED;
            PG8_LDB(B0, 1, 0); PG8_LDB(B1, 1, 1); PG8_SCHED; PG8_LDA(At, 1, 0); PG8_STAGE(PG8_SA(0, 1), a2 + hstep, s1);
            PG8_WAIT_V8R(); PG8_WAIT_L(0); PG8_BAR; PG8_MMA(0, 0, At, B0); PG8_MMA(0, 1, At, B1); PG8_BAR; PG8_SCHED;
            PG8_LDA(At, 1, 1); PG8_STAGE(PG8_SB(1, 0), b3, voffB); PG8_STAGE(PG8_SB(1, 1), b3 + hstepB, voffB); PG8_STAGE(PG8_SA(1, 0), a3, s0);
            PG8_WAIT_V8R(); PG8_WAIT_L(0); PG8_BAR; PG8_MMA(1, 0, At, B0); PG8_MMA(1, 1, At, B1); PG8_BAR; PG8_SCHED;
        }
        if constexpr (ALIGN_EPI) { if (wr == 0) PG8_BAR; }
        E(acc, cur, wr, wc, fr, fq, (const LAS unsigned char*)(rtab + (ui & 1) * 2048));
        if (!has_next) break;
        prev_ok = E.nst_ok(cur); cur = nxt; cA = nA; cB = nB; ++ui;
        if constexpr (GATHER) {
#pragma unroll
            for (int i = 0; i < 2; ++i) { const LAS int* tb = gtab + (ui & 1) * 256; int r0 = tb[RA[i]], r1 = tb[HALF + RA[i]]; r0 = r0 < 0 ? 0 : r0; r1 = r1 < 0 ? 0 : r1;
                gc0[i] = (unsigned)r0 * (unsigned)(K * 2) + CA2[i]; gc1[i] = (unsigned)r1 * (unsigned)(K * 2) + CA2[i]; }
        }
        if constexpr (ALIGN_EPI) { if (wr == 1) PG8_BAR; }
    }
    PG8_WAIT_V(0);
    if constexpr (!ALIGN_EPI) { if (wr == 0) PG8_BAR; }
    PG8_BAR;
#undef PG8_RT
#undef PG8_SA
#undef PG8_SB
#undef PG8_STAGE
#undef PG8_LDA
#undef PG8_LDB
#undef PG8_MMA
#undef PG8_MMA0
#undef PG8_MMAF
#undef PG8_WAIT_V
#undef PG8_WAIT_V8R
#undef PG8_WAIT_L
#undef PG8_BAR
#undef PG8_SCHED
}
template <class Epi, class Sched, bool GATHER, bool ALIGN_EPI = true>
__device__ __forceinline__ void gemm_phase8(LAS unsigned char* lds, const int tid_, const int K_, const Sched& S, const Epi& E) {
    int tid = tid_, K = K_;
    asm volatile("" : "+v"(tid)); asm volatile("" : "+s"(K));
    const int wid = __builtin_amdgcn_readfirstlane(tid >> 6), lane = tid & 63, wr = wid >> 2, wc = wid & 3, fr = lane & 15, fq = lane >> 4;
    const int nt = K / 128;
    unsigned voffA[2], voffB[2]; int RA[2], CA2[2];
#pragma unroll
    for (int i = 0; i < 2; ++i) { int R, C; stage_rc(tid * 16 + i * 8192, R, C); const int Rb = Epi::PERM ? ((R & ~31) + perm32(R & 31)) : R;
        voffA[i] = (unsigned)(R * K + C * 2); voffB[i] = (unsigned)(Rb * K + C * 2); RA[i] = R; CA2[i] = C * 2; }
    const size_t kstep = (size_t)(BK * 2);
    const size_t hstep = GATHER ? (size_t)0 : (size_t)HALF * K;
    const size_t hstepB = (size_t)HALF * K;
    const unsigned ldsw = (unsigned)wid * 1024u; const unsigned ldsb_ = (unsigned)(uintptr_t)lds + ldsw;
    const int aoff = lds_byte(wr * 64 + fr, fq * 16), boff = lds_byte(wc * 32 + fr, fq * 16);
#define PG8_SA(b, h) (((b) * 2 + (h)) * HTB)
#define PG8_SB(b, h) ((4 + (b) * 2 + (h)) * HTB)
#define PG8_STAGE(bufoff, gbase, voff) do { const char* _gb = uni_ptr((const char*)(gbase)); _Pragma("unroll") for (int _i = 0; _i < 2; ++_i) \
        glds16_s(_gb, (voff)[_i], ldsb_ + (unsigned)((bufoff) + _i * 8192)); } while (0)
#define PG8_LD32(p) (*(const LAS v8i*)(p))
#define PG8_LDA(dst, b, h) do { _Pragma("unroll") for (int m = 0; m < 4; ++m) dst[m] = PG8_LD32(lds + PG8_SA(b, h) + aoff + m * 2048); } while (0)
#define PG8_LDB(dst, b, h) do { _Pragma("unroll") for (int n = 0; n < 2; ++n) dst[n] = PG8_LD32(lds + PG8_SB(b, h) + boff + n * 2048); } while (0)
#define PG8_MMA(ai, bj, At, Bt) do { __builtin_amdgcn_s_setprio(1); _Pragma("unroll") for (int m = 0; m < 4; ++m) _Pragma("unroll") for (int n = 0; n < 2; ++n) \
        asm volatile("v_mfma_scale_f32_16x16x128_f8f6f4 %0, %1, %2, %0, %3, %3 op_sel_hi:[0,0,0]" : "+v"(acc[ai][bj][m][n]) : "v"(Bt[n]), "v"(At[m]), "v"(sc1_)); __builtin_amdgcn_s_setprio(0); } while (0)
#define PG8_MMA0(ai, bj, At, Bt) do { __builtin_amdgcn_s_setprio(1); _Pragma("unroll") for (int m = 0; m < 4; ++m) _Pragma("unroll") for (int n = 0; n < 2; ++n) \
        asm volatile("v_mfma_scale_f32_16x16x128_f8f6f4 %0, %1, %2, 0, %3, %3 op_sel_hi:[0,0,0]" : "=&v"(acc[ai][bj][m][n]) : "v"(Bt[n]), "v"(At[m]), "v"(sc1_)); __builtin_amdgcn_s_setprio(0); } while (0)
#define PG8_MMAF(ai, bj, At, Bt) do { if (t == 0) PG8_MMA0(ai, bj, At, Bt); else PG8_MMA(ai, bj, At, Bt); } while (0)
#define PG8_WAIT_V(n) asm volatile("s_waitcnt vmcnt(" #n ")" ::: "memory")
#define PG8_WAIT_V8R() do { if (Epi::NST > 0 && relax) asm volatile("s_waitcnt vmcnt(%0)" :: "n"(8 + Epi::NST) : "memory"); else asm volatile("s_waitcnt vmcnt(8)" ::: "memory"); } while (0)
#define PG8_WAIT_L(n) asm volatile("s_waitcnt lgkmcnt(" #n ")" ::: "memory")
#define PG8_BAR __builtin_amdgcn_s_barrier()
#define PG8_SCHED __builtin_amdgcn_sched_barrier(0)
    Unit cur, nxt; int ui = 0; bool prev_ok = false;
    if (!S.next(0, cur)) return;
    const unsigned sc1_ = 0x7F7F7F7Fu;
    f32x4 acc[2][2][4][2];
    unsigned gc0[2], gc1[2];
    const char* cA = S.a_ptr(cur); const char* cB = S.b_ptr(cur);
    LAS int* gtab = (LAS int*)(lds + STAGE_BYTES + 1024);
    LAS unsigned char* rtab = lds + STAGE_BYTES + 4096;
#define PG8_RT(U, SLOT) do { if constexpr (Epi::RT) { if (wid == 4 || wid == 5) \
        __builtin_amdgcn_global_load_lds((const unsigned*)(uni_ptr((const char*)E.rt_src((U), wid - 4)) + (unsigned)lane * 16u), (LAS unsigned*)(rtab + (SLOT) * 2048 + (wid - 4) * 1024), 16, 0, 0); } } while (0)
    PG8_RT(cur, 0);
    if constexpr (GATHER) {
#pragma unroll
        for (int i = 0; i < 2; ++i) { gc0[i] = (unsigned)S.a_row(cur, RA[i]) * (unsigned)K + CA2[i]; gc1[i] = (unsigned)S.a_row(cur, HALF + RA[i]) * (unsigned)K + CA2[i]; }
    } else {
#pragma unroll
        for (int i = 0; i < 2; ++i) { gc0[i] = voffA[i]; gc1[i] = voffA[i]; }
    }
    PG8_STAGE(PG8_SB(0, 0), cB, voffB); PG8_STAGE(PG8_SB(0, 1), cB + hstepB, voffB); PG8_STAGE(PG8_SA(0, 0), cA, gc0); PG8_STAGE(PG8_SA(0, 1), cA + hstep, gc1);
    if (wr == 1) PG8_BAR;
    PG8_WAIT_V(2); PG8_BAR;
    PG8_STAGE(PG8_SB(1, 0), cB + kstep, voffB); PG8_STAGE(PG8_SA(1, 0), cA + kstep, gc0); PG8_STAGE(PG8_SB(1, 1), cB + hstepB + kstep, voffB);
    PG8_WAIT_V(6); PG8_BAR;
    for (;;) {
        const bool has_next = S.next(ui + 1, nxt);
        const char* nA = has_next ? S.a_ptr(nxt) : cA; const char* nB = has_next ? S.b_ptr(nxt) : cB;
        if (has_next) PG8_RT(nxt, (ui + 1) & 1);
        if constexpr (GATHER) { if (has_next && wid < 4)
            __builtin_amdgcn_global_load_lds((const unsigned*)(uni_ptr((const char*)S.a_row_ptr(nxt, 0)) + (unsigned)tid * 4u), (LAS unsigned*)(gtab + ((ui + 1) & 1) * 256 + wid * 64), 4, 0, 0); }
        for (int t = 0; t < nt; t += 2) {
            const bool last = (t == nt - 2);
            const bool relax = (t == 0) && prev_ok;
            v8i At[4], B0[2], B1[2];
            const char* a1 = cA + (size_t)(t + 1) * kstep;
            const char* a2 = last ? nA : cA + (size_t)(t + 2) * kstep; const char* b2 = last ? nB : cB + (size_t)(t + 2) * kstep;
            const char* a3 = a2 + kstep; const char* b3 = b2 + kstep;
            unsigned s0[2], s1[2];
#pragma unroll
            for (int i = 0; i < 2; ++i) { s0[i] = gc0[i]; s1[i] = gc1[i]; }
            if constexpr (GATHER) { if (last && has_next) { int t2 = tid; asm volatile("" : "+v"(t2));
#pragma unroll
                for (int i = 0; i < 2; ++i) { int R_, C_; stage_rc(t2 * 16 + i * 8192, R_, C_); const LAS int* tb = gtab + ((ui + 1) & 1) * 256; int r0 = tb[R_], r1 = tb[HALF + R_]; r0 = r0 < 0 ? 0 : r0; r1 = r1 < 0 ? 0 : r1;
                    s0[i] = (unsigned)r0 * (unsigned)K + (unsigned)(C_ * 2); s1[i] = (unsigned)r1 * (unsigned)K + (unsigned)(C_ * 2); } } }
            PG8_LDB(B0, 0, 0); PG8_LDB(B1, 0, 1); PG8_SCHED; PG8_LDA(At, 0, 0); PG8_STAGE(PG8_SA(1, 1), a1 + hstep, gc1);
            PG8_WAIT_V8R(); PG8_WAIT_L(0); PG8_BAR; PG8_MMAF(0, 0, At, B0); PG8_MMAF(0, 1, At, B1); PG8_BAR; PG8_SCHED;
            PG8_LDA(At, 0, 1); PG8_STAGE(PG8_SB(0, 0), b2, voffB); PG8_STAGE(PG8_SB(0, 1), b2 + hstepB, voffB); PG8_STAGE(PG8_SA(0, 0), a2, s0);
            PG8_WAIT_V8R(); PG8_WAIT_L(0); PG8_BAR; PG8_MMAF(1, 0, At, B0); PG8_MMAF(1, 1, At, B1); PG8_BAR; PG8_SCHED;
            PG8_LDB(B0, 1, 0); PG8_LDB(B1, 1, 1); PG8_SCHED; PG8_LDA(At, 1, 0); PG8_STAGE(PG8_SA(0, 1), a2 + hstep, s1);
            PG8_WAIT_V8R(); PG8_WAIT_L(0); PG8_BAR; PG8_MMA(0, 0, At, B0); PG8_MMA(0, 1, At, B1); PG8_BAR; PG8_SCHED;
            PG8_LDA(At, 1, 1); PG8_STAGE(PG8_SB(1, 0), b3, voffB); PG8_STAGE(PG8_SB(1, 1), b3 + hstepB, voffB); PG8_STAGE(PG8_SA(1, 0), a3, s0);
            PG8_WAIT_V8R(); PG8_WAIT_L(0); PG8_BAR; PG8_MMA(1, 0, At, B0); PG8_MMA(1, 1, At, B1); PG8_BAR; PG8_SCHED;
        }
        if constexpr (ALIGN_EPI) { if (wr == 0) PG8_BAR; }
        asm volatile("s_nop 15\n\ts_nop 15" ::: "memory");
        E(acc, cur, wr, wc, fr, fq, (const LAS unsigned char*)(rtab + (ui & 1) * 2048));
        if (!has_next) break;
        prev_ok = E.nst_ok(cur); cur = nxt; cA = nA; cB = nB; ++ui;
        if constexpr (GATHER) { int t2 = tid; asm volatile("" : "+v"(t2));
#pragma unroll
            for (int i = 0; i < 2; ++i) { int R_, C_; stage_rc(t2 * 16 + i * 8192, R_, C_); const LAS int* tb = gtab + (ui & 1) * 256; int r0 = tb[R_], r1 = tb[HALF + R_]; r0 = r0 < 0 ? 0 : r0; r1 = r1 < 0 ? 0 : r1;
                gc0[i] = (unsigned)r0 * (unsigned)K + (unsigned)(C_ * 2); gc1[i] = (unsigned)r1 * (unsigned)K + (unsigned)(C_ * 2); }
        }
        if constexpr (ALIGN_EPI) { if (wr == 1) PG8_BAR; }
    }
    PG8_WAIT_V(0);
    if constexpr (!ALIGN_EPI) { if (wr == 0) PG8_BAR; }
    PG8_BAR;
#undef PG8_RT
#undef PG8_SA
#undef PG8_SB
#undef PG8_STAGE
#undef PG8_LDA
#undef PG8_LDB
#undef PG8_MMA
#undef PG8_MMA0
#undef PG8_MMAF
#undef PG8_WAIT_V
#undef PG8_WAIT_V8R
#undef PG8_WAIT_L
#undef PG8_BAR
#undef PG8_SCHED
#undef PG8_LD32
}
template <class Epi>
__device__ __forceinline__ void thin_gemm(LAS unsigned char* lds, const int tid_, const bf16_t* A, const bf16_t* Bt, const int K_, const int nN, const int bid, const Epi& E) {
    if (bid >= 4 * nN) return;
    int tid = tid_, K = K_; asm volatile("" : "+v"(tid)); asm volatile("" : "+s"(K));
    const int wid = __builtin_amdgcn_readfirstlane(tid >> 6), lane = tid & 63, fr = lane & 15, fq = lane >> 4;
    const int wc = bid & 3, pn = bid >> 2;
    LAS unsigned char* rtab = lds + STAGE_BYTES + 4096;
    { Unit u0; u0.pm = NPANEL - 1; u0.pn = pn; u0.dup = false;
      if constexpr (Epi::RT) { if (wid == 7) __builtin_amdgcn_global_load_lds((const unsigned*)(uni_ptr((const char*)E.rt_src(u0, 0)) + (unsigned)lane * 16u), (LAS unsigned*)rtab, 16, 0, 0); } }
    f32x4 part[2][2];
#pragma unroll
    for (int b = 0; b < 2; ++b)
#pragma unroll
        for (int n = 0; n < 2; ++n) part[b][n] = (f32x4){0.f, 0.f, 0.f, 0.f};
    const char* ab = uni_ptr((const char*)A); const char* bb = uni_ptr((const char*)Bt);
    const int kw = K >> 3;
    const unsigned aoff = ((unsigned)(MMAIN + fr) * (unsigned)K + (unsigned)(wid * kw) + fq * 8) * 2u;
    unsigned boff[2][2];
#pragma unroll
    for (int bj = 0; bj < 2; ++bj)
#pragma unroll
        for (int n = 0; n < 2; ++n) { const int rho = 16 * n + fr; const int col = pn * 256 + bj * 128 + wc * 32 + (Epi::PERM ? perm32(rho) : rho); boff[bj][n] = ((unsigned)col * (unsigned)K + (unsigned)(wid * kw) + fq * 8) * 2u; }
    for (int k0 = 0; k0 < kw; k0 += 32) {
        const bf16x8 a = *(const bf16x8*)(ab + aoff + k0 * 2);
#pragma unroll
        for (int bj = 0; bj < 2; ++bj)
#pragma unroll
            for (int n = 0; n < 2; ++n) { const bf16x8 b = *(const bf16x8*)(bb + boff[bj][n] + k0 * 2); part[bj][n] = __builtin_amdgcn_mfma_f32_16x16x32_bf16(b, a, part[bj][n], 0, 0, 0); }
    }
    LAS f32x4* px = (LAS f32x4*)lds;
#pragma unroll
    for (int bj = 0; bj < 2; ++bj)
#pragma unroll
        for (int n = 0; n < 2; ++n) px[(wid * 4 + bj * 2 + n) * 64 + lane] = part[bj][n];
    asm volatile("s_waitcnt vmcnt(0)" ::: "memory");
    __syncthreads();
    if (wid == 0) {
        f32x4 acc[2][2][4][2];
#pragma unroll
        for (int a = 0; a < 2; ++a)
#pragma unroll
            for (int b = 0; b < 2; ++b)
#pragma unroll
                for (int m = 0; m < 4; ++m)
#pragma unroll
                    for (int n = 0; n < 2; ++n) acc[a][b][m][n] = (f32x4){0.f, 0.f, 0.f, 0.f};
#pragma unroll
        for (int bj = 0; bj < 2; ++bj)
#pragma unroll
            for (int n = 0; n < 2; ++n) { f32x4 s = px[(bj * 2 + n) * 64 + lane];
#pragma unroll
                for (int w = 1; w < 8; ++w) s += px[(w * 4 + bj * 2 + n) * 64 + lane];
                acc[0][bj][0][n] = s; }
        Unit u; u.pm = NPANEL - 1; u.pn = pn; u.dup = false;
        E(acc, u, 0, wc, fr, fq, Epi::RT ? (const LAS unsigned char*)rtab : (const LAS unsigned char*)nullptr);
    }
    __syncthreads();
}
template <class Epi>
__device__ __forceinline__ void thin_gemm8(LAS unsigned char* lds, const int tid_, const unsigned char* A8, const unsigned char* Bt8, const int K_, const int nN, const int bid, const Epi& E) {
    if (bid >= 4 * nN) return;
    int tid = tid_, K = K_; asm volatile("" : "+v"(tid)); asm volatile("" : "+s"(K));
    const int wid = __builtin_amdgcn_readfirstlane(tid >> 6), lane = tid & 63, fr = lane & 15, fq = lane >> 4;
    const int wc = bid & 3, pn = bid >> 2;
    LAS unsigned char* rtab = lds + STAGE_BYTES + 4096;
    { Unit u0; u0.pm = NPANEL - 1; u0.pn = pn; u0.dup = false;
      if constexpr (Epi::RT) { if (wid == 7) __builtin_amdgcn_global_load_lds((const unsigned*)(uni_ptr((const char*)E.rt_src(u0, 0)) + (unsigned)lane * 16u), (LAS unsigned*)rtab, 16, 0, 0); } }
    f32x4 part[2][2];
#pragma unroll
    for (int b = 0; b < 2; ++b)
#pragma unroll
        for (int n = 0; n < 2; ++n) part[b][n] = (f32x4){0.f, 0.f, 0.f, 0.f};
    const char* ab = uni_ptr((const char*)A8); const char* bb = uni_ptr((const char*)Bt8);
    const unsigned aoff = (unsigned)(MMAIN + fr) * (unsigned)K + fq * 32;
    unsigned boff[2][2];
#pragma unroll
    for (int bj = 0; bj < 2; ++bj)
#pragma unroll
        for (int n = 0; n < 2; ++n) { const int rho = 16 * n + fr; const int col = pn * 256 + bj * 128 + wc * 32 + (Epi::PERM ? perm32(rho) : rho); boff[bj][n] = (unsigned)col * (unsigned)K + fq * 32; }
    const unsigned sc1_ = 0x7F7F7F7Fu;
    for (int k0 = wid * 128; k0 < K; k0 += 1024) {
        const v8i a = *(const v8i*)(ab + aoff + k0);
#pragma unroll
        for (int bj = 0; bj < 2; ++bj)
#pragma unroll
            for (int n = 0; n < 2; ++n) { const v8i b = *(const v8i*)(bb + boff[bj][n] + k0);
                asm volatile("v_mfma_scale_f32_16x16x128_f8f6f4 %0, %1, %2, %0, %3, %3 op_sel_hi:[0,0,0]" : "+v"(part[bj][n]) : "v"(b), "v"(a), "v"(sc1_)); }
    }
    asm volatile("s_nop 15\n\ts_nop 15" ::: "memory");
    LAS f32x4* px = (LAS f32x4*)lds;
#pragma unroll
    for (int bj = 0; bj < 2; ++bj)
#pragma unroll
        for (int n = 0; n < 2; ++n) px[(wid * 4 + bj * 2 + n) * 64 + lane] = part[bj][n];
    asm volatile("s_waitcnt vmcnt(0)" ::: "memory");
    __syncthreads();
    if (wid == 0) {
        f32x4 acc[2][2][4][2];
#pragma unroll
        for (int a = 0; a < 2; ++a)
#pragma unroll
            for (int b = 0; b < 2; ++b)
#pragma unroll
                for (int m = 0; m < 4; ++m)
#pragma unroll
                    for (int n = 0; n < 2; ++n) acc[a][b][m][n] = (f32x4){0.f, 0.f, 0.f, 0.f};
#pragma unroll
        for (int bj = 0; bj < 2; ++bj)
#pragma unroll
            for (int n = 0; n < 2; ++n) { f32x4 s = px[(bj * 2 + n) * 64 + lane];
#pragma unroll
                for (int w = 1; w < 8; ++w) s += px[(w * 4 + bj * 2 + n) * 64 + lane];
                acc[0][bj][0][n] = s; }
        Unit u; u.pm = NPANEL - 1; u.pn = pn; u.dup = false;
        E(acc, u, 0, wc, fr, fq, Epi::RT ? (const LAS unsigned char*)rtab : (const LAS unsigned char*)nullptr);
    }
    __syncthreads();
}
}
constexpr size_t AL256(size_t x) { return (x + 255) & ~(size_t)255; }
constexpr size_t WS_CTL = 0;
constexpr size_t CTL_BAR_W = 4096;
constexpr size_t CTL_QUEUE_B = 32768;
constexpr size_t CTL_MOECNT_B = 40960;
constexpr size_t CTL_SS_B = 65536;
constexpr size_t SS_BYTES = (size_t)MPAD * 8;
constexpr size_t CTL_BYTES = 9437184;
static_assert(CTL_SS_B + 17 * SS_BYTES <= CTL_BYTES, "ctl");
constexpr size_t WS_ROPE = CTL_BYTES;
constexpr size_t WS_ROUTER = WS_ROPE + 524288;
constexpr size_t WS_WMIX = WS_ROUTER + 65536;
constexpr size_t SZ_WIN = (size_t)DINP * DM * 2, SZ_WQ = (size_t)768 * QLORA * 2, SZ_WKV = (size_t)1024 * KVLORA * 2, SZ_WO = (size_t)DM * DM * 2;
constexpr size_t SZ_WMIX = SZ_WIN + SZ_WQ + SZ_WKV + SZ_WO;
constexpr size_t WS_WDENSE = WS_WMIX + DEPTH * SZ_WMIX;
constexpr size_t SZ_DGU = (size_t)2 * DFF * DM * 2, SZ_DD = (size_t)DM * DFF * 2, SZ_DENSE = SZ_DGU + SZ_DD;
constexpr size_t WS_WMOE = WS_WDENSE + 2 * SZ_DENSE;
constexpr size_t SZ_EGU = (size_t)2 * DFFE * DM * 2, SZ_ED = (size_t)DM * DFFE * 2, SZ_EXP = SZ_EGU + SZ_ED;
constexpr size_t WS_H = WS_WMOE + NEXP * SZ_EXP;
constexpr size_t WS_S = WS_H + (size_t)MPAD * DM * 2;
constexpr size_t S_CQ = 0, S_CKV = S_CQ + (size_t)MPAD * QLORA * 2, S_CAT = 0  ;
constexpr size_t S_XP = S_CKV + (size_t)MPAD * 256 * 2, S_MQK = S_XP + (size_t)MPAD * 256 * 2, S_MV = S_MQK + (size_t)MPAD * 512 * 2, S_MO = S_MV + (size_t)MPAD * 256 * 2;
constexpr size_t S_KR = S_MO + (size_t)MPAD * 256 * 2, S_GATES = S_KR + (size_t)MPAD * 32 * 2, S_Q = S_GATES + (size_t)MPAD * 8 * 4;
constexpr size_t S_KN = S_Q + (size_t)MPAD * 768 * 2, S_V = S_KN + (size_t)MPAD * 512 * 2, S_MIX_END = S_V + (size_t)MPAD * 512 * 2;
constexpr size_t S_ACT = 0;
#ifndef FP8_MOE_MASK
#define FP8_MOE_MASK 0xA
#endif
constexpr int MOE_NCHUNK = (FP8_MOE_MASK == 0xA) ? 2 : 4, MOE_CHUNK = 512 / MOE_NCHUNK, MOE_CHUNK_CAP = (FP8_MOE_MASK == 0xA) ? 272 : 136, MOE_RCAP = 520 * 256, MOE_NASG = MREAL * 2;
constexpr size_t S_ACTE = 0;
constexpr size_t S_Y = S_ACTE + (size_t)136 * 256 * DFFE * 2;
constexpr size_t S_STOK = S_Y + (size_t)MOE_NASG * DM * 2;
constexpr size_t S_SSLOT = S_STOK + (size_t)MOE_RCAP * 4, S_SGATE = S_SSLOT + (size_t)MOE_RCAP * 4, S_SRSTD = S_SGATE + (size_t)MOE_RCAP * 4;
constexpr size_t S_AE = S_SRSTD + (size_t)MOE_RCAP * 4;
constexpr size_t S_APOS = S_AE + AL256((size_t)MOE_NASG * 4), S_AGATE = S_APOS + AL256((size_t)MOE_NASG * 4);
constexpr size_t S_MINFO = S_AGATE + AL256((size_t)MOE_NASG * 4);
constexpr size_t S_ALATE = S_MINFO + 4096;
constexpr size_t S_MOE_END = S_ALATE + AL256((size_t)MOE_NASG * 4);
constexpr int MOE_LATE_LIM = 512 * 256;
constexpr size_t CTL_TAILCNT_B = 32768 + 2048;
static_assert(S_MOE_END <= S_MIX_END && (size_t)MPAD * DFF * 2 <= S_MIX_END, "overlays fit the mixer scratch");
constexpr size_t WS_END = WS_S + S_MIX_END;
constexpr size_t WS_XS8 = WS_END;
constexpr size_t WS_END8 = WS_XS8 + (size_t)MOE_RCAP * DM;
constexpr size_t SZ_EGU8 = (size_t)2 * DFFE * DM, SZ_ED8 = (size_t)DM * DFFE, SZ_EXP8 = SZ_EGU8 + SZ_ED8;
constexpr float W8_SCALE = 64.0f, ACT8_SCALE = 8.0f;
#ifndef FP8_DENSE_MASK
#define FP8_DENSE_MASK 0x4
#endif
#define DENSE_F8(l) ((((FP8_DENSE_MASK) >> (l)) & 1) != 0)
#ifndef FP8_WIN_MASK
#define FP8_WIN_MASK 0xC
#endif
#define WIN_F8(l) ((((FP8_WIN_MASK) >> (l)) & 1) != 0)
#ifndef FP8_WINP_MASK
#define FP8_WINP_MASK 0x3
#endif
#define WINP_F8(l) ((((FP8_WINP_MASK) >> (l)) & 1) != 0 && !WIN_F8(l))
#define H8_IN(l) ((l) < DEPTH && (WIN_F8(l) || WINP_F8(l)))
#ifndef FP8_WOUT_MASK
#define FP8_WOUT_MASK 0xC
#endif
#define WOUT_F8(l) ((((FP8_WOUT_MASK) >> (l)) & 1) != 0)
#ifndef FP8_QKV_MASK
#define FP8_QKV_MASK 0xF
#endif
#define QKV_F8(l) ((((FP8_QKV_MASK) >> (l)) & 1) != 0)
constexpr size_t WS_H8 = WS_XS8;
constexpr size_t SZ_DGU8 = (size_t)2 * DFF * DM, SZ_DD8 = (size_t)DM * DFF;
#define MOE_F8(l) ((FP8_MOE_MASK == 0xA) ? true : (FP8_MOE_MASK == 0) ? false : ((((FP8_MOE_MASK) >> (l)) & 1) != 0))

constexpr int RING_BYTES = 131072;
constexpr int LDS_MISC = RING_BYTES;
constexpr int LDS_BYTES = 147456;

enum { IN_X = 0, IN_META, IN_ATTN_NORM, IN_W_IN, IN_Q_NORM, IN_W_Q_UP, IN_KV_NORM, IN_W_KV_UP, IN_POOL_W, IN_POOL_SCALE, IN_CONV_W, IN_CONV_B, IN_GATE_BIAS, IN_MLSTM_NORM,
       IN_W_OUT, IN_FFN_NORM, IN_DGATE, IN_DUP, IN_DDOWN, IN_ROUTER, IN_MGATE, IN_MUP, IN_MDOWN, IN_FINAL_NORM, N_IN };
struct Args { const float* in[N_IN]; float* out; unsigned char* ws; int ph_lo, ph_hi; };
__device__ __forceinline__ const float* inp(int i) { return ((const float* const __attribute__((address_space(4)))*)__builtin_amdgcn_kernarg_segment_ptr())[i]; }
__device__ __forceinline__ float* outp() { return ((float* const __attribute__((address_space(4)))*)__builtin_amdgcn_kernarg_segment_ptr())[N_IN]; }
__device__ __forceinline__ unsigned char* wsp() { return ((unsigned char* const __attribute__((address_space(4)))*)__builtin_amdgcn_kernarg_segment_ptr())[N_IN + 1]; }
__device__ __forceinline__ int argi(int i) { return ((const int __attribute__((address_space(4)))*)__builtin_amdgcn_kernarg_segment_ptr())[2 * (N_IN + 2) + i]; }

struct Ctx {
    LAS unsigned char* lds; unsigned char* ws; int tid, lane, wave, G, bid;
    __device__ __forceinline__ u64* ss(int idx) const { return (u64*)(ws + CTL_SS_B) + (size_t)idx * MPAD; }
    __device__ __forceinline__ bf16_t* sb(size_t off) const { return (bf16_t*)(ws + WS_S + off); }
};
__device__ __forceinline__ Ctx fresh(const Ctx& X) { Ctx Y = X; asm volatile("" : "+s"(Y.ws)); Y.tid = Y.wave * 64 + lane_id(); asm volatile("" : "+v"(Y.tid)); Y.lane = Y.tid & 63; return Y; }

enum { KIND_ID = 0, KIND_WIN, KIND_QUP, KIND_KVUP, KIND_GU, KIND_WO };
struct Cvt { const float* W; const float* W2; const float* gain; bf16_t* dst; int ldw, K, NP, kind; };
__device__ __forceinline__ int rope_dim(int p) { return ((p >> 2) & 1) * 16 + (p >> 3) * 4 + (p & 3); }
__device__ __forceinline__ int cvt_srccol(int kind, int n, int ldw, bool& second) {
    second = false;
    switch (kind) {
    case KIND_WIN:
        if (n < 1024) return n; if (n < 1280) return 1056 + (n - 1024); if (n < 1792) return 1312 + (n - 1280); if (n < 2048) return 1824 + (n - 1792);
        if (n < 2304) return 2080 + (n - 2048); if (n < 2336) return 1024 + rope_dim(n - 2304); if (n < 2344) return n; return -1;
    case KIND_QUP: return n < 512 ? (n >> 6) * 96 + (n & 63) : ((n - 512) >> 5) * 96 + 64 + rope_dim((n - 512) & 31);
    case KIND_KVUP: return n < 512 ? (n >> 6) * 128 + (n & 63) : ((n - 512) >> 6) * 128 + 64 + ((n - 512) & 63);
    case KIND_GU: { const int t = n >> 8, r = n & 255; if (r >= 128) { second = true; return 128 * t + r - 128; } return 128 * t + r; }
    default: return n < ldw ? n : -1;
    }
}
__device__ __forceinline__ void cvt_item(const Cvt& c, int item, LAS float* scr, int lane) {
    const int nblk = c.NP / 64, kb = item / nblk, nb = item % nblk, k0 = 32 * kb, n0 = 64 * nb;
    if (c.kind == KIND_WO && k0 >= 512 && k0 < 768) return;
    bool second; const int sc = cvt_srccol(c.kind, n0 + 4 * (lane & 15), c.ldw, second);
    const float* src = second ? c.W2 : c.W;
    f32x4 v[8];
#pragma unroll
    for (int i = 0; i < 8; ++i) { const int kk = (lane >> 4) + 4 * i; v[i] = (f32x4){0.f, 0.f, 0.f, 0.f}; if (sc >= 0) v[i] = *(const f32x4*)(src + (size_t)(k0 + kk) * c.ldw + sc); }
    if (c.gain) {
#pragma unroll
        for (int i = 0; i < 8; ++i) v[i] = v[i] * c.gain[k0 + (lane >> 4) + 4 * i]; }
#pragma unroll
    for (int i = 0; i < 8; ++i) *(LAS f32x4*)(scr + ((lane >> 4) + 4 * i) * 68 + 4 * (lane & 15)) = v[i];
    asm volatile("s_waitcnt lgkmcnt(0)" ::: "memory");
    u32x4 o[4];
#pragma unroll
    for (int j = 0; j < 4; ++j) { const LAS float* s = scr + (8 * j) * 68 + lane;
        o[j].x = pk2(s[0 * 68], s[1 * 68]); o[j].y = pk2(s[2 * 68], s[3 * 68]); o[j].z = pk2(s[4 * 68], s[5 * 68]); o[j].w = pk2(s[6 * 68], s[7 * 68]); }
    bf16_t* dr = c.dst + (size_t)(n0 + lane) * c.K + k0;
#pragma unroll
    for (int j = 0; j < 4; ++j) *(u32x4*)(dr + 8 * j) = o[j];
    asm volatile("s_waitcnt lgkmcnt(0)" ::: "memory");
}
__device__ __forceinline__ float clamp8(float x) { return __builtin_amdgcn_fmed3f(x, -448.0f, 448.0f); }
__device__ __forceinline__ unsigned pk4_fp8(float a, float b, float c, float d) { a = clamp8(a); b = clamp8(b); c = clamp8(c); d = clamp8(d); int w = 0; w = __builtin_amdgcn_cvt_pk_fp8_f32(a, b, w, false); w = __builtin_amdgcn_cvt_pk_fp8_f32(c, d, w, true); return (unsigned)w; }
__device__ __forceinline__ void cvt_item8(const Cvt& c, unsigned char* dst8, int item, LAS float* scr, int lane) {
    const int nblk = c.NP / 64, kb = item / nblk, nb = item % nblk, k0 = 32 * kb, n0 = 64 * nb;
    if (c.kind == KIND_WO && k0 >= 512 && k0 < 768) return;
    bool second; const int sc = cvt_srccol(c.kind, n0 + 4 * (lane & 15), c.ldw, second);
    const float* src = second ? c.W2 : c.W;
    f32x4 v[8];
#pragma unroll
    for (int i = 0; i < 8; ++i) { const int kk = (lane >> 4) + 4 * i; v[i] = (f32x4){0.f, 0.f, 0.f, 0.f}; if (sc >= 0) v[i] = *(const f32x4*)(src + (size_t)(k0 + kk) * c.ldw + sc); }
#pragma unroll
    for (int i = 0; i < 8; ++i) v[i] = v[i] * ((c.gain ? c.gain[k0 + (lane >> 4) + 4 * i] : 1.0f) * W8_SCALE);
#pragma unroll
    for (int i = 0; i < 8; ++i) *(LAS f32x4*)(scr + ((lane >> 4) + 4 * i) * 68 + 4 * (lane & 15)) = v[i];
    asm volatile("s_waitcnt lgkmcnt(0)" ::: "memory");
    u32x4 o[2];
#pragma unroll
    for (int j = 0; j < 2; ++j) { const LAS float* s = scr + (16 * j) * 68 + lane;
        o[j].x = pk4_fp8(s[0 * 68], s[1 * 68], s[2 * 68], s[3 * 68]); o[j].y = pk4_fp8(s[4 * 68], s[5 * 68], s[6 * 68], s[7 * 68]);
        o[j].z = pk4_fp8(s[8 * 68], s[9 * 68], s[10 * 68], s[11 * 68]); o[j].w = pk4_fp8(s[12 * 68], s[13 * 68], s[14 * 68], s[15 * 68]); }
    unsigned char* dr = dst8 + (size_t)(n0 + lane) * c.K + k0;
#pragma unroll
    for (int j = 0; j < 2; ++j) *(u32x4*)(dr + 16 * j) = o[j];
    asm volatile("s_waitcnt lgkmcnt(0)" ::: "memory");
}
__device__ __forceinline__ int cvt_nitems(const Cvt& c) { return (c.K / 32) * (c.NP / 64); }
struct CvtJob { Cvt c; unsigned char* d8; int item; bool f8, live; };
struct CvtRegs { f32x4 v[8]; float g[8]; };
__device__ __forceinline__ void cvt_job_load(const CvtJob& j, int lane, CvtRegs& R) {
    const Cvt& c = j.c;
    const int nblk = c.NP / 64, kb = j.item / nblk, nb = j.item % nblk, k0 = 32 * kb, n0 = 64 * nb;
    bool second; const int sc = cvt_srccol(c.kind, n0 + 4 * (lane & 15), c.ldw, second);
    const float* src = second ? c.W2 : c.W;
    const bool on = j.live && !(c.kind == KIND_WO && k0 >= 512 && k0 < 768);
#pragma unroll
    for (int i = 0; i < 8; ++i) { const int kk = (lane >> 4) + 4 * i; R.v[i] = (f32x4){0.f, 0.f, 0.f, 0.f}; R.g[i] = 1.0f;
        if (on && sc >= 0) R.v[i] = __builtin_nontemporal_load((const f32x4*)(src + (size_t)(k0 + kk) * c.ldw + sc));
        if (on && c.gain) R.g[i] = c.gain[k0 + kk]; }
}
__device__ __forceinline__ void cvt_job_store(const CvtJob& j, const CvtRegs& R, LAS float* scr, int lane) {
    const Cvt& c = j.c;
    const int nblk = c.NP / 64, kb = j.item / nblk, nb = j.item % nblk, k0 = 32 * kb, n0 = 64 * nb;
    if (!j.live || (c.kind == KIND_WO && k0 >= 512 && k0 < 768)) return;
    const float ws_ = j.f8 ? W8_SCALE : 1.0f;
#pragma unroll
    for (int i = 0; i < 8; ++i) *(LAS f32x4*)(scr + ((lane >> 4) + 4 * i) * 68 + 4 * (lane & 15)) = R.v[i] * (R.g[i] * ws_);
    asm volatile("s_waitcnt lgkmcnt(0)" ::: "memory");
    if (j.f8) {
        u32x4 o[2];
#pragma unroll
        for (int q = 0; q < 2; ++q) { const LAS float* s = scr + (16 * q) * 68 + lane;
            o[q].x = pk4_fp8(s[0 * 68], s[1 * 68], s[2 * 68], s[3 * 68]); o[q].y = pk4_fp8(s[4 * 68], s[5 * 68], s[6 * 68], s[7 * 68]);
            o[q].z = pk4_fp8(s[8 * 68], s[9 * 68], s[10 * 68], s[11 * 68]); o[q].w = pk4_fp8(s[12 * 68], s[13 * 68], s[14 * 68], s[15 * 68]); }
        unsigned char* dr = j.d8 + (size_t)(n0 + lane) * c.K + k0;
#pragma unroll
        for (int q = 0; q < 2; ++q) *(u32x4*)(dr + 16 * q) = o[q];
    } else {
        u32x4 o[4];
#pragma unroll
        for (int q = 0; q < 4; ++q) { const LAS float* s = scr + (8 * q) * 68 + lane;
            o[q].x = pk2(s[0 * 68], s[1 * 68]); o[q].y = pk2(s[2 * 68], s[3 * 68]); o[q].z = pk2(s[4 * 68], s[5 * 68]); o[q].w = pk2(s[6 * 68], s[7 * 68]); }
        bf16_t* dr = c.dst + (size_t)(n0 + lane) * c.K + k0;
#pragma unroll
        for (int q = 0; q < 4; ++q) *(u32x4*)(dr + 8 * q) = o[q];
    }
    asm volatile("s_waitcnt lgkmcnt(0)" ::: "memory");
}
__device__ __forceinline__ void pool_prep_item(const Ctx& X, int l, int item) {
    const int g = item >> 4, nb = item & 15, n = nb * 64 + X.lane;
    const float* pw = inp(IN_POOL_W) + ((size_t)l * 4 + g) * 4096; const float* ps = inp(IN_POOL_SCALE) + l * 256 + g * 64;
    const float* wo = inp(IN_W_OUT) + (size_t)l * DM * DM + (size_t)(512 + 64 * g) * DM + n;
    bf16_t* dst = (bf16_t*)(X.ws + WS_WMIX + (size_t)l * SZ_WMIX + SZ_WIN + SZ_WQ + SZ_WKV) + (size_t)n * DM + 512 + 64 * g;
    float wv[64];
#pragma unroll
    for (int d = 0; d < 64; ++d) wv[d] = ps[d] * wo[(size_t)d * DM];
#pragma unroll 1
    for (int c8 = 0; c8 < 8; ++c8) {
        float o[8];
#pragma unroll
        for (int cc = 0; cc < 8; ++cc) { const float* pr = pw + (c8 * 8 + cc) * 64; float s = 0.f;
#pragma unroll
            for (int d = 0; d < 64; ++d) s += pr[d] * wv[d];
            o[cc] = s; }
        if (WOUT_F8(l)) { u32x2 w; w.x = pk4_fp8(o[0] * W8_SCALE, o[1] * W8_SCALE, o[2] * W8_SCALE, o[3] * W8_SCALE); w.y = pk4_fp8(o[4] * W8_SCALE, o[5] * W8_SCALE, o[6] * W8_SCALE, o[7] * W8_SCALE);
            *(u32x2*)((unsigned char*)(X.ws + WS_WMIX + (size_t)l * SZ_WMIX + SZ_WIN + SZ_WQ + SZ_WKV) + (size_t)n * DM + 512 + 64 * g + c8 * 8) = w; }
        else { u32x4 w; w.x = pk2(o[0], o[1]); w.y = pk2(o[2], o[3]); w.z = pk2(o[4], o[5]); w.w = pk2(o[6], o[7]);
        *(u32x4*)(dst + c8 * 8) = w; }
    }
}
__device__ __forceinline__ float wave_sum(float v) {
#pragma unroll
    for (int o = 1; o < 64; o <<= 1) v += __shfl_xor(v, o);
    return v;
}
template <class MK> __device__ __forceinline__ void cvt_run(const Ctx& X, int total, MK mk) {
    LAS float* scr = (LAS float*)(X.lds + X.wave * 8704);
    const int gw = X.bid * 8 + X.wave, NGW = X.G * 8;
    CvtJob jc = mk(gw < total ? gw : 0); jc.live = gw < total; CvtRegs rc; cvt_job_load(jc, X.lane, rc);
    for (int it = gw; it < total; it += NGW) {
        const bool hn = it + NGW < total;
        CvtJob jn = mk(hn ? it + NGW : it); jn.live = hn; CvtRegs rn; cvt_job_load(jn, X.lane, rn);
        cvt_job_store(jc, rc, scr, X.lane);
        jc = jn; rc = rn;
    }
}
__device__ __forceinline__ void moe_convert(const Ctx& X, int lm) {
    constexpr int NI_GU = (DM / 32) * (2 * DFFE / 64), NI_D = (DFFE / 32) * (DM / 64), NI_E = NI_GU + NI_D;
    cvt_run(X, NEXP * NI_E, [&](int it) {
        const bool f8 = MOE_F8(2 * lm + 1);
        const int e = it / NI_E, r = it % NI_E; CvtJob j; Cvt& c = j.c; j.f8 = f8; j.live = true;
        if (r < NI_GU) { c.W = inp(IN_MGATE) + ((size_t)lm * NEXP + e) * DM * DFFE; c.W2 = inp(IN_MUP) + ((size_t)lm * NEXP + e) * DM * DFFE; c.gain = inp(IN_FFN_NORM) + (2 * lm + 1) * DM;
            c.dst = (bf16_t*)(X.ws + WS_WMOE + (size_t)e * SZ_EXP); c.ldw = DFFE; c.K = DM; c.NP = 2 * DFFE; c.kind = KIND_GU; j.d8 = X.ws + WS_WMOE + (size_t)e * SZ_EXP8; j.item = r; }
        else { c.W = inp(IN_MDOWN) + ((size_t)lm * NEXP + e) * DFFE * DM; c.W2 = nullptr; c.gain = nullptr;
            c.dst = (bf16_t*)(X.ws + WS_WMOE + (size_t)e * SZ_EXP + SZ_EGU); c.ldw = DM; c.K = DFFE; c.NP = DM; c.kind = KIND_ID; j.d8 = X.ws + WS_WMOE + (size_t)e * SZ_EXP8 + SZ_EGU8; j.item = r - NI_GU; }
        return j; });
}
__device__ __forceinline__ void prologue(const Ctx& X) {
    const int gw = X.bid * 8 + X.wave, NGW = X.G * 8;
    constexpr int NI_WIN = (DM / 32) * (DINP / 64), NI_WQ = (QLORA / 32) * (768 / 64), NI_WKV = (KVLORA / 32) * (1024 / 64), NI_WO = (DM / 32) * (DM / 64);
    constexpr int NI_MIX = NI_WIN + NI_WQ + NI_WKV + NI_WO;
    constexpr int NI_DGU = (DM / 32) * (2 * DFF / 64), NI_DD = (DFF / 32) * (DM / 64), NI_DENSE = NI_DGU + NI_DD;
    cvt_run(X, DEPTH * NI_MIX + 2 * NI_DENSE, [&](int it) {
        CvtJob j; Cvt& c = j.c; c.W2 = nullptr; c.gain = nullptr; j.live = true; j.f8 = false; j.d8 = nullptr;
        if (it < DEPTH * NI_MIX) {
            const int l = it / NI_MIX; int r = it % NI_MIX; unsigned char* wb = X.ws + WS_WMIX + (size_t)l * SZ_WMIX;
            if (r < NI_WIN) { c.W = inp(IN_W_IN) + (size_t)l * DM * DIN; c.gain = inp(IN_ATTN_NORM) + l * DM; c.dst = (bf16_t*)wb; c.ldw = DIN; c.K = DM; c.NP = DINP; c.kind = KIND_WIN; j.f8 = WIN_F8(l) || (WINP_F8(l) && (r % (DINP / 64)) < 16); j.d8 = wb; }
            else if ((r -= NI_WIN) < NI_WQ) { c.W = inp(IN_W_Q_UP) + (size_t)l * QLORA * 768; c.gain = inp(IN_Q_NORM) + l * QLORA; c.dst = (bf16_t*)(wb + SZ_WIN); c.ldw = 768; c.K = QLORA; c.NP = 768; c.kind = KIND_QUP; j.f8 = QKV_F8(l); j.d8 = wb + SZ_WIN; }
            else if ((r -= NI_WQ) < NI_WKV) { c.W = inp(IN_W_KV_UP) + (size_t)l * KVLORA * 1024; c.gain = inp(IN_KV_NORM) + l * KVLORA; c.dst = (bf16_t*)(wb + SZ_WIN + SZ_WQ); c.ldw = 1024; c.K = KVLORA; c.NP = 1024; c.kind = KIND_KVUP; j.f8 = QKV_F8(l); j.d8 = wb + SZ_WIN + SZ_WQ; }
            else { r -= NI_WKV; c.W = inp(IN_W_OUT) + (size_t)l * DM * DM; c.dst = (bf16_t*)(wb + SZ_WIN + SZ_WQ + SZ_WKV); c.ldw = DM; c.K = DM; c.NP = DM; c.kind = KIND_WO; j.f8 = WOUT_F8(l); j.d8 = wb + SZ_WIN + SZ_WQ + SZ_WKV; }
            j.item = r;
        } else {
            const int q = it - DEPTH * NI_MIX, jj = q / NI_DENSE; int r = q % NI_DENSE; unsigned char* wb = X.ws + WS_WDENSE + (size_t)jj * SZ_DENSE;
            if (r < NI_DGU) { c.W = inp(IN_DGATE) + (size_t)jj * DM * DFF; c.W2 = inp(IN_DUP) + (size_t)jj * DM * DFF; c.gain = inp(IN_FFN_NORM) + (2 * jj) * DM; c.dst = (bf16_t*)wb; c.ldw = DFF; c.K = DM; c.NP = 2 * DFF; c.kind = KIND_GU; j.d8 = wb; }
            else { r -= NI_DGU; c.W = inp(IN_DDOWN) + (size_t)jj * DFF * DM; c.dst = (bf16_t*)(wb + SZ_DGU); c.ldw = DM; c.K = DFF; c.NP = DM; c.kind = KIND_ID; j.d8 = wb + SZ_DGU8; }
            j.f8 = DENSE_F8(2 * jj); j.item = r;
        }
        return j; });
    for (int it = gw; it < DEPTH * 64; it += NGW) pool_prep_item(X, it >> 6, it & 63);
    { float* rope = (float*)(X.ws + WS_ROPE); const int gt = X.bid * 512 + X.tid, NT = X.G * 512;
      for (int i = gt; i < LTOT * 16; i += NT) { const int pos = i >> 4, j = i & 15; const float inv = __builtin_amdgcn_exp2f(-(float)j * (13.287712379549449f / 16.0f)); const float ang = (float)pos * inv;
          float rev = ang * 0.15915494309189535f; rev -= floorf(rev);
          rope[pos * 32 + j] = __builtin_amdgcn_cosf(rev); rope[pos * 32 + 16 + j] = __builtin_amdgcn_sinf(rev); }
      float* gr = (float*)(X.ws + WS_ROUTER);
      for (int i = gt; i < 2 * DM * NEXP; i += NT) { const int lm = i / (DM * NEXP), k = (i / NEXP) % DM; gr[i] = inp(IN_ROUTER)[i] * inp(IN_FFN_NORM)[(2 * lm + 1) * DM + k]; } }
    { bf16_t* h = (bf16_t*)(X.ws + WS_H); u64* ss0 = X.ss(0);
      for (int row0 = gw; row0 < MREAL; row0 += 4 * NGW) {
          f32x4 v[4][4];
#pragma unroll
          for (int q = 0; q < 4; ++q) { const int row = row0 + q * NGW;
#pragma unroll
              for (int j = 0; j < 4; ++j) { v[q][j] = (f32x4){0.f, 0.f, 0.f, 0.f};
                  if (row < MREAL) { const float* src = row < MMAIN ? inp(IN_X) + (size_t)row * DM : inp(IN_META) + (size_t)(row - MMAIN) * DM; v[q][j] = __builtin_nontemporal_load((const f32x4*)(src + j * 256 + X.lane * 4)); } } }
#pragma unroll
          for (int q = 0; q < 4; ++q) { const int row = row0 + q * NGW;
              if (row < MREAL) {
                  float s = 0.f;
#pragma unroll
                  for (int j = 0; j < 4; ++j) { u32x2 w; w.x = pk2(v[q][j][0], v[q][j][1]); w.y = pk2(v[q][j][2], v[q][j][3]);
                      *(u32x2*)(h + (size_t)row * DM + j * 256 + X.lane * 4) = w;
                      if (H8_IN(0)) *(unsigned*)(X.ws + WS_H8 + (size_t)row * DM + j * 256 + X.lane * 4) = pk4_fp8(bflo(w.x), bfhi(w.x), bflo(w.y), bfhi(w.y));
                      s += (bflo(w.x) * bflo(w.x) + bfhi(w.x) * bfhi(w.x)) + (bflo(w.y) * bflo(w.y) + bfhi(w.y) * bfhi(w.y)); }
                  s = wave_sum(s); if (X.lane == 0) ss0[row] = ss_fix(s);
              } }
      } }
    moe_convert(X, 0);
}
typedef f32x4 AccT[2][2][4][2];
#define EPI_ROWS_BEGIN  _Pragma("unroll") for (int ai = 0; ai < 2; ++ai) _Pragma("unroll") for (int m = 0; m < 4; ++m) { const int row = row0 + ai * 128 + m * 16;
#define EPI_ROWS_END    }
#define EPI_ROWS_BEGIN_T  _Pragma("unroll") for (int ai = 0; ai < 2; ++ai) _Pragma("unroll") for (int m = 0; m < 4; ++m) { if (u.pm == NPANEL - 1 && ai + m > 0) continue; const int row = row0 + ai * 128 + m * 16;
template <class T> __device__ __forceinline__ T ldo(const void* base, unsigned off) { return *(const T*)((const char*)base + off); }
template <class T> __device__ __forceinline__ void sto(void* base, unsigned off, T v) { *(T*)((char*)base + off) = v; }
__device__ __forceinline__ u32x2 bf4(f32x4 v) { u32x2 w; w.x = pk2(v[0], v[1]); w.y = pk2(v[2], v[3]); return w; }
__device__ __forceinline__ u32x4 bf8(f32x4 a, f32x4 b) { u32x4 w; w.x = pk2(a[0], a[1]); w.y = pk2(a[2], a[3]); w.z = pk2(b[0], b[1]); w.w = pk2(b[2], b[3]); return w; }
__device__ __forceinline__ float sq4(f32x4 v) { return (v[0] * v[0] + v[1] * v[1]) + (v[2] * v[2] + v[3] * v[3]); }
__device__ __forceinline__ float red_fq(float s) { s += __shfl_xor(s, 16); s += __shfl_xor(s, 32); return s; }
__device__ __forceinline__ float sqw(unsigned w) { return bflo(w) * bflo(w) + bfhi(w) * bfhi(w); }
#define EPI_LAUNDER int fr = fr_, fq = fq_; asm volatile("" : "+v"(fr), "+v"(fq));
#define EPI_NODUP if (u.dup) return;
constexpr size_t SSOFF(int idx) { return CTL_SS_B + (size_t)idx * SS_BYTES; }

struct EpiWin {
    static constexpr bool PERM = true;
    static constexpr int NST = 16;
    __device__ __forceinline__ bool nst_ok(const pg8::Unit& u) const { return u.pn + pn0 <= 8; }
    static constexpr bool RT = true;
    __device__ __forceinline__ const unsigned char* rt_src(const pg8::Unit& u, int i) const { return ws + CTL_SS_B + (size_t)(4 * l) * SS_BYTES + ((size_t)u.pm * 256 + i * 128) * 8; }
    unsigned char* ws; int l; float sc; bool q8; int pn0;
    __device__ __forceinline__ void operator()(const AccT& acc, const pg8::Unit& u, int wr, int wc, int fr_, int fq_, const LAS unsigned char* rt) const {
        EPI_NODUP
        EPI_LAUNDER
        const int row0 = u.pm * 256 + wr * 64 + fr, pn = u.pn + pn0;
        const unsigned char* ssin = ws + CTL_SS_B + (size_t)(4 * l) * SS_BYTES;
        if (pn <= 8) {
            unsigned char* dst; int pitch, coff; unsigned char* ssacc = nullptr;
            if (pn < 3) { dst = ws + WS_S + S_CQ; pitch = QLORA; coff = pn * 256; ssacc = ws + CTL_SS_B + (size_t)(4 * l + 1) * SS_BYTES; }
            else if (pn == 3) { dst = ws + WS_S + S_CKV; pitch = 256; coff = 0; ssacc = ws + CTL_SS_B + (size_t)(4 * l + 2) * SS_BYTES; }
            else if (pn == 4) { dst = ws + WS_S + S_XP; pitch = 256; coff = 0; }
            else if (pn <= 6) { dst = ws + WS_S + S_MQK; pitch = 512; coff = (pn - 5) * 256; }
            else if (pn == 7) { dst = ws + WS_S + S_MV; pitch = 256; coff = 0; }
            else { dst = ws + WS_S + S_MO; pitch = 256; coff = 0; }
            EPI_ROWS_BEGIN_T
                const float r = rstd_of((rt ? *(const LAS u64*)(rt + (unsigned)(row - u.pm * 256) * 8u) : ldo<u64>(ssin, (unsigned)row * 8u)), 1.0f / DM) * sc; float s = 0.f;
                const unsigned ro = ((unsigned)row * (unsigned)pitch + (unsigned)(coff + wc * 32 + fq * 8)) * 2u;
#pragma unroll
                for (int bj = 0; bj < 2; ++bj) { const f32x4 v0 = acc[ai][bj][m][0] * r, v1 = acc[ai][bj][m][1] * r; s += sq4(v0) + sq4(v1);
                    if (q8 && pn <= 3) { u32x2 w; w.x = pk4_fp8(v0[0], v0[1], v0[2], v0[3]); w.y = pk4_fp8(v1[0], v1[1], v1[2], v1[3]); sto<u32x2>(dst, (ro >> 1) + bj * 128, w); }
                    else sto<u32x4>(dst, ro + bj * 256, bf8(v0, v1)); }
                if (ssacc) { s = red_fq(s); if (fq == 0) atomicAdd((u64*)(ssacc + (unsigned)row * 8u), ss_fix(s)); }
            EPI_ROWS_END
        } else {
            if (wc == 0) {
                const unsigned char* rope = ws + WS_ROPE; unsigned char* zkr = ws + WS_S + S_KR;
                EPI_ROWS_BEGIN_T
                    const float r = rstd_of((rt ? *(const LAS u64*)(rt + (unsigned)(row - u.pm * 256) * 8u) : ldo<u64>(ssin, (unsigned)row * 8u)), 1.0f / DM) * sc;
                    const f32x4 x1 = acc[ai][0][m][0] * r, x2 = acc[ai][0][m][1] * r;
                    const unsigned co = ((unsigned)rowpos(row) * 32u + fq * 4) * 4u;
                    const f32x4 c = ldo<f32x4>(rope, co), sn = ldo<f32x4>(rope, co + 64);
                    sto<u32x2>(zkr, ((unsigned)row * 32u + fq * 4) * 2u, bf4(x1 * c - x2 * sn));
                    sto<u32x2>(zkr, ((unsigned)row * 32u + 16 + fq * 4) * 2u, bf4(x2 * c + x1 * sn));
                EPI_ROWS_END
            } else if (wc == 1) {
                if (fq == 0) {
                    const f32x4 gb0 = *(const f32x4*)(inp(IN_GATE_BIAS) + l * 8), gb1 = *(const f32x4*)(inp(IN_GATE_BIAS) + l * 8 + 4); unsigned char* gates = ws + WS_S + S_GATES;
                    EPI_ROWS_BEGIN_T
                        const float r = rstd_of((rt ? *(const LAS u64*)(rt + (unsigned)(row - u.pm * 256) * 8u) : ldo<u64>(ssin, (unsigned)row * 8u)), 1.0f / DM) * sc;
                        sto<f32x4>(gates, ((unsigned)row * 8u) * 4u, acc[ai][0][m][0] * r + gb0); sto<f32x4>(gates, ((unsigned)row * 8u + 4) * 4u, acc[ai][0][m][1] * r + gb1);
                    EPI_ROWS_END
                }
            }
        }
    }
};
struct EpiQ {
    static constexpr bool PERM = true;
    static constexpr int NST = 16;
    __device__ static __forceinline__ bool nst_ok(const pg8::Unit& u) { return true; }
    static constexpr bool RT = true;
    __device__ __forceinline__ const unsigned char* rt_src(const pg8::Unit& u, int i) const { return ws + CTL_SS_B + (size_t)(4 * l + 1) * SS_BYTES + ((size_t)u.pm * 256 + i * 128) * 8; }
    unsigned char* ws; int l; float sc;
    __device__ __forceinline__ void operator()(const AccT& acc, const pg8::Unit& u, int wr, int wc, int fr_, int fq_, const LAS unsigned char* rt) const {
        EPI_LAUNDER
        const int row0 = u.pm * 256 + wr * 64 + fr, pn = u.pn;
        const unsigned char* ssin = ws + CTL_SS_B + (size_t)(4 * l + 1) * SS_BYTES; unsigned char* q = ws + WS_S + S_Q; const unsigned char* rope = ws + WS_ROPE;
        EPI_ROWS_BEGIN_T
            const float r = rstd_of((rt ? *(const LAS u64*)(rt + (unsigned)(row - u.pm * 256) * 8u) : ldo<u64>(ssin, (unsigned)row * 8u)), 1.0f / QLORA) * (QSCALE * sc);
            const unsigned ro = ((unsigned)row * 768u + (unsigned)(pn * 256 + wc * 32 + fq * 4)) * 2u;
            if (pn < 2) {
                const unsigned rw = ((unsigned)row * 768u + (unsigned)(pn * 256 + wc * 32 + fq * 8)) * 2u;
#pragma unroll
                for (int bj = 0; bj < 2; ++bj) sto<u32x4>(q, rw + bj * 256, bf8(acc[ai][bj][m][0] * r, acc[ai][bj][m][1] * r));
            } else {
                const unsigned co = ((unsigned)rowpos(row) * 32u + fq * 4) * 4u;
                const f32x4 c = ldo<f32x4>(rope, co), sn = ldo<f32x4>(rope, co + 64);
#pragma unroll
                for (int bj = 0; bj < 2; ++bj) { const f32x4 x1 = acc[ai][bj][m][0] * r, x2 = acc[ai][bj][m][1] * r;
                    sto<u32x2>(q, ro + bj * 256, bf4(x1 * c - x2 * sn)); sto<u32x2>(q, ro + bj * 256 + 32, bf4(x2 * c + x1 * sn)); }
            }
        EPI_ROWS_END
    }
};
struct EpiKV {
    static constexpr bool PERM = true;
    static constexpr int NST = 16;
    __device__ static __forceinline__ bool nst_ok(const pg8::Unit& u) { return true; }
    static constexpr bool RT = true;
    __device__ __forceinline__ const unsigned char* rt_src(const pg8::Unit& u, int i) const { return ws + CTL_SS_B + (size_t)(4 * l + 2) * SS_BYTES + ((size_t)u.pm * 256 + i * 128) * 8; }
    unsigned char* ws; int l; float sc;
    __device__ __forceinline__ void operator()(const AccT& acc, const pg8::Unit& u, int wr, int wc, int fr_, int fq_, const LAS unsigned char* rt) const {
        EPI_LAUNDER
        const int row0 = u.pm * 256 + wr * 64 + fr, pn = u.pn;
        const unsigned char* ssin = ws + CTL_SS_B + (size_t)(4 * l + 2) * SS_BYTES;
        unsigned char* dst = ws + WS_S + ((pn < 2) ? S_KN : S_V); const int coff = (pn & 1) * 256 + wc * 32 + fq * 8;
        EPI_ROWS_BEGIN_T
            const float r = rstd_of((rt ? *(const LAS u64*)(rt + (unsigned)(row - u.pm * 256) * 8u) : ldo<u64>(ssin, (unsigned)row * 8u)), 1.0f / KVLORA) * sc;
            const unsigned ro = ((unsigned)row * 512u + (unsigned)coff) * 2u;
#pragma unroll
            for (int bj = 0; bj < 2; ++bj) sto<u32x4>(dst, ro + bj * 256, bf8(acc[ai][bj][m][0] * r, acc[ai][bj][m][1] * r));
        EPI_ROWS_END
    }
};
struct EpiRes {
    static constexpr bool PERM = true;
    static constexpr int NST = 40;
    __device__ static __forceinline__ bool nst_ok(const pg8::Unit& u) { return true; }
    static constexpr bool RT = false;
    unsigned char* ws; int ssidx; float sc; bool emit8;
    __device__ __forceinline__ void operator()(const AccT& acc, const pg8::Unit& u, int wr, int wc, int fr_, int fq_, const LAS unsigned char* rt) const {
        EPI_NODUP
        EPI_LAUNDER
        const int row0 = u.pm * 256 + wr * 64 + fr, pn = u.pn;
        unsigned char* h = ws + WS_H; unsigned char* ssout = ws + CTL_SS_B + (size_t)ssidx * SS_BYTES;
        EPI_ROWS_BEGIN_T
            const unsigned ro = ((unsigned)row * (unsigned)DM + (unsigned)(pn * 256 + wc * 32 + fq * 8)) * 2u; float s = 0.f;
#pragma unroll
            for (int bj = 0; bj < 2; ++bj) {
                const u32x4 o = ldo<u32x4>(h, ro + bj * 256);
                const f32x4 a = acc[ai][bj][m][0], b = acc[ai][bj][m][1];
                const float v0 = __builtin_fmaf(a[0], sc, bflo(o.x)), v1 = __builtin_fmaf(a[1], sc, bfhi(o.x)), v2 = __builtin_fmaf(a[2], sc, bflo(o.y)), v3 = __builtin_fmaf(a[3], sc, bfhi(o.y));
                const float v4 = __builtin_fmaf(b[0], sc, bflo(o.z)), v5 = __builtin_fmaf(b[1], sc, bfhi(o.z)), v6 = __builtin_fmaf(b[2], sc, bflo(o.w)), v7 = __builtin_fmaf(b[3], sc, bfhi(o.w));
                u32x4 w; w.x = pk2(v0, v1); w.y = pk2(v2, v3); w.z = pk2(v4, v5); w.w = pk2(v6, v7);
                sto<u32x4>(h, ro + bj * 256, w);
                if (emit8) { u32x2 q; q.x = pk4_fp8(v0, v1, v2, v3); q.y = pk4_fp8(v4, v5, v6, v7); sto<u32x2>(ws + WS_H8, (ro >> 1) + bj * 128, q); }
                s = __builtin_fmaf(v0, v0, s); s = __builtin_fmaf(v1, v1, s); s = __builtin_fmaf(v2, v2, s); s = __builtin_fmaf(v3, v3, s);
                s = __builtin_fmaf(v4, v4, s); s = __builtin_fmaf(v5, v5, s); s = __builtin_fmaf(v6, v6, s); s = __builtin_fmaf(v7, v7, s);
            }
            s = red_fq(s); if (fq == 0) atomicAdd((u64*)(ssout + (unsigned)row * 8u), ss_fix(s));
        EPI_ROWS_END
    }
};
__device__ __forceinline__ f32x4 swiglu4(const f32x4 g, const f32x4 u, const float c1, const float lk, const float ik) {
    f32x4 t;
#pragma unroll
    for (int e = 0; e < 4; ++e) t[e] = fexp2(__builtin_fmaf(g[e], c1, lk));
#pragma unroll
    for (int e = 0; e < 4; ++e) t[e] = frcp(ik + t[e]);
    const f32x4 p = g * u;
    return p * t;
}
struct EpiGU {
    static constexpr bool PERM = true;
    static constexpr int NST = 8;
    __device__ static __forceinline__ bool nst_ok(const pg8::Unit& u) { return true; }
    static constexpr bool RT = true;
    __device__ __forceinline__ const unsigned char* rt_src(const pg8::Unit& u, int i) const { return ws + CTL_SS_B + (size_t)(ssidx) * SS_BYTES + ((size_t)u.pm * 256 + i * 128) * 8; }
    unsigned char* ws; int ssidx;
    __device__ __forceinline__ void operator()(const AccT& acc, const pg8::Unit& u, int wr, int wc, int fr_, int fq_, const LAS unsigned char* rt) const {
#ifdef PROBE_NOEPI
        EPI_NODUP
#endif
        EPI_LAUNDER
        const int row0 = u.pm * 256 + wr * 64 + fr, pn = u.pn;
        const unsigned char* ssin = ws + CTL_SS_B + (size_t)ssidx * SS_BYTES; unsigned char* act = ws + WS_S + S_ACT;
        EPI_ROWS_BEGIN_T
            const float r = rstd_of((rt ? *(const LAS u64*)(rt + (unsigned)(row - u.pm * 256) * 8u) : ldo<u64>(ssin, (unsigned)row * 8u)), 1.0f / DM), c1 = r * -1.4426950408889634f, lk = -2.0f * __builtin_amdgcn_logf(r), ik = frcp(r * r);
            f32x4 o[2];
#pragma unroll
            for (int n = 0; n < 2; ++n) o[n] = swiglu4(acc[ai][0][m][n], acc[ai][1][m][n], c1, lk, ik);
            sto<u32x4>(act, ((unsigned)row * (unsigned)DFF + (unsigned)(pn * 128 + wc * 32 + fq * 8)) * 2u, bf8(o[0], o[1]));
        EPI_ROWS_END
    }
};
struct EpiMoeGU {
    static constexpr bool PERM = true;
    static constexpr int NST = 0;
    __device__ static __forceinline__ bool nst_ok(const pg8::Unit& u) { return true; }
    static constexpr bool RT = false;
    unsigned char* ws; int blk0;
    __device__ __forceinline__ void operator()(const AccT& acc, const pg8::Unit& u, int wr, int wc, int fr_, int fq_, const LAS unsigned char* rt) const {
        EPI_LAUNDER
        const int row0 = wr * 64 + fr, pn = u.pn;
        const unsigned char* srstd = ws + WS_S + S_SRSTD; unsigned char* act = ws + WS_S + S_ACTE;
        EPI_ROWS_BEGIN
            const float r = ldo<float>(srstd, ((unsigned)u.pm * 256u + row) * 4u);
            f32x4 o[2];
#pragma unroll
            for (int n = 0; n < 2; ++n) { const f32x4 g = acc[ai][0][m][n] * r, uu = acc[ai][1][m][n] * r;
#pragma unroll
                for (int e = 0; e < 4; ++e) o[n][e] = siluf_(g[e]) * uu[e]; }
            sto<u32x4>(act, (((unsigned)(u.pm - blk0) * 256u + row) * (unsigned)DFFE + (unsigned)(pn * 128 + wc * 32 + fq * 8)) * 2u, bf8(o[0], o[1]));
        EPI_ROWS_END
    }
};
struct EpiMoeDown {
    static constexpr bool PERM = true;
    static constexpr int NST = 0;
    __device__ static __forceinline__ bool nst_ok(const pg8::Unit& u) { return true; }
    static constexpr bool RT = false;
    unsigned char* ws;
    __device__ __forceinline__ void operator()(const AccT& acc, const pg8::Unit& u, int wr, int wc, int fr_, int fq_, const LAS unsigned char* rt) const {
        EPI_LAUNDER
        const int row0 = wr * 64 + fr, pn = u.pn;
        const unsigned char* sslot = ws + WS_S + S_SSLOT; const unsigned char* sgate = ws + WS_S + S_SGATE; unsigned char* y = ws + WS_S + S_Y;
        EPI_ROWS_BEGIN
            const unsigned so = ((unsigned)u.pm * 256u + row) * 4u;
            const int slot = ldo<int>(sslot, so); const float g = ldo<float>(sgate, so);
            if (slot >= 0) {
                const unsigned ro = ((unsigned)slot * (unsigned)DM + (unsigned)(pn * 256 + wc * 32 + fq * 8)) * 2u;
#pragma unroll
                for (int bj = 0; bj < 2; ++bj) sto<u32x4>(y, ro + bj * 256, bf8(acc[ai][bj][m][0] * g, acc[ai][bj][m][1] * g));
            }
        EPI_ROWS_END
    }
};
struct EpiMoeGU8 {
    static constexpr bool PERM = true;
    static constexpr int NST = 8;
    __device__ static __forceinline__ bool nst_ok(const pg8::Unit& u) { return true; }
    static constexpr bool RT = false;
    unsigned char* ws; int blk0;
    __device__ __forceinline__ void operator()(const AccT& acc, const pg8::Unit& u, int wr, int wc, int fr_, int fq_, const LAS unsigned char* rt) const {
        EPI_LAUNDER
        const int row0 = wr * 64 + fr, pn = u.pn;
        unsigned char* act = ws + WS_S + S_ACTE;
        static_assert(W8_SCALE == 64.0f && ACT8_SCALE == 8.0f, "k = ACT8_SCALE / W8_SCALE^2 = 2^-9 below");
        const float c1 = -1.4426950408889634f / W8_SCALE, lk = 9.0f, ik = 512.0f;
        EPI_ROWS_BEGIN
            f32x4 o[2];
#pragma unroll
            for (int n = 0; n < 2; ++n) o[n] = swiglu4(acc[ai][0][m][n], acc[ai][1][m][n], c1, lk, ik);
            u32x2 w; w.x = pk4_fp8(o[0][0], o[0][1], o[0][2], o[0][3]); w.y = pk4_fp8(o[1][0], o[1][1], o[1][2], o[1][3]);
            sto<u32x2>(act, ((unsigned)(u.pm - blk0) * 256u + row) * (unsigned)DFFE + (unsigned)(pn * 128 + wc * 32 + fq * 8), w);
        EPI_ROWS_END
    }
};
struct EpiMoeDown8 {
    static constexpr bool PERM = true;
    static constexpr int NST = 0;
    __device__ static __forceinline__ bool nst_ok(const pg8::Unit& u) { return true; }
    static constexpr bool RT = true;
    __device__ __forceinline__ const unsigned char* rt_src(const pg8::Unit& u, int i) const { return ws + WS_S + (i == 0 ? S_SSLOT : S_SGATE) + (size_t)u.pm * 1024; }
    unsigned char* ws;
    __device__ __forceinline__ void operator()(const AccT& acc, const pg8::Unit& u, int wr, int wc, int fr_, int fq_, const LAS unsigned char* rt) const {
        EPI_LAUNDER
        const int row0 = wr * 64 + fr, pn = u.pn;
        const unsigned char* sslot = ws + WS_S + S_SSLOT; const unsigned char* sgate = ws + WS_S + S_SGATE; unsigned char* y = ws + WS_S + S_Y;
        EPI_ROWS_BEGIN
            const unsigned so = ((unsigned)u.pm * 256u + row) * 4u;
            const int slot = rt ? *(const LAS int*)(rt + (unsigned)row * 4u) : ldo<int>(sslot, so); const float g = (rt ? *(const LAS float*)(rt + 1024 + (unsigned)row * 4u) : ldo<float>(sgate, so)) * (1.0f / (W8_SCALE * ACT8_SCALE));
            if (slot >= 0) {
                const unsigned ro = ((unsigned)slot * (unsigned)DM + (unsigned)(pn * 256 + wc * 32 + fq * 8)) * 2u;
#pragma unroll
                for (int bj = 0; bj < 2; ++bj) sto<u32x4>(y, ro + bj * 256, bf8(acc[ai][bj][m][0] * g, acc[ai][bj][m][1] * g));
            }
        EPI_ROWS_END
    }
};
struct EpiGU8 {
    static constexpr bool PERM = true;
    static constexpr int NST = 8;
    __device__ static __forceinline__ bool nst_ok(const pg8::Unit& u) { return true; }
    static constexpr bool RT = true;
    __device__ __forceinline__ const unsigned char* rt_src(const pg8::Unit& u, int i) const { return ws + CTL_SS_B + (size_t)(ssidx) * SS_BYTES + ((size_t)u.pm * 256 + i * 128) * 8; }
    unsigned char* ws; int ssidx;
    __device__ __forceinline__ void operator()(const AccT& acc, const pg8::Unit& u, int wr, int wc, int fr_, int fq_, const LAS unsigned char* rt) const {
        EPI_LAUNDER
        const int row0 = u.pm * 256 + wr * 64 + fr, pn = u.pn;
        const unsigned char* ssin = ws + CTL_SS_B + (size_t)ssidx * SS_BYTES; unsigned char* act = ws + WS_S + S_ACT;
        EPI_ROWS_BEGIN_T
            const float r = rstd_of((rt ? *(const LAS u64*)(rt + (unsigned)(row - u.pm * 256) * 8u) : ldo<u64>(ssin, (unsigned)row * 8u)), 1.0f / DM) * (1.0f / W8_SCALE), c1 = r * -1.4426950408889634f;
            const float lk = -2.0f * __builtin_amdgcn_logf(r) - 3.0f, ik = frcp(r * r * ACT8_SCALE);
            f32x4 o[2];
#pragma unroll
            for (int n = 0; n < 2; ++n) o[n] = swiglu4(acc[ai][0][m][n], acc[ai][1][m][n], c1, lk, ik);
            u32x2 w; w.x = pk4_fp8(o[0][0], o[0][1], o[0][2], o[0][3]); w.y = pk4_fp8(o[1][0], o[1][1], o[1][2], o[1][3]);
            sto<u32x2>(act, (unsigned)row * (unsigned)DFF + (unsigned)(pn * 128 + wc * 32 + fq * 8), w);
        EPI_ROWS_END
    }
};
struct MixP { const bf16_t *q, *kn, *v, *kr, *xp, *mqk, *mv, *mo; const float* gates; bf16_t* cat; const float *conv_w, *conv_b, *mnorm; bool f8; };
__device__ __forceinline__ void cat_store(const MixP& P, size_t elem, const u32x4 v) {
    if (P.f8) { u32x2 w; w.x = pk4_fp8(bflo(v.x), bfhi(v.x), bflo(v.y), bfhi(v.y)); w.y = pk4_fp8(bflo(v.z), bfhi(v.z), bflo(v.w), bfhi(v.w)); *(u32x2*)((unsigned char*)P.cat + elem) = w; }
    else *(u32x4*)(P.cat + elem) = v;
}
#define MFMA32(a, b, c) __builtin_amdgcn_mfma_f32_32x32x16_bf16((a), (b), (c), 0, 0, 0)
__device__ __forceinline__ int crow(int r, int hi) { return (r & 3) + 8 * (r >> 2) + 4 * hi; }
__device__ __forceinline__ float swap_max(float m) { auto rr = __builtin_amdgcn_permlane32_swap(__float_as_uint(m), __float_as_uint(m), false, false); return fmaxf(__uint_as_float(rr[0]), __uint_as_float(rr[1])); }
__device__ __forceinline__ float swap_sum(float m) { auto rr = __builtin_amdgcn_permlane32_swap(__float_as_uint(m), __float_as_uint(m), false, false); return __uint_as_float(rr[0]) + __uint_as_float(rr[1]); }
__device__ __forceinline__ s16x4 vtr(const LAS char* p) { typedef short v4i16_t __attribute__((ext_vector_type(4))); return __builtin_bit_cast(s16x4, __builtin_amdgcn_ds_read_tr16_b64_v4i16((LAS v4i16_t*)p)); }

__device__ __forceinline__ bf16x8 pack8(const f32x16& p, int s) { u32x4 w; w.x = pk2(p[8 * s], p[8 * s + 1]); w.y = pk2(p[8 * s + 2], p[8 * s + 3]); w.z = pk2(p[8 * s + 4], p[8 * s + 5]); w.w = pk2(p[8 * s + 6], p[8 * s + 7]); return __builtin_bit_cast(bf16x8, w); }
__device__ __forceinline__ bf16x8 cat8(s16x4 lo, s16x4 hi) { return (bf16x8){lo[0], lo[1], lo[2], lo[3], hi[0], hi[1], hi[2], hi[3]}; }
template <int BASE> __device__ __forceinline__ void vtr_half(unsigned va, bf16x8& v00, bf16x8& v01, bf16x8& v10, bf16x8& v11) {
    s16x4 a0, a1, a2, a3, b0, b1, b2, b3;
    asm volatile("ds_read_b64_tr_b16 %0, %1 offset:%c2" : "=&v"(a0) : "v"(va), "i"(BASE) : "memory");
    asm volatile("ds_read_b64_tr_b16 %0, %1 offset:%c2" : "=&v"(a1) : "v"(va), "i"(BASE + 512) : "memory");
    asm volatile("ds_read_b64_tr_b16 %0, %1 offset:%c2" : "=&v"(a2) : "v"(va), "i"(BASE + 4096) : "memory");
    asm volatile("ds_read_b64_tr_b16 %0, %1 offset:%c2" : "=&v"(a3) : "v"(va), "i"(BASE + 4096 + 512) : "memory");
    asm volatile("ds_read_b64_tr_b16 %0, %1 offset:%c2" : "=&v"(b0) : "v"(va), "i"(BASE + 1024) : "memory");
    asm volatile("ds_read_b64_tr_b16 %0, %1 offset:%c2" : "=&v"(b1) : "v"(va), "i"(BASE + 1024 + 512) : "memory");
    asm volatile("ds_read_b64_tr_b16 %0, %1 offset:%c2" : "=&v"(b2) : "v"(va), "i"(BASE + 4096 + 1024) : "memory");
    asm volatile("ds_read_b64_tr_b16 %0, %1 offset:%c2" : "=&v"(b3) : "v"(va), "i"(BASE + 4096 + 1024 + 512) : "memory");
    asm volatile("s_waitcnt lgkmcnt(0)" ::: "memory");
    __builtin_amdgcn_sched_barrier(0);
    v00 = cat8(a0, a1); v01 = cat8(a2, a3); v10 = cat8(b0, b1); v11 = cat8(b2, b3);
}
__device__ __forceinline__ void kread6_issue(unsigned ae, unsigned ao, bf16x8& f0, bf16x8& f1, bf16x8& f2, bf16x8& f3, bf16x8& f4, bf16x8& f5) {
    asm volatile("ds_read_b128 %0, %1" : "=&v"(f0) : "v"(ae) : "memory");
    asm volatile("ds_read_b128 %0, %1" : "=&v"(f1) : "v"(ao) : "memory");
    asm volatile("ds_read_b128 %0, %1 offset:64" : "=&v"(f2) : "v"(ae) : "memory");
    asm volatile("ds_read_b128 %0, %1 offset:64" : "=&v"(f3) : "v"(ao) : "memory");
    asm volatile("ds_read_b128 %0, %1 offset:128" : "=&v"(f4) : "v"(ae) : "memory");
    asm volatile("ds_read_b128 %0, %1 offset:128" : "=&v"(f5) : "v"(ao) : "memory");
}
constexpr int ATT_NBUF = 4, AK_BYTES = 64 * 192, A_K0 = 0, A_V0 = ATT_NBUF * AK_BYTES, A_WS = A_V0 + ATT_NBUF * 8192, A_OST = A_WS + 8 * 256, A_END = A_OST + 8 * 4096;
static_assert(A_END <= RING_BYTES, "attention LDS");
#ifndef ATT_THR
#define ATT_THR 4.0f
#endif
constexpr size_t WS_ZERO16 = 61440;
__device__ __forceinline__ int akoff(int key, int c) { return (key * 12 + (c ^ ((key >> 2) & 3))) * 16; }

template <int VAR = 0>
__device__ __forceinline__ void attn_unit(LAS unsigned char* lds, const MixP& P, const unsigned char* ws, int tid_, int b, int hd, int qt) {
#define AEXP(x) ((VAR == 1) ? (x) * 0.001f + 0.01f : fexp2(x))
    int tid = tid_; asm volatile("" : "+v"(tid));
    const int lane = tid & 63, wid = __builtin_amdgcn_readfirstlane(tid >> 6), r32 = lane & 31, hh = lane >> 5;
    const bool meta = qt < 0;
    const int qbase = meta ? MMAIN + wid * 32 : b * SEQ + qt * 256 + wid * 32;
    const int cw = (meta || VAR == 5) ? 0 : qt * 4 + (wid >> 1) + 1, NT = (meta || VAR == 5) ? 1 : qt * 4 + 5;
    const bool active = !meta || wid == 0;
    bf16x8 qf[6];
    { const bf16_t* qr = P.q + (size_t)(qbase + r32) * 768;
#pragma unroll
      for (int d0 = 0; d0 < 4; ++d0) qf[d0] = *(const bf16x8*)(qr + hd * 64 + d0 * 16 + hh * 8);
#pragma unroll
      for (int d0 = 0; d0 < 2; ++d0) qf[4 + d0] = *(const bf16x8*)(qr + 512 + hd * 32 + d0 * 16 + hh * 8); }
    const char* src1[3]; const char* src0[3]; unsigned strd[3]; unsigned ldst[3];
#pragma unroll
    for (int i = 0; i < 3; ++i) { const int q = wid + 8 * i;
        if (q < 12) { const int s = q * 64 + lane, key = s / 12, pos = s - key * 12, c = pos ^ ((key >> 2) & 3);
            const bool nope = c < 8;
            const bf16_t* base = nope ? P.kn + hd * 64 + c * 8 : P.kr + (c - 8) * 8; const int pitch = nope ? 512 : 32;
            src1[i] = (const char*)(base + (size_t)(b * SEQ + key) * pitch); strd[i] = (unsigned)(64 * pitch * 2);
            src0[i] = key < NMETA ? (const char*)(base + (size_t)(MMAIN + key) * pitch) : (const char*)(ws + WS_ZERO16);
            ldst[i] = (unsigned)(q * 1024);
        } else { const int t = (q - 12) * 64 + lane, key = ((t >> 6) & 3) * 16 + ((t >> 2) & 15), ch = (t >> 8) * 4 + (t & 3);
            const bf16_t* base = P.v + hd * 64 + ch * 8;
            src1[i] = (const char*)(base + (size_t)(b * SEQ + key) * 512); strd[i] = 65536u;
            src0[i] = key < NMETA ? (const char*)(base + (size_t)(MMAIN + key) * 512) : (const char*)(ws + WS_ZERO16);
            ldst[i] = (unsigned)(A_V0 - 12 * 1024 + q * 1024);
        } }
    const int nmine = (wid < 4) ? 3 : 2;
    const int ksw0 = (r32 >> 2) & 3, ksw1 = ((32 + r32) >> 2) & 3;
    const unsigned ke0 = (unsigned)((r32 * 12 + (hh ^ ksw0)) * 16), ko0 = (unsigned)((r32 * 12 + ((2 + hh) ^ ksw0)) * 16);
    const unsigned ke1 = (unsigned)(((32 + r32) * 12 + (hh ^ ksw1)) * 16), ko1 = (unsigned)(((32 + r32) * 12 + ((2 + hh) ^ ksw1)) * 16);
    const unsigned ldsb = (unsigned)(uintptr_t)lds;
#define ATT_DMA(J, BSEL) do { _Pragma("unroll") for (int i_ = 0; i_ < 3; ++i_) { if (i_ < nmine) { const int q_ = wid + 8 * i_; \
        const char* g_ = ((J) == 0) ? src0[i_] : src1[i_] + (size_t)((J) - 1) * strd[i_]; \
        const unsigned l_ = ldst[i_] + (unsigned)(BSEL) * (q_ < 12 ? (unsigned)AK_BYTES : 8192u); \
        __builtin_amdgcn_global_load_lds((const unsigned*)g_, (LAS unsigned*)(lds + l_), 16, 0, 0); } } } while (0)
    f32x16 o0, o1;
#pragma unroll
    for (int i = 0; i < 16; ++i) { o0[i] = 0.f; o1[i] = 0.f; }
    float m_run = 0.f, l_run = 0.f; f32x16 negm;
#pragma unroll
    for (int i = 0; i < 16; ++i) negm[i] = 0.f;
#define ATT_NEGM() do { _Pragma("unroll") for (int i_ = 0; i_ < 16; ++i_) negm[i_] = -m_run; asm volatile("" : "+v"(negm)); } while (0)
    LAS float* wsf = (LAS float*)(lds + A_WS + wid * 256);
#define ATT_WAIT(AH) do { if ((AH) >= 2) { if (wid < 4) asm volatile("s_waitcnt vmcnt(6)" ::: "memory"); else asm volatile("s_waitcnt vmcnt(4)" ::: "memory"); } \
        else if ((AH) == 1) { if (wid < 4) asm volatile("s_waitcnt vmcnt(3)" ::: "memory"); else asm volatile("s_waitcnt vmcnt(2)" ::: "memory"); } \
        else asm volatile("s_waitcnt vmcnt(0)" ::: "memory"); } while (0)
    const bool grpB = wid >= 4;
    ATT_DMA(0, 0);
    if (NT > 1) ATT_DMA(1, 1);
    if (grpB && NT > 2) ATT_DMA(2, 2);
    { const int ah0 = grpB ? (NT > 2 ? 2 : NT - 1) : (NT > 1 ? 1 : 0); ATT_WAIT(ah0); }
    __builtin_amdgcn_s_barrier(); asm volatile("" ::: "memory");
    if (grpB) { __builtin_amdgcn_s_barrier(); asm volatile("" ::: "memory"); }
    int bcur = 0;
    bf16x8 pa0, pa1, pa2, pa3;
    const int q4 = (lane & 15) >> 2, p4 = lane & 3, blk = (lane >> 4) & 1;
    const unsigned vlane = (unsigned)((4 * hh + q4) * 64 + blk * 32 + p4 * 8);
#define ATT_PV(J1) do { const unsigned vp_ = ldsb + A_V0 + (unsigned)((bcur + 3) & 3) * 8192u + vlane; \
        if ((J1) == 0) { bf16x8 v00, v01, v10, v11; vtr_half<0>(vp_, v00, v01, v10, v11); o0 = MFMA32(pa0, v00, o0); o1 = MFMA32(pa0, v01, o1); } \
        else { { bf16x8 v00, v01, v10, v11; vtr_half<0>(vp_, v00, v01, v10, v11); o0 = MFMA32(pa0, v00, o0); o1 = MFMA32(pa0, v01, o1); o0 = MFMA32(pa1, v10, o0); o1 = MFMA32(pa1, v11, o1); } \
               { bf16x8 v00, v01, v10, v11; vtr_half<2048>(vp_, v00, v01, v10, v11); o0 = MFMA32(pa2, v00, o0); o1 = MFMA32(pa2, v01, o1); o0 = MFMA32(pa3, v10, o0); o1 = MFMA32(pa3, v11, o1); } } } while (0)
    for (int j = 0; j < NT; ++j) {
        if (!grpB && VAR != 4 && j + 2 < NT) ATT_DMA(j + 2, (bcur + 2) & 3);
        f32x16 p0, p1;
        __builtin_amdgcn_s_setprio(1);
        if (active) {
            const unsigned kb_ = ldsb + A_K0 + bcur * AK_BYTES;
            if (j <= cw) {
                if (j == 0) {
#pragma unroll
                    for (int i = 0; i < 16; ++i) p0[i] = 0.f;
                    bf16x8 a0, a1, a2, a3, a4, a5;
                    kread6_issue(kb_ + ke0, kb_ + ko0, a0, a1, a2, a3, a4, a5);
                    asm volatile("s_waitcnt lgkmcnt(0)" ::: "memory"); __builtin_amdgcn_sched_barrier(0);
                    p0 = MFMA32(a0, qf[0], p0); p0 = MFMA32(a1, qf[1], p0); p0 = MFMA32(a2, qf[2], p0); p0 = MFMA32(a3, qf[3], p0); p0 = MFMA32(a4, qf[4], p0); p0 = MFMA32(a5, qf[5], p0);
                } else {
                    bf16x8 a0, a1, a2, a3, a4, a5, b0, b1, b2, b3, b4, b5;
                    kread6_issue(kb_ + ke0, kb_ + ko0, a0, a1, a2, a3, a4, a5); kread6_issue(kb_ + ke1, kb_ + ko1, b0, b1, b2, b3, b4, b5);
                    asm volatile("s_waitcnt lgkmcnt(0)" ::: "memory"); __builtin_amdgcn_sched_barrier(0);
                    p0 = MFMA32(a0, qf[0], negm); p1 = MFMA32(b0, qf[0], negm); p0 = MFMA32(a1, qf[1], p0); p1 = MFMA32(b1, qf[1], p1); p0 = MFMA32(a2, qf[2], p0); p1 = MFMA32(b2, qf[2], p1);
                    p0 = MFMA32(a3, qf[3], p0); p1 = MFMA32(b3, qf[3], p1); p0 = MFMA32(a4, qf[4], p0); p1 = MFMA32(b4, qf[4], p1); p0 = MFMA32(a5, qf[5], p0); p1 = MFMA32(b5, qf[5], p1);
                }
            }
            if (j >= 1 && j - 1 <= cw) ATT_PV(j - 1);
        }
        __builtin_amdgcn_s_setprio(0);
        if (grpB) { const int ah = (VAR == 4) ? 0 : (j + 2 < NT) ? 1 : 0; ATT_WAIT(ah); }
        asm volatile("s_waitcnt lgkmcnt(0)" ::: "memory");
        __builtin_amdgcn_s_barrier(); asm volatile("" ::: "memory");
        if (grpB && VAR != 4 && j + 3 < NT) ATT_DMA(j + 3, (bcur + 3) & 3);
        if (active && j <= cw) {
            if (j == 0) {
                float mx = fmaxf(fmaxf(p0[0], p0[1]), fmaxf(p0[2], p0[3]));
                mx = fmaxf(mx, fmaxf(fmaxf(p0[4], p0[5]), fmaxf(p0[6], p0[7])));
                m_run = swap_max(mx); ATT_NEGM();
                float ls = 0.f;
#pragma unroll
                for (int i = 0; i < 8; ++i) { p0[i] = fexp2(p0[i] - m_run); ls += p0[i]; }
                l_run = ls;
                pa0 = pack8(p0, 0);
            } else {
                float dl0 = 0.f;
                {
                    float mx = fmaxf(p0[0], p0[1]);
#pragma unroll
                    for (int i = 2; i < 16; ++i) mx = fmaxf(mx, p0[i]);
                    mx = swap_max(mx);
                    if (__any(mx > ATT_THR)) {
                        const float dl = fmaxf(mx, 0.f), sc = fexp2(-dl);
                        m_run += dl; l_run *= sc; dl0 = dl; ATT_NEGM();
#pragma unroll
                        for (int i = 0; i < 16; ++i) p0[i] -= dl;
                        if (hh == 0) wsf[r32] = sc;
#pragma unroll
                        for (int i = 0; i < 16; ++i) { const float f = wsf[crow(i, hh)]; o0[i] *= f; o1[i] *= f; }
                    }
                    float ls = 0.f;
#pragma unroll
                    for (int i = 0; i < 16; ++i) { p0[i] = AEXP(p0[i]); ls += p0[i]; }
                    l_run += ls;
                    pa0 = pack8(p0, 0); pa1 = pack8(p0, 1);
                }
                {
                    float mx = fmaxf(p1[0], p1[1]);
#pragma unroll
                    for (int i = 2; i < 16; ++i) mx = fmaxf(mx, p1[i]);
                    mx = swap_max(mx) - dl0;
                    if (__any(dl0 > 0.f)) {
#pragma unroll
                        for (int i = 0; i < 16; ++i) p1[i] -= dl0; }
                    if (__any(mx > ATT_THR)) {
                        const float dl = fmaxf(mx, 0.f), sc = fexp2(-dl);
                        m_run += dl; l_run *= sc; ATT_NEGM();
#pragma unroll
                        for (int i = 0; i < 16; ++i) p1[i] -= dl;
                        if (hh == 0) wsf[r32] = sc;
#pragma unroll
                        for (int i = 0; i < 16; ++i) { const float f = wsf[crow(i, hh)]; o0[i] *= f; o1[i] *= f; }
#pragma unroll
                        for (int i = 0; i < 16; ++i) p0[i] *= sc;
                        pa0 = pack8(p0, 0); pa1 = pack8(p0, 1);
                    }
                    float ls = 0.f;
#pragma unroll
                    for (int i = 0; i < 16; ++i) { p1[i] = AEXP(p1[i]); ls += p1[i]; }
                    l_run += ls;
                    pa2 = pack8(p1, 0); pa3 = pack8(p1, 1);
                }
            }
        }
        if (!grpB) { const int ah = (VAR == 4) ? 0 : (j + 2 < NT) ? 1 : 0; ATT_WAIT(ah); }
        asm volatile("s_waitcnt lgkmcnt(0)" ::: "memory");
        __builtin_amdgcn_s_barrier(); asm volatile("" ::: "memory");
        bcur = (bcur + 1) & 3;
    }
    if (active && NT - 1 <= cw) ATT_PV(NT - 1);
    if (!grpB) { __builtin_amdgcn_s_barrier(); asm volatile("" ::: "memory"); }
#undef ATT_PV
#undef ATT_DMA
#undef ATT_WAIT
#undef ATT_NEGM
    if (active) {
        const float lt = swap_sum(l_run);
        if (hh == 0) wsf[32 + r32] = lt;
        LAS bf16_t* stg = (LAS bf16_t*)(lds + A_OST + wid * 4096);
#pragma unroll
        for (int i = 0; i < 16; ++i) { const int orow = crow(i, hh); const float rl = frcp(wsf[32 + orow]);
            stg[orow * 64 + r32] = (bf16_t)f2bf(o0[i] * rl); stg[orow * 64 + 32 + r32] = (bf16_t)f2bf(o1[i] * rl); }
        const int nvalid = meta ? 16 : 32;
#pragma unroll
        for (int it = 0; it < 4; ++it) { const int row = it * 8 + (lane >> 3), ch = lane & 7; const u32x4 val = *(const LAS u32x4*)(stg + row * 64 + ch * 8);
            if (row < nvalid) cat_store(P, (size_t)(qbase + row) * DM + hd * 64 + ch * 8, val); }
    }
    asm volatile("s_waitcnt vmcnt(0) lgkmcnt(0)" ::: "memory");
    __builtin_amdgcn_s_barrier(); asm volatile("" ::: "memory");
#undef AEXP
}

template <int W> __device__ __forceinline__ void pool_piece(const MixP& P, int b, int pos, int ch) {
    const int cnt = (pos + 1 < W) ? pos + 1 : W; const float inv = 1.0f / (float)cnt;
    u32x4 x[W];
#pragma unroll
    for (int jj = 0; jj < W; ++jj) { const u32x4 z = {0u, 0u, 0u, 0u}; x[jj] = z; if (jj < cnt) x[jj] = *(const u32x4*)(P.xp + (size_t)seqrow(b, pos - jj) * 256 + ch); }
    float a[8];
#pragma unroll
    for (int e = 0; e < 8; ++e) a[e] = 0.f;
#pragma unroll
    for (int jj = 0; jj < W; ++jj) { a[0] += bflo(x[jj].x); a[1] += bfhi(x[jj].x); a[2] += bflo(x[jj].y); a[3] += bfhi(x[jj].y); a[4] += bflo(x[jj].z); a[5] += bfhi(x[jj].z); a[6] += bflo(x[jj].w); a[7] += bfhi(x[jj].w); }
    const u32x4 self = x[0]; u32x4 o;
    o.x = pk2(a[0] * inv - bflo(self.x), a[1] * inv - bfhi(self.x)); o.y = pk2(a[2] * inv - bflo(self.y), a[3] * inv - bfhi(self.y));
    o.z = pk2(a[4] * inv - bflo(self.z), a[5] * inv - bfhi(self.z)); o.w = pk2(a[6] * inv - bflo(self.w), a[7] * inv - bfhi(self.w));
    cat_store(P, (size_t)seqrow(b, pos) * DM + 512 + ch, o);
}
__device__ __forceinline__ void pool_unit(const MixP& P, int tid_, int b, int grp) {
    int tid = tid_; asm volatile("" : "+v"(tid));
    const int t = tid & 63, pq = tid >> 6;
    const int pos = (grp == 0) ? t : NMETA + 64 * (grp - 1) + t;
    if (grp == 0 && t >= NMETA) return;
#pragma unroll
    for (int k = 0; k < 4; ++k) { const int piece = pq * 4 + k, ch = piece * 8, g = pq >> 1;
        if (g == 0) pool_piece<2>(P, b, pos, ch); else if (g == 1) pool_piece<4>(P, b, pos, ch); else if (g == 2) pool_piece<8>(P, b, pos, ch); else pool_piece<16>(P, b, pos, ch); }
}

constexpr int MLP = 144, ML_IMGB = 3 * 64 * MLP + 8192;
constexpr int ML_CB = 2 * ML_IMGB, ML_N = ML_CB + 2 * 64 * MLP, ML_H = ML_N + 512, ML_WSF = ML_H + 2 * 16384, ML_CW = ML_WSF + 1024, ML_END = ML_CW + 2560;
static_assert(ML_END <= RING_BYTES, "mLSTM LDS");
__device__ __forceinline__ float log_sigmoid_(float x) { return fminf(x, 0.f) - __logf(1.0f + __expf(-fabsf(x))); }
template <int CTRL, int ROWMASK> __device__ __forceinline__ float dpp_id(float v, float ident) {
    return __builtin_bit_cast(float, __builtin_amdgcn_update_dpp(__builtin_bit_cast(int, ident), __builtin_bit_cast(int, v), CTRL, ROWMASK, 0xf, false)); }
__device__ __forceinline__ float scan_add(float x, int lane) {
    (void)lane;
    x += dpp_id<0x111, 0xf>(x, 0.f); x += dpp_id<0x112, 0xf>(x, 0.f); x += dpp_id<0x114, 0xf>(x, 0.f); x += dpp_id<0x118, 0xf>(x, 0.f);
    x += dpp_id<0x142, 0xa>(x, 0.f); x += dpp_id<0x143, 0xc>(x, 0.f);
    return x; }
__device__ __forceinline__ float scan_max(float x, int lane) {
    (void)lane; const float ni = -3.0e38f;
    x = fmaxf(x, dpp_id<0x111, 0xf>(x, ni)); x = fmaxf(x, dpp_id<0x112, 0xf>(x, ni)); x = fmaxf(x, dpp_id<0x114, 0xf>(x, ni)); x = fmaxf(x, dpp_id<0x118, 0xf>(x, ni));
    x = fmaxf(x, dpp_id<0x142, 0xa>(x, ni)); x = fmaxf(x, dpp_id<0x143, 0xc>(x, ni));
    return x; }

__device__ __forceinline__ void mlstm_unit(LAS unsigned char* lds, const MixP& P, int tid_, int b, int hd) {
    int tid = tid_; asm volatile("" : "+v"(tid));
    const int lane = tid & 63, wid = __builtin_amdgcn_readfirstlane(tid >> 6), r32 = lane & 31, hh = lane >> 5;
    const int q4 = (lane & 15) >> 2, p4 = lane & 3, blk = (lane >> 4) & 1;
    const int ts = tid >> 3, tj = tid & 7;
    LAS float* nst = (LAS float*)(lds + ML_N); LAS float* hbuf = (LAS float*)(lds + ML_H); LAS float* wsf = (LAS float*)(lds + ML_WSF + (wid & 3) * 256);
    LAS float* cwl = (LAS float*)(lds + ML_CW);
    if (wid >= 4) __builtin_amdgcn_s_setprio(1);
    for (int i = tid; i < 640; i += 512) { const int tap = i >> 7, ch = i & 127; const int gc = (ch < 64) ? hd * 64 + ch : 256 + hd * 64 + (ch - 64);
        cwl[i] = (tap < 4) ? P.conv_w[tap * 512 + gc] : P.conv_b[gc]; }
    for (int i = tid; i < 64 * MLP / 4; i += 512) ((LAS unsigned*)(lds + ML_CB))[i] = 0u;
    if (tid < 64) nst[tid] = 0.f;
    f32x16 Cacc;
#pragma unroll
    for (int i = 0; i < 16; ++i) Cacc[i] = 0.f;
    float m = 0.f;
    float rf = 0.f, em = 0.f, cd = 0.f;
    const int gcol = (tj < 4) ? hd * 64 + tj * 16 : 256 + hd * 64 + (tj - 4) * 16;
    __syncthreads();
    u32x4 xt[4][2], xv, xmo = {0u, 0u, 0u, 0u}, xmo_n = {0u, 0u, 0u, 0u}; float gi = 0.f, gf = 0.f;
    const f32x4 ng0 = *(const f32x4*)(P.mnorm + hd * 64 + tj * 8), ng1 = *(const f32x4*)(P.mnorm + hd * 64 + tj * 8 + 4);
#define ML_LOAD(cn) do { const int pos0n = ((cn) == 0) ? 0 : NMETA + 64 * ((cn) - 1); const int pos = pos0n + ts; \
        _Pragma("unroll") for (int tap = 0; tap < 4; ++tap) { const int pp = pos - 3 + tap; const u32x4 z4 = {0u, 0u, 0u, 0u}; xt[tap][0] = z4; xt[tap][1] = z4; \
            if (pp >= 0) { const bf16_t* src = P.mqk + (size_t)seqrow(b, pp) * 512 + gcol; xt[tap][0] = *(const u32x4*)src; xt[tap][1] = *(const u32x4*)(src + 8); } } \
        xv = *(const u32x4*)(P.mv + (size_t)seqrow(b, pos) * 256 + hd * 64 + tj * 8); xmo_n = *(const u32x4*)(P.mo + (size_t)seqrow(b, pos) * 256 + hd * 64 + tj * 8); \
        { const int rl = seqrow(b, pos0n + lane); gi = P.gates[(size_t)rl * 8 + hd]; gf = P.gates[(size_t)rl * 8 + 4 + hd]; } } while (0)
#define ML_PHASE1(cn) do { const bool vld = ((cn) > 0) || lane < NMETA; const float lf = vld ? log_sigmoid_(gf) : 0.f, li = vld ? gi : -1e30f; \
        const float bs = scan_add(lf, lane), as = li - bs, pm = scan_max(as, lane), Mt = fmaxf(m, pm); \
        const float M63 = __shfl(Mt, 63), Bt = __shfl(bs, 63); \
        const float wgv = __expf(as - M63), decv = __expf(m - Mt); \
        rf_n = __expf(fminf(M63 - Mt, 80.f)); em_n = __expf(-(bs + Mt)); cd_n = __expf(m - M63); m_n = Bt + M63; \
        const float wg_s = __shfl(wgv, ts), dec_s = __shfl(decv, ts); \
        float yv[16]; \
        _Pragma("unroll") for (int e = 0; e < 16; ++e) yv[e] = cwl[512 + tj * 16 + e]; \
        _Pragma("unroll") for (int tap = 0; tap < 4; ++tap) { const LAS float* wr_ = cwl + tap * 128 + tj * 16; \
            _Pragma("unroll") for (int hx = 0; hx < 2; ++hx) { const u32x4 xx = xt[tap][hx]; \
                yv[8 * hx + 0] += wr_[8 * hx + 0] * bflo(xx.x); yv[8 * hx + 1] += wr_[8 * hx + 1] * bfhi(xx.x); yv[8 * hx + 2] += wr_[8 * hx + 2] * bflo(xx.y); yv[8 * hx + 3] += wr_[8 * hx + 3] * bfhi(xx.y); \
                yv[8 * hx + 4] += wr_[8 * hx + 4] * bflo(xx.z); yv[8 * hx + 5] += wr_[8 * hx + 5] * bfhi(xx.z); yv[8 * hx + 6] += wr_[8 * hx + 6] * bflo(xx.w); yv[8 * hx + 7] += wr_[8 * hx + 7] * bfhi(xx.w); } } \
        _Pragma("unroll") for (int e = 0; e < 16; ++e) yv[e] = siluf_(yv[e]); \
        LAS unsigned char* In = lds + ((cn) & 1) * ML_IMGB; \
        if (tj < 4) { \
            u32x4 w0, w1; w0.x = pk2(yv[0], yv[1]); w0.y = pk2(yv[2], yv[3]); w0.z = pk2(yv[4], yv[5]); w0.w = pk2(yv[6], yv[7]); w1.x = pk2(yv[8], yv[9]); w1.y = pk2(yv[10], yv[11]); w1.z = pk2(yv[12], yv[13]); w1.w = pk2(yv[14], yv[15]); \
            *(LAS u32x4*)(In + ts * MLP + tj * 32) = w0; *(LAS u32x4*)(In + ts * MLP + tj * 32 + 16) = w1; \
            w0.x = pk2(yv[0] * dec_s, yv[1] * dec_s); w0.y = pk2(yv[2] * dec_s, yv[3] * dec_s); w0.z = pk2(yv[4] * dec_s, yv[5] * dec_s); w0.w = pk2(yv[6] * dec_s, yv[7] * dec_s); \
            w1.x = pk2(yv[8] * dec_s, yv[9] * dec_s); w1.y = pk2(yv[10] * dec_s, yv[11] * dec_s); w1.z = pk2(yv[12] * dec_s, yv[13] * dec_s); w1.w = pk2(yv[14] * dec_s, yv[15] * dec_s); \
            *(LAS u32x4*)(In + 64 * MLP + ts * MLP + tj * 32) = w0; *(LAS u32x4*)(In + 64 * MLP + ts * MLP + tj * 32 + 16) = w1; \
        } else { const float kk = 0.125f * wg_s; \
            u32x4 w0, w1; w0.x = pk2(yv[0] * kk, yv[1] * kk); w0.y = pk2(yv[2] * kk, yv[3] * kk); w0.z = pk2(yv[4] * kk, yv[5] * kk); w0.w = pk2(yv[6] * kk, yv[7] * kk); \
            w1.x = pk2(yv[8] * kk, yv[9] * kk); w1.y = pk2(yv[10] * kk, yv[11] * kk); w1.z = pk2(yv[12] * kk, yv[13] * kk); w1.w = pk2(yv[14] * kk, yv[15] * kk); \
            *(LAS u32x4*)(In + 128 * MLP + ts * MLP + (tj - 4) * 32) = w0; *(LAS u32x4*)(In + 128 * MLP + ts * MLP + (tj - 4) * 32 + 16) = w1; } \
        *(LAS u32x4*)(In + 192 * MLP + (tj >> 2) * 4096 + (ts >> 4) * 1024 + (ts & 15) * 64 + (tj & 3) * 16) = xv; } while (0)
    float rf_n, em_n, cd_n, m_n;
    ML_LOAD(0); ML_PHASE1(0);
    u32x4 xmo_c = xmo_n;
    rf = rf_n; em = em_n; cd = cd_n; const float m0n = m_n; float m_after = m0n;
    __syncthreads();
    for (int c = 0; c <= 32; ++c) {
        const bool more = c < 32;
        if (more) ML_LOAD(c + 1);
        const LAS unsigned char* I = lds + (c & 1) * ML_IMGB; const LAS unsigned char* Qi = I; const LAS unsigned char* Qdi = I + 64 * MLP; const LAS unsigned char* Kwi = I + 128 * MLP; const LAS char* Vi = (const LAS char*)(I + 192 * MLP);
        if (wid < 4) {
            const int tb = wid & 1, vb = wid >> 1, t = 32 * tb + r32;
            const LAS unsigned char* Cb = lds + ML_CB + (c & 1) * 64 * MLP; const LAS float* nb = nst + (c & 1) * 64;
            bf16x8 qf[4];
#pragma unroll
            for (int d0 = 0; d0 < 4; ++d0) qf[d0] = *(const LAS bf16x8*)(Qi + t * MLP + (2 * d0 + hh) * 16);
            f32x16 p0, p1;
#pragma unroll
            for (int i = 0; i < 16; ++i) { p0[i] = 0.f; p1[i] = 0.f; }
#pragma unroll
            for (int d0 = 0; d0 < 4; ++d0) p0 = MFMA32(*(const LAS bf16x8*)(Kwi + r32 * MLP + (2 * d0 + hh) * 16), qf[d0], p0);
            if (tb == 1) {
#pragma unroll
                for (int d0 = 0; d0 < 4; ++d0) p1 = MFMA32(*(const LAS bf16x8*)(Kwi + (32 + r32) * MLP + (2 * d0 + hh) * 16), qf[d0], p1);
            }
            const float rf_t = __shfl(rf, t), em_t = __shfl(em, t);
            float ds = 0.f;
            if (tb == 0) {
#pragma unroll
                for (int i = 0; i < 16; ++i) { p0[i] = (crow(i, hh) <= r32) ? p0[i] * rf_t : 0.f; ds += p0[i]; }
            } else {
#pragma unroll
                for (int i = 0; i < 16; ++i) { p0[i] *= rf_t; p1[i] = (crow(i, hh) <= r32) ? p1[i] * rf_t : 0.f; ds += p0[i] + p1[i]; }
            }
            float nq = 0.f;
#pragma unroll
            for (int c4 = 0; c4 < 4; ++c4) { const u32x4 qd = *(const LAS u32x4*)(Qdi + t * MLP + (hh * 4 + c4) * 16); const f32x4 n0 = *(const LAS f32x4*)(nb + 32 * hh + 8 * c4), n1 = *(const LAS f32x4*)(nb + 32 * hh + 8 * c4 + 4);
                nq += bflo(qd.x) * n0[0] + bfhi(qd.x) * n0[1] + bflo(qd.y) * n0[2] + bfhi(qd.y) * n0[3] + bflo(qd.z) * n1[0] + bfhi(qd.z) * n1[1] + bflo(qd.w) * n1[2] + bfhi(qd.w) * n1[3]; }
            const float den = swap_sum(ds + nq);
            const float nrm = 1.0f / fmaxf(fabsf(den), em_t);
            if (hh == 0) wsf[r32] = nrm;
            f32x16 O;
#pragma unroll
            for (int i = 0; i < 16; ++i) O[i] = 0.f;
            const LAS char* vp = Vi + vb * 4096 + (4 * hh + q4) * 64 + blk * 32 + p4 * 8;
#pragma unroll
            for (int ks = 0; ks < 2; ++ks) O = MFMA32(pack8(p0, ks), cat8(vtr(vp + ks * 1024), vtr(vp + ks * 1024 + 512)), O);
            if (tb == 1) {
#pragma unroll
                for (int ks = 0; ks < 2; ++ks) O = MFMA32(pack8(p1, ks), cat8(vtr(vp + (2 + ks) * 1024), vtr(vp + (2 + ks) * 1024 + 512)), O);
            }
#pragma unroll
            for (int ks = 0; ks < 4; ++ks) O = MFMA32(*(const LAS bf16x8*)(Qdi + t * MLP + (2 * ks + hh) * 16), *(const LAS bf16x8*)(Cb + (32 * vb + r32) * MLP + (2 * ks + hh) * 16), O);
            LAS float* hb = hbuf + (c & 1) * 4096;
#pragma unroll
            for (int i = 0; i < 16; ++i) hb[(32 * tb + crow(i, hh)) * 64 + 32 * vb + r32] = O[i] * wsf[crow(i, hh)];
        } else {
            const int w2 = wid - 4, vb = w2 >> 1, kb = w2 & 1;
#pragma unroll
            for (int i = 0; i < 16; ++i) Cacc[i] *= cd;
#pragma unroll
            for (int ks = 0; ks < 4; ++ks) {
                const LAS char* va = Vi + vb * 4096 + ks * 1024 + (8 * hh + q4) * 64 + blk * 32 + p4 * 8;
                const LAS char* ka = (const LAS char*)Kwi + (16 * ks + 8 * hh + q4) * MLP + (32 * kb + 16 * blk) * 2 + p4 * 8;
                Cacc = MFMA32(cat8(vtr(va), vtr(va + 256)), cat8(vtr(ka), vtr(ka + 4 * MLP)), Cacc);
            }
            LAS unsigned char* Cn = lds + ML_CB + ((c + 1) & 1) * 64 * MLP;
#pragma unroll
            for (int i = 0; i < 16; ++i) *(LAS bf16_t*)(Cn + (32 * vb + crow(i, hh)) * MLP + (32 * kb + r32) * 2) = (bf16_t)f2bf(Cacc[i]);
            if (wid == 4) { float a = cd * nst[(c & 1) * 64 + lane];
#pragma unroll 8
                for (int s = 0; s < 64; ++s) a += bf2f(*(const LAS bf16_t*)(Kwi + s * MLP + lane * 2));
                nst[((c + 1) & 1) * 64 + lane] = a; }
        }
#define ML_NORMPASS(cc) do { const int pos = ((cc) == 0) ? ts : NMETA + 64 * ((cc) - 1) + ts; const bool ok = ((cc) > 0) || (ts < NMETA && b == 0); \
            const LAS float* hp = hbuf + ((cc) & 1) * 4096 + ts * 64 + tj * 8; const f32x4 x0 = *(const LAS f32x4*)hp, x1 = *(const LAS f32x4*)(hp + 4); \
            float ss = sq4(x0) + sq4(x1); ss += __shfl_xor(ss, 1); ss += __shfl_xor(ss, 2); ss += __shfl_xor(ss, 4); \
            const float r = rsqrtf(ss * (1.0f / 64.0f) + EPS); \
            if (ok) { const int row = seqrow(b, pos); const u32x4 mo = xmo; const f32x4 g0 = ng0, g1 = ng1; u32x4 o; \
                o.x = pk2(x0[0] * r * g0[0] * sigmoidf_(bflo(mo.x)), x0[1] * r * g0[1] * sigmoidf_(bfhi(mo.x))); o.y = pk2(x0[2] * r * g0[2] * sigmoidf_(bflo(mo.y)), x0[3] * r * g0[3] * sigmoidf_(bfhi(mo.y))); \
                o.z = pk2(x1[0] * r * g1[0] * sigmoidf_(bflo(mo.z)), x1[1] * r * g1[1] * sigmoidf_(bfhi(mo.z))); o.w = pk2(x1[2] * r * g1[2] * sigmoidf_(bflo(mo.w)), x1[3] * r * g1[3] * sigmoidf_(bfhi(mo.w))); \
                cat_store(P, (size_t)row * DM + 768 + hd * 64 + tj * 8, o); } } while (0)
        if (c > 0) ML_NORMPASS(c - 1);
        if (more) { m = m_after; ML_PHASE1(c + 1); m_after = m_n; }
        __syncthreads();
        if (more) { rf = rf_n; em = em_n; cd = cd_n; }
        xmo = xmo_c; xmo_c = xmo_n;
    }
    ML_NORMPASS(32);
    __builtin_amdgcn_s_setprio(0);
    __syncthreads();
#undef ML_LOAD
#undef ML_PHASE1
#undef ML_NORMPASS
}
constexpr int R1_GR = 0, R1_E = 32768, R1_LP = R1_E + 2048, R1_G = R1_LP + 2048, R1_CNT = R1_G + 2048, R1_BASE = R1_CNT + 64, R1_END = R1_BASE + 64;
__device__ __forceinline__ void moe_route(const Ctx& X, int l) {
    const int lm = l >> 1, tid = X.tid, lane = X.lane, wid = X.wave;
    LAS float* gr = (LAS float*)(X.lds + R1_GR); LAS int* le = (LAS int*)(X.lds + R1_E); LAS int* lp = (LAS int*)(X.lds + R1_LP); LAS float* lg = (LAS float*)(X.lds + R1_G);
    LAS unsigned* lcnt = (LAS unsigned*)(X.lds + R1_CNT); LAS unsigned* lbase = (LAS unsigned*)(X.lds + R1_BASE);
    const float* grg = (const float*)(X.ws + WS_ROUTER) + (size_t)lm * DM * NEXP;
    for (int i = tid; i < DM * NEXP; i += 512) gr[i] = grg[i];
    { int* stok = (int*)(X.ws + WS_S + S_STOK); int* sslot = (int*)(X.ws + WS_S + S_SSLOT); float* sgate = (float*)(X.ws + WS_S + S_SGATE); float* srstd = (float*)(X.ws + WS_S + S_SRSTD);
      for (int i = X.bid * 512 + tid; i < MOE_RCAP; i += X.G * 512) { stok[i] = 0; sslot[i] = -1; sgate[i] = 0.f; srstd[i] = 0.f; } }
    const bf16_t* h = (const bf16_t*)(X.ws + WS_H); const u64* ssf = X.ss(4 * l + 3);
    unsigned* gcnt = (unsigned*)(X.ws + CTL_MOECNT_B) + (size_t)lm * 8 * 64;
    int* ae = (int*)(X.ws + WS_S + S_AE); int* apos = (int*)(X.ws + WS_S + S_APOS); float* agate = (float*)(X.ws + WS_S + S_AGATE);
    for (int p = X.bid; p < NPANEL; p += X.G) {
        if (tid < 8) lcnt[tid] = 0u;
        __syncthreads();
        for (int rr = 0; rr < 32; rr += 4) {
            const int r0 = wid * 32 + rr, row0 = p * 256 + r0;
            if (row0 >= MREAL) break;
            u32x4 xa[4][2];
#pragma unroll
            for (int q = 0; q < 4; ++q) { xa[q][0] = *(const u32x4*)(h + (size_t)(row0 + q) * DM + lane * 16); xa[q][1] = *(const u32x4*)(h + (size_t)(row0 + q) * DM + lane * 16 + 8); }
            float lg8[4][8];
#pragma unroll
            for (int q = 0; q < 4; ++q)
#pragma unroll
                for (int e = 0; e < 8; ++e) lg8[q][e] = 0.f;
#pragma unroll
            for (int k = 0; k < 16; ++k) { const f32x4 w0 = *(const LAS f32x4*)(gr + (lane * 16 + k) * 8), w1 = *(const LAS f32x4*)(gr + (lane * 16 + k) * 8 + 4);
#pragma unroll
                for (int q = 0; q < 4; ++q) { const unsigned wd = (k & 8) ? ((k & 6) == 0 ? xa[q][1].x : (k & 6) == 2 ? xa[q][1].y : (k & 6) == 4 ? xa[q][1].z : xa[q][1].w) : ((k & 6) == 0 ? xa[q][0].x : (k & 6) == 2 ? xa[q][0].y : (k & 6) == 4 ? xa[q][0].z : xa[q][0].w);
                    const float xv = (k & 1) ? bfhi(wd) : bflo(wd);
                    lg8[q][0] += xv * w0[0]; lg8[q][1] += xv * w0[1]; lg8[q][2] += xv * w0[2]; lg8[q][3] += xv * w0[3]; lg8[q][4] += xv * w1[0]; lg8[q][5] += xv * w1[1]; lg8[q][6] += xv * w1[2]; lg8[q][7] += xv * w1[3]; } }
#pragma unroll
            for (int o = 1; o < 64; o <<= 1)
#pragma unroll
                for (int q = 0; q < 4; ++q)
#pragma unroll
                    for (int e = 0; e < 8; ++e) lg8[q][e] += __shfl_xor(lg8[q][e], o);
#pragma unroll
            for (int q = 0; q < 4; ++q) {
                const int r = r0 + q; const float rs = rstd_of(ssf[row0 + q], 1.0f / DM);
                int i0 = 0; float v0 = lg8[q][0] * rs;
#pragma unroll
                for (int e = 1; e < 8; ++e) if (lg8[q][e] * rs > v0) { v0 = lg8[q][e] * rs; i0 = e; }
                int i1 = -1; float v1 = -3.0e38f;
#pragma unroll
                for (int e = 0; e < 8; ++e) if (e != i0 && lg8[q][e] * rs > v1) { v1 = lg8[q][e] * rs; i1 = e; }
                if (i1 < 0) { i1 = (i0 == 0) ? 1 : 0; v1 = v0; }
                if (lane == 0) { const float ex = __expf(v1 - v0), g0 = 1.0f / (1.0f + ex);
                    le[r * 2] = i0; le[r * 2 + 1] = i1; lg[r * 2] = g0; lg[r * 2 + 1] = ex * g0;
                    lp[r * 2] = (int)__hip_atomic_fetch_add(&lcnt[i0], 1u, __ATOMIC_RELAXED, __HIP_MEMORY_SCOPE_WORKGROUP); lp[r * 2 + 1] = (int)__hip_atomic_fetch_add(&lcnt[i1], 1u, __ATOMIC_RELAXED, __HIP_MEMORY_SCOPE_WORKGROUP); }
            }
        }
        __syncthreads();
        if (tid < 8) lbase[tid] = atomicAdd(gcnt + tid * 64, lcnt[tid]);
        __syncthreads();
        if (tid < 256 && p * 256 + tid < MREAL) { const int row = p * 256 + tid;
#pragma unroll
            for (int k = 0; k < 2; ++k) { const int e = le[tid * 2 + k]; ae[row * 2 + k] = e; apos[row * 2 + k] = (int)lbase[e] + lp[tid * 2 + k]; agate[row * 2 + k] = lg[tid * 2 + k]; } }
        __syncthreads();
    }
}
__device__ __forceinline__ void moe_scatter(const Ctx& X, int l) {
    const int lm = l >> 1, tid = X.tid;
    const unsigned* gcnt = (const unsigned*)(X.ws + CTL_MOECNT_B) + (size_t)lm * 8 * 64;
    int pstart[8]; int acc = 0;
#pragma unroll
    for (int e = 0; e < 8; ++e) { const int c = (int)__hip_atomic_load(gcnt + e * 64, __ATOMIC_RELAXED, __HIP_MEMORY_SCOPE_AGENT); pstart[e] = acc; acc += ((c + 255) >> 8) << 8; }
    const int nblk = acc >> 8;
    int* minfo = (int*)(X.ws + WS_S + S_MINFO);
    if (X.bid == 0) { if (tid == 0) minfo[0] = nblk;
        for (int blk = tid; blk < nblk; blk += 512) { int e = 0;
#pragma unroll
            for (int k = 1; k < 8; ++k) if (blk * 256 >= pstart[k]) e = k;
            minfo[16 + blk] = e; } }
    int* stok = (int*)(X.ws + WS_S + S_STOK); int* sslot = (int*)(X.ws + WS_S + S_SSLOT); float* sgate = (float*)(X.ws + WS_S + S_SGATE); float* srstd = (float*)(X.ws + WS_S + S_SRSTD);
    const int* ae = (const int*)(X.ws + WS_S + S_AE); const int* apos = (const int*)(X.ws + WS_S + S_APOS); const float* agate = (const float*)(X.ws + WS_S + S_AGATE);
    const u64* ssf = X.ss(4 * l + 3);
    for (int a = X.bid * 512 + tid; a < MOE_NASG; a += X.G * 512) {
        const int e = ae[a]; int ps = 0;
#pragma unroll
        for (int k = 0; k < 8; ++k) if (k == e) ps = pstart[k];
        const int dest = ps + apos[a], row = a >> 1;
        stok[dest] = row; sslot[dest] = a; sgate[dest] = agate[a]; srstd[dest] = rstd_of(ssf[row], 1.0f / DM);
        ((int*)(X.ws + WS_S + S_ALATE))[a] = dest >= MOE_LATE_LIM ? 1 : 0;
    }
    if (MOE_F8(l)) {
        const bf16_t* h = (const bf16_t*)(X.ws + WS_H); unsigned char* xs8 = X.ws + WS_XS8;
        const int gw = X.bid * 8 + X.wave, NGW = X.G * 8, lane = X.lane;
        for (int t0 = gw; t0 < MREAL; t0 += 4 * NGW) {
            u32x4 x[4][2]; int d0[4], d1[4]; float rq[4];
#pragma unroll
            for (int q = 0; q < 4; ++q) { const int row = t0 + q * NGW; d0[q] = -1; d1[q] = -1; rq[q] = 0.f; const u32x4 z = {0u, 0u, 0u, 0u}; x[q][0] = z; x[q][1] = z;
                if (row < MREAL) { const int e0 = __builtin_amdgcn_readfirstlane(ae[2 * row]), e1 = __builtin_amdgcn_readfirstlane(ae[2 * row + 1]); int p0 = 0, p1 = 0;
#pragma unroll
                    for (int k = 0; k < 8; ++k) { if (k == e0) p0 = pstart[k]; if (k == e1) p1 = pstart[k]; }
                    d0[q] = p0 + __builtin_amdgcn_readfirstlane(apos[2 * row]); d1[q] = p1 + __builtin_amdgcn_readfirstlane(apos[2 * row + 1]); rq[q] = rstd_of(ssf[row], 1.0f / DM);
                    x[q][0] = __builtin_nontemporal_load((const u32x4*)(h + (size_t)row * DM + lane * 16)); x[q][1] = __builtin_nontemporal_load((const u32x4*)(h + (size_t)row * DM + lane * 16 + 8)); } }
#pragma unroll
            for (int q = 0; q < 4; ++q) if (d0[q] >= 0) { const float r = rq[q]; u32x4 w;
                w.x = pk4_fp8(bflo(x[q][0].x) * r, bfhi(x[q][0].x) * r, bflo(x[q][0].y) * r, bfhi(x[q][0].y) * r); w.y = pk4_fp8(bflo(x[q][0].z) * r, bfhi(x[q][0].z) * r, bflo(x[q][0].w) * r, bfhi(x[q][0].w) * r);
                w.z = pk4_fp8(bflo(x[q][1].x) * r, bfhi(x[q][1].x) * r, bflo(x[q][1].y) * r, bfhi(x[q][1].y) * r); w.w = pk4_fp8(bflo(x[q][1].z) * r, bfhi(x[q][1].z) * r, bflo(x[q][1].w) * r, bfhi(x[q][1].w) * r);
                *(u32x4*)(xs8 + (size_t)d0[q] * DM + lane * 16) = w; *(u32x4*)(xs8 + (size_t)d1[q] * DM + lane * 16) = w; }
        }
    }
}
struct MoeOrder {
    int blk_lo, nb, nN, G, c; const char* A; const char* W; size_t tstepA, tstepB; const int* stok; const int* bexp; bool gather; size_t estride;
    __device__ __forceinline__ bool next(int i, pg8::Unit& u) const {
        u.dup = false;
        const bool xo = (G == 256);
        const int nbs = xo ? ((nb >> 6) << 6) : 0, gq = nbs >> 6, pgn = nN >> 2, Rs = gq * pgn, x = c & 7, j = c >> 3;
        if (i < Rs) { const int q = (i >= pgn ? 1 : 0) + (i >= 2 * pgn ? 1 : 0) + (i >= 3 * pgn ? 1 : 0), pg = i - q * pgn; u.pm = blk_lo + (x + 8 * q) * 8 + (j & 7); u.pn = pg * 4 + (j >> 3); return true; }
        const int rem = nb - nbs; int L = (i - Rs) * G + c; if (L >= rem * nN) return false;
        int pn = 0; while (L >= rem) { L -= rem; ++pn; }
        u.pn = pn; u.pm = blk_lo + nbs + L; return true;
    }
    __device__ __forceinline__ const char* a_ptr(const pg8::Unit& u) const { return gather ? A : A + (size_t)(u.pm - blk_lo) * tstepA; }
    __device__ __forceinline__ const char* b_ptr(const pg8::Unit& u) const { const int e = __builtin_amdgcn_readfirstlane(bexp[u.pm]); return W + (size_t)e * estride + (size_t)u.pn * tstepB; }
    __device__ __forceinline__ int a_row(const pg8::Unit& u, int r) const { return stok[(size_t)u.pm * 256 + r]; }
    __device__ __forceinline__ const int* a_row_ptr(const pg8::Unit& u, int r) const { return stok + (size_t)u.pm * 256 + r; }
};
__device__ __forceinline__ void combine_rows(const Ctx& X, int l, const int r0, const int r1) {
    const bool lastl = (l == DEPTH - 1);
    bf16_t* h = (bf16_t*)(X.ws + WS_H); const bf16_t* y = X.sb(S_Y); u64* ssn = X.ss(lastl ? 16 : 4 * (l + 1)); const float* fn = inp(IN_FINAL_NORM); float* out = outp();
    const int lane = X.lane;
    {
        u32x2 ha[2][4], ya[2][4], yb[2][4];
#pragma unroll
        for (int q = 0; q < 2; ++q) { const int row = q ? r1 : r0;
#pragma unroll
            for (int j = 0; j < 4; ++j) { const u32x2 z = {0u, 0u}; ha[q][j] = z; ya[q][j] = z; yb[q][j] = z;
                if (row >= 0) { const size_t c = (size_t)j * 256 + lane * 4; ha[q][j] = *(const u32x2*)(h + (size_t)row * DM + c); ya[q][j] = __builtin_nontemporal_load((const u32x2*)(y + (size_t)(2 * row) * DM + c)); yb[q][j] = __builtin_nontemporal_load((const u32x2*)(y + (size_t)(2 * row + 1) * DM + c)); } } }
#pragma unroll
        for (int q = 0; q < 2; ++q) { const int row = q ? r1 : r0;
            if (row >= 0) {
                float vv[16]; float s = 0.f;
#pragma unroll
                for (int j = 0; j < 4; ++j) { const u32x2 a = ha[q][j], b0 = ya[q][j], b1 = yb[q][j];
                    vv[4 * j] = bflo(a.x) + (bflo(b0.x) + bflo(b1.x)); vv[4 * j + 1] = bfhi(a.x) + (bfhi(b0.x) + bfhi(b1.x)); vv[4 * j + 2] = bflo(a.y) + (bflo(b0.y) + bflo(b1.y)); vv[4 * j + 3] = bfhi(a.y) + (bfhi(b0.y) + bfhi(b1.y)); }
                if (!lastl) {
#pragma unroll
                    for (int j = 0; j < 4; ++j) { u32x2 w; w.x = pk2(vv[4 * j], vv[4 * j + 1]); w.y = pk2(vv[4 * j + 2], vv[4 * j + 3]); *(u32x2*)(h + (size_t)row * DM + j * 256 + lane * 4) = w;
                        if (H8_IN(l + 1)) *(unsigned*)(X.ws + WS_H8 + (size_t)row * DM + j * 256 + lane * 4) = pk4_fp8(bflo(w.x), bfhi(w.x), bflo(w.y), bfhi(w.y));
                        s += (bflo(w.x) * bflo(w.x) + bfhi(w.x) * bfhi(w.x)) + (bflo(w.y) * bflo(w.y) + bfhi(w.y) * bfhi(w.y)); }
                    s = wave_sum(s); if (lane == 0) ssn[row] = ss_fix(s);
                } else {
#pragma unroll
                    for (int k = 0; k < 16; ++k) s += vv[k] * vv[k];
                    s = wave_sum(s); float r = rsqrtf(s * (1.0f / DM) + EPS);
#ifdef PROBE_A
                    { const unsigned long long* st = (const unsigned long long*)(X.ws + 49152); const float cq = floorf((float)(st[PROBE_B] - st[PROBE_A]) * (0.01f / PROBE_Q) + 0.5f);
#pragma unroll
                      for (int k = 0; k < 16; ++k) vv[k] = cq; r = 1.0f; }
#endif
                    if (row < MMAIN) {
#pragma unroll
                        for (int j = 0; j < 4; ++j) { f32x4 g = *(const f32x4*)(fn + j * 256 + lane * 4);
#ifdef PROBE_A
                            g = (f32x4){1.f, 1.f, 1.f, 1.f};
#endif
                            f32x4 o = {vv[4 * j] * r * g[0], vv[4 * j + 1] * r * g[1], vv[4 * j + 2] * r * g[2], vv[4 * j + 3] * r * g[3]};
                            __builtin_nontemporal_store(o, (f32x4*)(out + (size_t)row * DM + j * 256 + lane * 4)); } }
                }
            } }
    }
}
__device__ __forceinline__ void moe_combine(const Ctx& X, int l) {
    const int gw = X.bid * 8 + X.wave, NGW = X.G * 8;
    for (int rowa = gw; rowa < MREAL; rowa += 2 * NGW) { const int rb = rowa + NGW; combine_rows(X, l, rowa, rb < MREAL ? rb : -1); }
}
__device__ __forceinline__ void moe_combine_ov(const Ctx& X, int l, const int ntail, const int nblk, volatile LAS unsigned* misc) {
    const int* alate = (const int*)(X.ws + WS_S + S_ALATE);
    if (X.bid >= ntail) {
        const int gw = (X.bid - ntail) * 8 + X.wave, NGW = (X.G - ntail) * 8;
        int f0 = 0, f1 = 0;
        if (gw < MREAL) { const u32x2 t = *(const u32x2*)(alate + 2 * gw); f0 = (int)(t.x | t.y); }
        if (gw + NGW < MREAL) { const u32x2 t = *(const u32x2*)(alate + 2 * (gw + NGW)); f1 = (int)(t.x | t.y); }
        for (int rowa = gw; rowa < MREAL; rowa += 2 * NGW) {
            const int rb = rowa + NGW, na = rowa + 2 * NGW, nb = na + NGW;
            const int la = __builtin_amdgcn_readfirstlane(f0), lb = __builtin_amdgcn_readfirstlane(f1);
            int g0 = 0, g1 = 0;
            if (na < MREAL) { const u32x2 t = *(const u32x2*)(alate + 2 * na); g0 = (int)(t.x | t.y); }
            if (nb < MREAL) { const u32x2 t = *(const u32x2*)(alate + 2 * nb); g1 = (int)(t.x | t.y); }
            combine_rows(X, l, la ? -1 : rowa, (rb < MREAL && !lb) ? rb : -1);
            f0 = g0; f1 = g1;
        }
    }
    unsigned* cnt = (unsigned*)(X.ws + CTL_TAILCNT_B) + (l >> 1) * 64;
    unsigned* bar = (unsigned*)(X.ws + WS_CTL) + CTL_BAR_W;
    __syncthreads();
    if (X.wave == 0 && lane_id() == 0) { XB_SPIN(xb_ld(cnt) < (unsigned)ntail, bar); __builtin_amdgcn_fence(__ATOMIC_ACQUIRE, "agent"); asm volatile("s_waitcnt vmcnt(0)" ::: "memory"); }
    __syncthreads();
    const int* sslot = (const int*)(X.ws + WS_S + S_SSLOT);
    const int gw = X.bid * 8 + X.wave, NGW = X.G * 8;
    for (int d = MOE_LATE_LIM + gw; d < nblk * 256; d += NGW) {
        const int a = __builtin_amdgcn_readfirstlane(sslot[d]);
        if (a < 0) continue;
        if ((a & 1) && __builtin_amdgcn_readfirstlane(alate[a ^ 1])) continue;
        combine_rows(X, l, a >> 1, -1);
    }
}
#ifndef SKIP
#define SKIP 0
#endif
#define PH_ON(bit) (!((SKIP >> (bit)) & 1))
#ifndef DUP
#define DUP 0
#endif
#define NREP(bit) ((((DUP) >> (bit)) & 1) ? 2 : 1)
#ifndef GU8_ALIGN
#define GU8_ALIGN true
#endif
#ifndef GU_ALIGN
#define GU_ALIGN true
#endif
#ifndef ONE_LAUNCH
#define ONE_LAUNCH 1
#endif
#ifndef TAIL_OVERLAP
#define TAIL_OVERLAP 1
#endif
constexpr int PH_PER_LAYER = 15, N_PHASES = 1 + DEPTH * PH_PER_LAYER;
constexpr int ATT_UNITS = NBATCH * NHEAD * 8 + NHEAD;

__device__ __forceinline__ bool stamp_fn(unsigned char* ws, int bid, int wave, int k) {
#ifdef PROBE_A
    if (bid == 0 && wave == 0 && lane_id() == 0) ((unsigned long long*)(ws + 49152))[k] = __builtin_amdgcn_s_memrealtime();
#endif
    return true;
}
__global__ void __launch_bounds__(512, 2) fwd(Args args) {
    extern __shared__ __attribute__((aligned(16))) unsigned char lds_raw[];
    Ctx X0; X0.lds = (LAS unsigned char*)lds_raw; X0.ws = wsp(); X0.wave = __builtin_amdgcn_readfirstlane((int)threadIdx.x >> 6); X0.lane = lane_id(); X0.tid = X0.wave * 64 + X0.lane; X0.G = gridDim.x; X0.bid = blockIdx.x;
    volatile LAS unsigned* MISC = (volatile LAS unsigned*)(X0.lds + LDS_MISC);
    for (int u = X0.tid; u < (LDS_BYTES - LDS_MISC) / 4; u += 512) MISC[u] = 0u;
    __syncthreads();
    const int lo = argi(0), hi = argi(1);
    const bool use_bar = (hi - lo) > 1;
    XcdBarrier bar; bar.bar = (unsigned*)(X0.ws + WS_CTL) + CTL_BAR_W; bar.x = 0; bar.st = MISC + 8;
    if (use_bar) bar = xcd_barrier_post((unsigned*)(X0.ws + WS_CTL) + CTL_BAR_W, MISC + 8, X0.wave == 0 && lane_id() == 0);
#define IN(k) ((lo <= (k) && (k) < hi) && stamp_fn(X0.ws, X0.bid, X0.wave, (k)))
#ifdef PROBE_BAR2
#define SEAM(k) do { if ((k) + 1 < hi) { xcd_barrier(bar, X0.wave == 0 && lane_id() == 0); xcd_barrier(bar, X0.wave == 0 && lane_id() == 0); } } while (0)
#else
#define SEAM(k) do { if ((k) + 1 < hi) xcd_barrier(bar, X0.wave == 0 && lane_id() == 0); } while (0)
#endif
    LAS unsigned char* ring = X0.lds;
#define PHASE_CTX const Ctx X = fresh(X0); bf16_t* H = (bf16_t*)(X.ws + WS_H); const float* rope = (const float*)(X.ws + WS_ROPE); (void)H; (void)rope;

    if (PH_ON(0) && IN(0)) { PHASE_CTX for (int rep = 0; rep < NREP(0); ++rep) { prologue(X); if (rep + 1 < NREP(0)) xcd_barrier(bar, X0.wave == 0 && lane_id() == 0); } SEAM(0); }

#pragma unroll 1
    for (int l = 0; l < DEPTH; ++l) {
        const int pb = 1 + l * PH_PER_LAYER;
        if (PH_ON(1) && IN(pb)) {
            PHASE_CTX unsigned char* wmix = X.ws + WS_WMIX + (size_t)l * SZ_WMIX; (void)wmix;
            if (PH_ON(0) && l == 2) { moe_convert(X, 1); __syncthreads(); }
            if (WIN_F8(l)) {
            pg8::StaticOrder S; S.init((const bf16_t*)(X.ws + WS_H8), (const bf16_t*)wmix, DM / 2, NPANEL - 1, DINP / 256, X.G, X.bid);
            EpiWin E{X.ws, l, 1.0f / W8_SCALE, QKV_F8(l), 0};
            pg8::thin_gemm8<EpiWin>(ring, X.tid, X.ws + WS_H8, wmix, DM, DINP / 256, X.bid, E);
            pg8::gemm_phase8<EpiWin, pg8::StaticOrder, false>(ring, X0.wave * 64 + lane_id(), DM, S, E);
            } else if (WINP_F8(l)) {
            { pg8::StaticOrder S; S.init((const bf16_t*)(X.ws + WS_H8), (const bf16_t*)wmix, DM / 2, NPANEL - 1, 4, X.G, X.bid);
              EpiWin E{X.ws, l, 1.0f / W8_SCALE, QKV_F8(l), 0};
              pg8::thin_gemm8<EpiWin>(ring, X.tid, X.ws + WS_H8, wmix, DM, 4, X.bid, E);
              pg8::gemm_phase8<EpiWin, pg8::StaticOrder, false>(ring, X0.wave * 64 + lane_id(), DM, S, E); }
            { const bf16_t* wb4 = (const bf16_t*)(wmix + (size_t)4 * 256 * DM * 2);
              pg8::StaticOrder S; S.init(H, wb4, DM, NPANEL - 1, DINP / 256 - 4, X.G, X.bid);
              EpiWin E{X.ws, l, 1.0f, QKV_F8(l), 4};
              pg8::thin_gemm<EpiWin>(ring, X.tid, H, wb4, DM, DINP / 256 - 4, X.bid, E);
              pg8::gemm_phase<EpiWin, pg8::StaticOrder, false>(ring, X0.wave * 64 + lane_id(), DM, S, E); }
            } else {
            pg8::StaticOrder S; S.init(H, (const bf16_t*)wmix, DM, NPANEL - 1, DINP / 256, X.G, X.bid, NREP(1));
            EpiWin E{X.ws, l, 1.0f, QKV_F8(l), 0};
            pg8::thin_gemm<EpiWin>(ring, X.tid, H, (const bf16_t*)wmix, DM, DINP / 256, X.bid, E);
            pg8::gemm_phase<EpiWin, pg8::StaticOrder, false>(ring, X.tid, DM, S, E);
            }
            SEAM(pb);
        }
        if (PH_ON(2) && IN(pb + 1)) {
            PHASE_CTX unsigned char* wmix = X.ws + WS_WMIX + (size_t)l * SZ_WMIX; (void)wmix;
            for (int rep = 0; rep < NREP(2); ++rep) {
            if (QKV_F8(l)) {
            if (PH_ON(15)) { pg8::StaticOrder S; S.init(X.sb(S_CQ), (const bf16_t*)(wmix + SZ_WIN), QLORA / 2, NPANEL - 1, 3, X.G, X.bid);
              EpiQ E{X.ws, l, 1.0f / W8_SCALE};
              pg8::thin_gemm8<EpiQ>(ring, X.tid, (const unsigned char*)X.sb(S_CQ), wmix + SZ_WIN, QLORA, 3, X.bid, E);
              pg8::gemm_phase8<EpiQ, pg8::StaticOrder, false>(ring, X0.wave * 64 + lane_id(), QLORA, S, E); }
            if (PH_ON(16)) { pg8::StaticOrder S; S.init(X.sb(S_CKV), (const bf16_t*)(wmix + SZ_WIN + SZ_WQ), KVLORA / 2, NPANEL - 1, 4, X.G, X.bid);
              EpiKV E{X.ws, l, 1.0f / W8_SCALE};
              pg8::thin_gemm8<EpiKV>(ring, X.tid, (const unsigned char*)X.sb(S_CKV), wmix + SZ_WIN + SZ_WQ, KVLORA, 4, X.bid, E);
              pg8::gemm_phase8<EpiKV, pg8::StaticOrder, false>(ring, X0.wave * 64 + lane_id(), KVLORA, S, E); }
            } else {
            if (PH_ON(15)) { pg8::StaticOrder S; S.init(X.sb(S_CQ), (const bf16_t*)(wmix + SZ_WIN), QLORA, NPANEL - 1, 3, X.G, X.bid, NREP(18));
              EpiQ E{X.ws, l, 1.0f};
              pg8::thin_gemm<EpiQ>(ring, X.tid, X.sb(S_CQ), (const bf16_t*)(wmix + SZ_WIN), QLORA, 3, X.bid, E);
              pg8::gemm_phase<EpiQ, pg8::StaticOrder, false>(ring, X.tid, QLORA, S, E); }
            if (PH_ON(16)) { pg8::StaticOrder S; S.init(X.sb(S_CKV), (const bf16_t*)(wmix + SZ_WIN + SZ_WQ), KVLORA, NPANEL - 1, 4, X.G, X.bid, NREP(18));
              EpiKV E{X.ws, l, 1.0f};
              pg8::thin_gemm<EpiKV>(ring, X.tid, X.sb(S_CKV), (const bf16_t*)(wmix + SZ_WIN + SZ_WQ), KVLORA, 4, X.bid, E);
              pg8::gemm_phase<EpiKV, pg8::StaticOrder, false>(ring, X.tid, KVLORA, S, E); }
            }
            if (rep + 1 < NREP(2)) xcd_barrier(bar, X0.wave == 0 && lane_id() == 0); }
            SEAM(pb + 1);
        }
        if (PH_ON(3) && IN(pb + 2)) {
            PHASE_CTX unsigned char* wmix = X.ws + WS_WMIX + (size_t)l * SZ_WMIX; (void)wmix;
            MixP P{X.sb(S_Q), X.sb(S_KN), X.sb(S_V), X.sb(S_KR), X.sb(S_XP), X.sb(S_MQK), X.sb(S_MV), X.sb(S_MO), (const float*)(X.ws + WS_S + S_GATES), X.sb(S_CAT),
                   inp(IN_CONV_W) + (size_t)l * 4 * 512, inp(IN_CONV_B) + l * 512, inp(IN_MLSTM_NORM) + l * 256, WOUT_F8(l)};
            for (int rep = 0; rep < NREP(3); ++rep) {
            if (PH_ON(12)) for (int it = X.bid; it < NBATCH * 32 + 1; it += X.G) { if (it < NBATCH * 32) pool_unit(P, X0.wave * 64 + lane_id(), it >> 5, (it & 31) + 1); else pool_unit(P, X0.wave * 64 + lane_id(), 0, 0); }
            if (PH_ON(13)) for (int u = X.bid; u < NBATCH * MH * NREP(13); u += X.G) mlstm_unit(ring, P, X0.wave * 64 + lane_id(), (u & 127) >> 2, u & 3);
            for (int rep3 = 0; rep3 < NREP(14); ++rep3) {
            unsigned* qhead = (unsigned*)(X.ws + CTL_QUEUE_B) + l * 64 + rep * 16 + rep3 * 32;
            if (PH_ON(14)) {
                unsigned nxt = 0u; const bool qleader = (X0.wave == 0 && lane_id() == 0);
                __syncthreads();
                if (qleader) MISC[16] = atomicAdd(qhead, 1u);
                __syncthreads();
                for (int it = 0;; ++it) {
                    const int idx = (int)MISC[16 + (it & 1)];
                    if (idx >= ATT_UNITS) break;
                    if (qleader) nxt = atomicAdd(qhead, 1u);
                    if (idx < NBATCH * NHEAD * 8) { const int qt = 7 - (idx >> 8), bh = idx & 255; attn_unit(ring, P, X.ws, X0.wave * 64 + lane_id(), bh >> 3, bh & 7, qt); }
                    else attn_unit(ring, P, X.ws, X0.wave * 64 + lane_id(), 0, idx - NBATCH * NHEAD * 8, -1);
                    if (qleader) MISC[16 + ((it + 1) & 1)] = nxt;
                    __syncthreads();
                }
            }
            }
            if (rep + 1 < NREP(3)) xcd_barrier(bar, X0.wave == 0 && lane_id() == 0); }
            SEAM(pb + 2);
        }
        if (PH_ON(4) && IN(pb + 3)) {
            PHASE_CTX unsigned char* wmix = X.ws + WS_WMIX + (size_t)l * SZ_WMIX; (void)wmix;
            if (WOUT_F8(l)) {
            pg8::StaticOrder S; S.init(X.sb(S_CAT), (const bf16_t*)(wmix + SZ_WIN + SZ_WQ + SZ_WKV), DM / 2, NPANEL - 1, 4, X.G, X.bid);
            EpiRes E{X.ws, 4 * l + 3, 1.0f / W8_SCALE, DENSE_F8(l) && (l & 1) == 0};
            pg8::thin_gemm8<EpiRes>(ring, X.tid, (const unsigned char*)X.sb(S_CAT), wmix + SZ_WIN + SZ_WQ + SZ_WKV, DM, 4, X.bid, E);
            pg8::gemm_phase8<EpiRes, pg8::StaticOrder, false>(ring, X0.wave * 64 + lane_id(), DM, S, E);
            } else {
            pg8::StaticOrder S; S.init(X.sb(S_CAT), (const bf16_t*)(wmix + SZ_WIN + SZ_WQ + SZ_WKV), DM, NPANEL - 1, 4, X.G, X.bid, NREP(4));
            EpiRes E{X.ws, 4 * l + 3, 1.0f, DENSE_F8(l) && (l & 1) == 0};
            pg8::thin_gemm<EpiRes>(ring, X.tid, X.sb(S_CAT), (const bf16_t*)(wmix + SZ_WIN + SZ_WQ + SZ_WKV), DM, 4, X.bid, E);
            pg8::gemm_phase<EpiRes, pg8::StaticOrder, false>(ring, X.tid, DM, S, E);
            }
            SEAM(pb + 3);
        }
        if ((l & 1) == 0) {
            if (PH_ON(5) && IN(pb + 4)) {
                PHASE_CTX unsigned char* wd = X.ws + WS_WDENSE + (size_t)(l >> 1) * SZ_DENSE;
if (DENSE_F8(l)) {
                pg8::StaticOrder S; S.init((const bf16_t*)(X.ws + WS_H8), (const bf16_t*)wd, DM / 2, NPANEL - 1, 2 * DFF / 256, X.G, X.bid);
                EpiGU8 E{X.ws, 4 * l + 3};
                pg8::thin_gemm8<EpiGU8>(ring, X.tid, X.ws + WS_H8, wd, DM, 2 * DFF / 256, X.bid, E);
                pg8::gemm_phase8<EpiGU8, pg8::StaticOrder, false, GU8_ALIGN>(ring, X0.wave * 64 + lane_id(), DM, S, E);
                } else {
                pg8::StaticOrder S; S.init(H, (const bf16_t*)wd, DM, NPANEL - 1, 2 * DFF / 256, X.G, X.bid, NREP(17));
                EpiGU E{X.ws, 4 * l + 3};
                pg8::thin_gemm<EpiGU>(ring, X.tid, H, (const bf16_t*)wd, DM, 2 * DFF / 256, X.bid, E);
                for (int rep = 0; rep < NREP(5); ++rep) { pg8::gemm_phase<EpiGU, pg8::StaticOrder, false, GU_ALIGN>(ring, X.tid, DM, S, E); if (rep + 1 < NREP(5)) xcd_barrier(bar, X0.wave == 0 && lane_id() == 0); }
                }
                SEAM(pb + 4);
            }
            if (PH_ON(6) && IN(pb + 5)) {
                PHASE_CTX unsigned char* wd = X.ws + WS_WDENSE + (size_t)(l >> 1) * SZ_DENSE;
if (DENSE_F8(l)) {
                pg8::StaticOrder S; S.init(X.sb(S_ACT), (const bf16_t*)(wd + SZ_DGU8), DFF / 2, NPANEL - 1, 4, X.G, X.bid);
                EpiRes E{X.ws, 4 * (l + 1), 1.0f / (W8_SCALE * ACT8_SCALE), H8_IN(l + 1)};
                pg8::thin_gemm8<EpiRes>(ring, X.tid, (const unsigned char*)X.sb(S_ACT), wd + SZ_DGU8, DFF, 4, X.bid, E);
                pg8::gemm_phase8<EpiRes, pg8::StaticOrder, false>(ring, X0.wave * 64 + lane_id(), DFF, S, E);
                } else {
                pg8::StaticOrder S; S.init(X.sb(S_ACT), (const bf16_t*)(wd + SZ_DGU), DFF, NPANEL - 1, 4, X.G, X.bid, NREP(6));
                EpiRes E{X.ws, 4 * (l + 1), 1.0f, H8_IN(l + 1)};
                pg8::thin_gemm<EpiRes>(ring, X.tid, X.sb(S_ACT), (const bf16_t*)(wd + SZ_DGU), DFF, 4, X.bid, E);
                pg8::gemm_phase<EpiRes, pg8::StaticOrder, false>(ring, X.tid, DFF, S, E);
                }
                SEAM(pb + 5);
            }
        } else {
            if (PH_ON(7) && IN(pb + 4)) { PHASE_CTX moe_route(X, l); SEAM(pb + 4); }
            if (PH_ON(8) && IN(pb + 5)) { PHASE_CTX moe_scatter(X, l); SEAM(pb + 5); }
#pragma unroll 1
            for (int ci = 0; ci < MOE_NCHUNK; ++ci) {
                if (IN(pb + 6 + 2 * ci) || IN(pb + 7 + 2 * ci)) {
                    PHASE_CTX const int* minfo = (const int*)(X.ws + WS_S + S_MINFO);
                    const int nblk = __builtin_amdgcn_readfirstlane(minfo[0]);
                    const int blk_lo = MOE_CHUNK * ci; int blk_hi = (ci == MOE_NCHUNK - 1) ? nblk : (nblk < MOE_CHUNK * (ci + 1) ? nblk : MOE_CHUNK * (ci + 1));
                    if (blk_hi > blk_lo + MOE_CHUNK_CAP) blk_hi = blk_lo + MOE_CHUNK_CAP;
                    const int nb = blk_hi > blk_lo ? blk_hi - blk_lo : 0;
                    if (PH_ON(9) && IN(pb + 6 + 2 * ci)) {
                        if (MOE_F8(l)) {
                            MoeOrder S{blk_lo, nb, 2 * DFFE / 256, X.G, X.bid, (const char*)(X.ws + WS_XS8) + (size_t)blk_lo * 256 * DM, (const char*)(X.ws + WS_WMOE), (size_t)256 * DM, (size_t)256 * DM, (const int*)(X.ws + WS_S + S_STOK), minfo + 16, false, SZ_EXP8};
                            EpiMoeGU8 E{X.ws, blk_lo};
                            pg8::gemm_phase8<EpiMoeGU8, MoeOrder, false, GU8_ALIGN>(ring, X0.wave * 64 + lane_id(), DM, S, E);
                        } else {
#if FP8_MOE_MASK != 0xA
                        MoeOrder S{blk_lo, nb, 2 * DFFE / 256, X.G, X.bid, (const char*)H, (const char*)(X.ws + WS_WMOE), 0, (size_t)256 * DM * 2, (const int*)(X.ws + WS_S + S_STOK), minfo + 16, true, SZ_EXP};
                        EpiMoeGU E{X.ws, blk_lo};
                        for (int rep = 0; rep < NREP(9); ++rep) { pg8::gemm_phase<EpiMoeGU, MoeOrder, true, GU_ALIGN>(ring, X0.wave * 64 + lane_id(), DM, S, E); if (rep + 1 < NREP(9)) xcd_barrier(bar, X0.wave == 0 && lane_id() == 0); }
#endif
                        }
                        SEAM(pb + 6 + 2 * ci);
                    }
                    if (PH_ON(10) && IN(pb + 7 + 2 * ci)) {
                        if (MOE_F8(l)) {
                            const bool ov = TAIL_OVERLAP && ci == MOE_NCHUNK - 1 && nb > 256 && X.G >= 128;
                            const int rem = ov ? nb - 256 : 0;
#pragma unroll 1
                            for (int part = 0; part < (ov ? 2 : 1); ++part) {
                                const int lo_ = part ? blk_lo + 256 : blk_lo, nb_ = part ? rem : (ov ? 256 : nb);
                                if (part) SEAM(pb + 7 + 2 * ci);
                                if (!part || X.bid < 4 * rem) {
                                    MoeOrder S{lo_, nb_, 4, X.G, X.bid, (const char*)X.sb(S_ACTE) + (size_t)(lo_ - blk_lo) * 256 * DFFE, (const char*)(X.ws + WS_WMOE + SZ_EGU8), (size_t)256 * DFFE, (size_t)256 * DFFE, (const int*)(X.ws + WS_S + S_STOK), minfo + 16, false, SZ_EXP8};
                                    EpiMoeDown8 E{X.ws};
                                    pg8::gemm_phase8<EpiMoeDown8, MoeOrder, false>(ring, X0.wave * 64 + lane_id(), DFFE, S, E);
                                    if (part) { asm volatile("s_waitcnt vmcnt(0)" ::: "memory"); __syncthreads();
                                        if (X0.wave == 0 && lane_id() == 0) { __builtin_amdgcn_fence(__ATOMIC_RELEASE, "agent"); asm volatile("s_waitcnt vmcnt(0)" ::: "memory"); xb_add((unsigned*)(X.ws + CTL_TAILCNT_B) + (l >> 1) * 64, 1u); } }
                                }
                            }
                            if (ov) continue;
                        } else {
#if FP8_MOE_MASK != 0xA
                        MoeOrder S{blk_lo, nb, 4, X.G, X.bid, (const char*)X.sb(S_ACTE), (const char*)(X.ws + WS_WMOE + SZ_EGU), (size_t)256 * DFFE * 2, (size_t)256 * DFFE * 2, (const int*)(X.ws + WS_S + S_STOK), minfo + 16, false, SZ_EXP};
                        EpiMoeDown E{X.ws};
                        for (int rep = 0; rep < NREP(10); ++rep) { pg8::gemm_phase<EpiMoeDown, MoeOrder, false>(ring, X0.wave * 64 + lane_id(), DFFE, S, E); if (rep + 1 < NREP(10)) xcd_barrier(bar, X0.wave == 0 && lane_id() == 0); }
#endif
                        }
                        SEAM(pb + 7 + 2 * ci);
                    }
                }
            }
            if (PH_ON(11) && IN(pb + 14)) { PHASE_CTX
                const int nblk = __builtin_amdgcn_readfirstlane(((const int*)(X.ws + WS_S + S_MINFO))[0]);
                if (TAIL_OVERLAP && MOE_F8(l) && MOE_NCHUNK == 2 && nblk > 512 && nblk <= 520 && X.G >= 128 && IN(pb + 7 + 2 * (MOE_NCHUNK - 1))) moe_combine_ov(X, l, 4 * (nblk - 512), nblk, MISC);
                else moe_combine(X, l);
                SEAM(pb + 14); }
        }
    }
#undef IN
#undef SEAM
}

extern "C" void kernel_launch(void* const* d_in, const int* in_sizes, int n_in, void* d_out, int out_size, void* d_ws, size_t ws_size, hipStream_t stream) {
    static int grid = 0;
    if (grid == 0) {
        if (n_in != N_IN || in_sizes[0] != MMAIN * DM || out_size != MMAIN * DM || ws_size < WS_END8) {
            fprintf(stderr, "kernel_launch: unexpected shapes (n_in %d, in0 %d, out %d, ws %zu < %zu); nothing launched\n", n_in, n_in > 0 ? in_sizes[0] : -1, out_size, ws_size, (size_t)WS_END); grid = -1; return; }
        int dev = 0, cus = 0, per_cu = 0;
        if (hipGetDevice(&dev) != hipSuccess || hipDeviceGetAttribute(&cus, hipDeviceAttributeMultiprocessorCount, dev) != hipSuccess) { grid = -1; return; }
        if (hipFuncSetAttribute((const void*)fwd, hipFuncAttributeMaxDynamicSharedMemorySize, LDS_BYTES) != hipSuccess) { fprintf(stderr, "kernel_launch: hipFuncSetAttribute failed\n"); grid = -1; return; }
        if (hipOccupancyMaxActiveBlocksPerMultiprocessor(&per_cu, (const void*)fwd, 512, LDS_BYTES) != hipSuccess || per_cu < 1) { fprintf(stderr, "kernel_launch: occupancy query says %d\n", per_cu); }
        (void)hipGetLastError();
        grid = cus;
    }
    if (grid < 0) return;
    (void)hipMemsetAsync((char*)d_ws + WS_CTL, 0, CTL_BYTES, stream);
    Args a{};
    for (int i = 0; i < N_IN; ++i) a.in[i] = (const float*)d_in[i];
    a.out = (float*)d_out; a.ws = (unsigned char*)d_ws;
#if ONE_LAUNCH
    a.ph_lo = 0; a.ph_hi = N_PHASES;
    hipLaunchKernelGGL(fwd, dim3(grid), dim3(512), LDS_BYTES, stream, a);
#else
    for (int ph = 0; ph < N_PHASES; ++ph) {
        if (ph > 0) { const int l = (ph - 1) / PH_PER_LAYER, r = (ph - 1) % PH_PER_LAYER; if ((l & 1) == 0 && r > 5) continue; }
        a.ph_lo = ph; a.ph_hi = ph + 1;
        hipLaunchKernelGGL(fwd, dim3(grid), dim3(512), LDS_BYTES, stream, a);
    }
#endif
    const hipError_t le = hipPeekAtLastError();
    if (le != hipSuccess) fprintf(stderr, "kernel_launch: launch failed: %s\n", hipGetErrorName(le));
}
```
